# Optimizing an MI355X kernel written in HIP

```python
import math
import jax, jax.numpy as jnp
from jax import lax
import numpy as np

D_MODEL = 1024
BATCH = 2
SEQ = 8192
DEPTH = 2
DEC_BATCH = 1
DEC_SEQ = 16384
PAST_LEN = 128

MEM_LEN = 256
D_FF = 2816
EPS = 1e-6
N_MIXERS = 2
GLA_HEADS = 4
GLA_DK = D_MODEL // 2 // GLA_HEADS
GLA_DV = D_MODEL // GLA_HEADS
GLA_RANK = 16
GLA_TAU = 16.0
GLA_CHUNK = 64
GLA_IN = 2 * GLA_HEADS * GLA_DK + 2 * GLA_HEADS * GLA_DV + 2 * GLA_RANK
DIL_GROUPS = ((128, 1), (512, 4), (2048, 16))
N_DIL = len(DIL_GROUPS)
DIL_HEADS = 16
DIL_HD = D_MODEL // DIL_HEADS
DIL_QKV = 3 * N_DIL * DIL_HEADS * DIL_HD
NUM_BUCKETS = 32
MAX_DISTANCE = 1024
X_HEADS = 4
X_HD = D_MODEL // X_HEADS
N_A = (DEPTH + 1) // 2
N_B = DEPTH // 2
NEG = -1e30

kernel_name = 'hybrid_gla_dilated_encoder'


def rmsnorm(x, g):
    xf = x.astype(jnp.float32)
    y = xf * lax.rsqrt(jnp.mean(xf * xf, axis=-1, keepdims=True) + EPS)
    return (y * g.astype(jnp.float32)).astype(x.dtype)


def swiglu(x, w_in, w_out):
    a, b = jnp.split(x @ w_in, 2, axis=-1)
    return (jax.nn.silu(a) * b) @ w_out


def t5_bucket(rel):
    half = NUM_BUCKETS // 2
    max_exact = half // 2
    ret = (rel > 0).astype(np.int32) * half
    n = np.abs(rel)
    large = max_exact + (np.log(np.maximum(n, 1) / max_exact) / np.log(MAX_DISTANCE / max_exact) * (half - max_exact)).astype(np.int32)
    large = np.minimum(large, half - 1)
    return (ret + np.where(n < max_exact, n, large)).astype(np.int32)


def gla_scan(q, k, v, g):
    B, H, S, DK = q.shape
    DV = v.shape[-1]
    n = S // GLA_CHUNK
    causal = np.tril(np.ones((GLA_CHUNK, GLA_CHUNK), dtype=bool))

    def chunks(t):
        return jnp.moveaxis(t.reshape(B, H, n, GLA_CHUNK, t.shape[-1]), 2, 0)

    def step(state, inp):
        qc, kc, vc, gc = inp
        b = jnp.cumsum(gc, axis=2)
        inter = jnp.einsum('bhck,bhkv->bhcv', qc * jnp.exp(b), state)
        diff = b[:, :, :, None, :] - b[:, :, None, :, :]
        decay = jnp.exp(jnp.where(causal[:, :, None], diff, -jnp.inf))
        att = jnp.einsum('bhijk,bhjk->bhij', qc[:, :, :, None, :] * decay, kc)
        intra = jnp.einsum('bhij,bhjv->bhiv', att, vc)
        b_last = b[:, :, -1:, :]
        new_state = jnp.exp(b_last[:, :, 0, :])[..., None] * state + jnp.einsum('bhck,bhcv->bhkv', kc * jnp.exp(b_last - b), vc)
        return new_state, inter + intra

    state0 = jnp.zeros((B, H, DK, DV), jnp.float32)
    _, out = lax.scan(step, state0, (chunks(q), chunks(k), chunks(v), chunks(g)))
    return jnp.moveaxis(out, 0, 2).reshape(B, H, S, DV)


def gla_mixer(h, w_in, wg_f, bg_f, wg_b, bg_b, g_norm, w_out):
    B, S, _ = h.shape
    dq = GLA_HEADS * GLA_DK
    dv = GLA_HEADS * GLA_DV
    proj = h @ w_in
    q, k, v, r, zf, zb = jnp.split(proj, [dq, 2 * dq, 2 * dq + dv, 2 * dq + 2 * dv, 2 * dq + 2 * dv + GLA_RANK], axis=-1)

    def heads(t, d):
        return t.reshape(B, S, GLA_HEADS, d).transpose(0, 2, 1, 3).astype(jnp.float32)

    def log_gate(z, wg, bg):
        return heads(jax.nn.log_sigmoid((z @ wg + bg).astype(jnp.float32)) / GLA_TAU, GLA_DK)

    q = heads(q, GLA_DK) * (GLA_DK ** -0.5)
    k = heads(k, GLA_DK)
    v = heads(v, GLA_DV)
    gf = log_gate(zf, wg_f, bg_f)
    gb = log_gate(zb, wg_b, bg_b)
    flip = lambda t: jnp.flip(t, axis=2)
    o = gla_scan(q, k, v, gf) + flip(gla_scan(flip(q), flip(k), flip(v), flip(gb)))
    o = o.transpose(0, 2, 1, 3)
    o = o * lax.rsqrt(jnp.mean(o * o, axis=-1, keepdims=True) + EPS) * g_norm.reshape(GLA_HEADS, GLA_DV).astype(jnp.float32)
    o = o.reshape(B, S, dv).astype(h.dtype) * jax.nn.silu(r)
    return o @ w_out


def dilated_group(q, k, v, r, n_side, bias_cols):
    B, S, H, D = q.shape
    L = S // r
    W = n_side
    nb = -(-L // W)
    Lp = nb * W
    N = B * r

    def sub(t):
        return t.reshape(B, L, r, H, D).transpose(0, 2, 1, 3, 4).reshape(N, L, H, D)

    qs, ks, vs = sub(q), sub(k), sub(v)
    qb = jnp.pad(qs, ((0, 0), (0, Lp - L), (0, 0), (0, 0))).reshape(N, nb, W, H, D)

    def band(t):
        tp = jnp.pad(t, ((0, 0), (W, Lp - L + W), (0, 0), (0, 0))).reshape(N, nb + 2, W, H, D)
        return jnp.concatenate([tp[:, :-2], tp[:, 1:-1], tp[:, 2:]], axis=2)

    kb, vb = band(ks), band(vs)
    rel = np.arange(3 * W)[None, :] - W - np.arange(W)[:, None]
    key_pos = np.arange(nb)[:, None] * W - W + np.arange(3 * W)[None, :]
    mask = (np.abs(rel) <= W)[None] & ((key_pos >= 0) & (key_pos < L))[:, None, :]
    bias = jnp.transpose(bias_cols[t5_bucket(rel * r)], (2, 0, 1)).astype(jnp.float32)
    s = jnp.einsum('nbqhd,nbkhd->nbhqk', qb, kb).astype(jnp.float32) * (D ** -0.5) + bias
    s = jnp.where(mask[None, :, None], s, NEG)
    mx = jnp.max(s, axis=-1, keepdims=True)
    p = jnp.exp(s - mx)
    l = jnp.sum(p, axis=-1, keepdims=True)
    o = jnp.einsum('nbhqk,nbkhd->nbqhd', p, vb.astype(jnp.float32))
    o = o / jnp.moveaxis(l[..., 0], 2, 3)[..., None]
    lse = jnp.moveaxis((mx + jnp.log(l))[..., 0], 2, 3)

    def unsub(t):
        rest = t.shape[3:]
        t = t.reshape((N, Lp) + rest)[:, :L]
        return jnp.swapaxes(t.reshape((B, r, L) + rest), 1, 2).reshape((B, S) + rest)

    return unsub(o), unsub(lse)


def dilated_mixer(h, w_qkv, w_out, rel_bias):
    B, S, _ = h.shape
    qkv = (h @ w_qkv).reshape(B, S, 3, N_DIL, DIL_HEADS, DIL_HD)
    outs, lses = [], []
    for g, (window, r) in enumerate(DIL_GROUPS):
        o, lse = dilated_group(qkv[:, :, 0, g], qkv[:, :, 1, g], qkv[:, :, 2, g], r, window // (2 * r),
                               rel_bias[:, g * DIL_HEADS:(g + 1) * DIL_HEADS])
        outs.append(o)
        lses.append(lse)
    wts = jax.nn.softmax(jnp.stack(lses), axis=0)
    o = jnp.sum(wts[..., None] * jnp.stack(outs), axis=0)
    return o.reshape(B, S, D_MODEL).astype(h.dtype) @ w_out


def cross_attn(h, m, w_q, w_kv, w_o):
    B, S, _ = h.shape
    M = m.shape[1]
    q = (h @ w_q).reshape(B, S, X_HEADS, X_HD)
    kv = (m @ w_kv).reshape(B, M, 2, X_HEADS, X_HD)
    s = jnp.einsum('bqhd,bkhd->bhqk', q, kv[:, :, 0]).astype(jnp.float32) * (X_HD ** -0.5)
    p = jax.nn.softmax(s, axis=-1)
    o = jnp.einsum('bhqk,bkhd->bqhd', p, kv[:, :, 1].astype(jnp.float32))
    return o.reshape(B, S, D_MODEL).astype(h.dtype) @ w_o


def trunk(x, mem, rel_bias, norm_ffn1, ffn1_in, ffn1_out, norm_mix, gla_w_in, gla_wg_f, gla_bg_f, gla_wg_b, gla_bg_b,
          gla_norm, gla_w_out, dil_w_qkv, dil_w_out, norm_cross, norm_mem, cross_w_q, cross_w_kv, cross_w_o,
          norm_ffn2, ffn2_in, ffn2_out, norm_final):
    for i in range(DEPTH):
        x = x + 0.5 * swiglu(rmsnorm(x, norm_ffn1[i]), ffn1_in[i], ffn1_out[i])
        h = rmsnorm(x, norm_mix[i])
        j = i // N_MIXERS
        if i % N_MIXERS == 0:
            x = x + gla_mixer(h, gla_w_in[j], gla_wg_f[j], gla_bg_f[j], gla_wg_b[j], gla_bg_b[j], gla_norm[j], gla_w_out[j])
        else:
            x = x + dilated_mixer(h, dil_w_qkv[j], dil_w_out[j], rel_bias)
        x = x + cross_attn(rmsnorm(x, norm_cross[i]), rmsnorm(mem, norm_mem[i]), cross_w_q[i], cross_w_kv[i], cross_w_o[i])
        x = x + 0.5 * swiglu(rmsnorm(x, norm_ffn2[i]), ffn2_in[i], ffn2_out[i])
    return rmsnorm(x, norm_final)


def setup_inputs(seed: int = 0) -> dict:
    key = jax.random.key(seed)
    ks = jax.random.split(key, 32)
    f32 = jnp.float32

    def w(k, shape, fan_in):
        return jax.random.normal(k, shape, f32) * (fan_in ** -0.5)

    def gain(k, shape):
        return 1.0 + 0.05 * jax.random.normal(k, shape, f32)

    D = D_MODEL
    return {
        'x_prompt': jax.random.normal(ks[0], (BATCH, SEQ, D), f32),
        'x_sample': jax.random.normal(ks[1], (DEC_BATCH, DEC_SEQ, D), f32),
        'mem_prompt': jax.random.normal(ks[2], (BATCH, MEM_LEN, D), f32),
        'mem_sample': jax.random.normal(ks[3], (DEC_BATCH, MEM_LEN, D), f32),
        'rel_bias': 0.1 * jax.random.normal(ks[4], (NUM_BUCKETS, N_DIL * DIL_HEADS), f32),
        'norm_ffn1': gain(ks[5], (DEPTH, D)),
        'ffn1_in': w(ks[6], (DEPTH, D, 2 * D_FF), D),
        'ffn1_out': w(ks[7], (DEPTH, D_FF, D), D_FF),
        'norm_mix': gain(ks[8], (DEPTH, D)),
        'gla_w_in': w(ks[9], (N_A, D, GLA_IN), D),
        'gla_wg_f': w(ks[10], (N_A, GLA_RANK, GLA_HEADS * GLA_DK), GLA_RANK),
        'gla_bg_f': 0.1 * jax.random.normal(ks[11], (N_A, GLA_HEADS * GLA_DK), f32),
        'gla_wg_b': w(ks[12], (N_A, GLA_RANK, GLA_HEADS * GLA_DK), GLA_RANK),
        'gla_bg_b': 0.1 * jax.random.normal(ks[13], (N_A, GLA_HEADS * GLA_DK), f32),
        'gla_norm': gain(ks[14], (N_A, GLA_HEADS * GLA_DV)),
        'gla_w_out': w(ks[15], (N_A, GLA_HEADS * GLA_DV, D), GLA_HEADS * GLA_DV),
        'dil_w_qkv': w(ks[16], (N_B, D, DIL_QKV), D),
        'dil_w_out': w(ks[17], (N_B, DIL_HEADS * DIL_HD, D), DIL_HEADS * DIL_HD),
        'norm_cross': gain(ks[18], (DEPTH, D)),
        'norm_mem': gain(ks[19], (DEPTH, D)),
        'cross_w_q': w(ks[20], (DEPTH, D, D), D),
        'cross_w_kv': w(ks[21], (DEPTH, D, 2 * D), D),
        'cross_w_o': w(ks[22], (DEPTH, D, D), D),
        'norm_ffn2': gain(ks[23], (DEPTH, D)),
        'ffn2_in': w(ks[24], (DEPTH, D, 2 * D_FF), D),
        'ffn2_out': w(ks[25], (DEPTH, D_FF, D), D_FF),
        'norm_final': gain(ks[26], (D,)),
    }


def reference(x_prompt, x_sample, mem_prompt, mem_sample, rel_bias, norm_ffn1, ffn1_in, ffn1_out, norm_mix,
              gla_w_in, gla_wg_f, gla_bg_f, gla_wg_b, gla_bg_b, gla_norm, gla_w_out, dil_w_qkv, dil_w_out,
              norm_cross, norm_mem, cross_w_q, cross_w_kv, cross_w_o, norm_ffn2, ffn2_in, ffn2_out, norm_final):
    y_prompt = trunk(x_prompt, mem_prompt, rel_bias, norm_ffn1, ffn1_in, ffn1_out, norm_mix, gla_w_in, gla_wg_f,
                     gla_bg_f, gla_wg_b, gla_bg_b, gla_norm, gla_w_out, dil_w_qkv, dil_w_out, norm_cross, norm_mem,
                     cross_w_q, cross_w_kv, cross_w_o, norm_ffn2, ffn2_in, ffn2_out, norm_final)
    y_sample = trunk(x_sample, mem_sample, rel_bias, norm_ffn1, ffn1_in, ffn1_out, norm_mix, gla_w_in, gla_wg_f,
                     gla_bg_f, gla_wg_b, gla_bg_b, gla_norm, gla_w_out, dil_w_qkv, dil_w_out, norm_cross, norm_mem,
                     cross_w_q, cross_w_kv, cross_w_o, norm_ffn2, ffn2_in, ffn2_out, norm_final)
    return (y_prompt, y_sample)
```

```cpp
#include <hip/hip_runtime.h>
#include <hip/hip_cooperative_groups.h>
#include <cstdio>
#include <cstdint>
namespace cg = cooperative_groups;

#define LAS __attribute__((address_space(3)))
typedef unsigned short bf16_t;
typedef short bf16x8 __attribute__((ext_vector_type(8)));
typedef short bf16x4 __attribute__((ext_vector_type(4)));
typedef float f32x4 __attribute__((ext_vector_type(4)));
typedef float f32x2 __attribute__((ext_vector_type(2)));
typedef unsigned u32x4 __attribute__((ext_vector_type(4)));
typedef unsigned u32x2 __attribute__((ext_vector_type(2)));

#ifndef OPMASK
#define OPMASK 0xFFFFFFFFu
#endif
#define EN(o) ((OPMASK >> (o)) & 1u)
constexpr int T = 32768, DM = 1024, DFF = 2816;
constexpr float EPS = 1e-6f;
constexpr int BM = 256, BK = 64, HALF = 128, HTB = HALF * BK * 2, STAGE_BYTES = 8 * HTB, NXCD = 8, WGM = 8;
constexpr int LDS_X = STAGE_BYTES;
constexpr int LDS_BYTES = STAGE_BYTES + 8192;

constexpr size_t E_FFN1_IN = 0, E_FFN1_OUT = 5767168, E_FFN2_IN = 8650752, E_FFN2_OUT = 14417920, E_CQ = 17301504, E_CKV = 18350080,
                 E_CO = 20447232, E_MIX_IN = 21495808, E_MIX_OUT = 30932992, E_GT = 31981568, E_HM = 35127296, E_WEND = 38273024;
constexpr size_t OFF_XB = E_WEND * 2, OFF_PART = OFF_XB + (size_t)T * DM * 2, OFF_BTAB = OFF_PART + (size_t)T * 16, OFF_STAGE = OFF_BTAB + 32768;
constexpr size_t ST_HID = 0, ST_MEMN = 184549376, ST_KV = 186122240;
constexpr size_t ST_ABUF = 0, ST_QK = 67108864, ST_GG = 83886080, ST_VV = 117440512, ST_OF = 134217728, ST_OB = 167772160, ST_SLOC = 201326592, ST_DVEC = 209715200;
constexpr size_t ST_QKG = 67108864, ST_VTG = 167772160;
constexpr size_t WS_NEED = OFF_STAGE + 218103808;

struct Params {
    const float* in[27];
    float* X;
    unsigned char* ws;
    int ph_lo, ph_hi;
};

__device__ __forceinline__ unsigned cvt_pk_bf16(float lo, float hi) { unsigned r; asm volatile("v_cvt_pk_bf16_f32 %0, %1, %2" : "=v"(r) : "v"(lo), "v"(hi)); return r; }
__device__ __forceinline__ float bf2f(bf16_t b) { return __uint_as_float(((unsigned)b) << 16); }
__device__ __forceinline__ bf16_t f2bf(float f) { return (bf16_t)(cvt_pk_bf16(f, 0.f) & 0xffffu); }

__host__ __device__ __forceinline__ int lds_byte(int r, int c) { const int st = (r >> 4) * 2 + (c >> 5), rr = r & 15, cc = c & 31, ob = rr * 64 + cc * 2; return st * 1024 + (ob ^ (((ob >> 9) & 1) << 5)); }
__host__ __device__ __forceinline__ void stage_rc(int b, int& R, int& C) { const int st = b / 1024, sb = b % 1024, swz = sb ^ (((sb >> 9) & 1) << 5); R = (st >> 1) * 16 + swz / 64; C = (st & 1) * 32 + (swz % 64) / 2; }
__host__ __device__ __forceinline__ int perm32(int rho) { const int n = rho >> 4, i = rho & 15; return 8 * (i >> 2) + 4 * n + (i & 3); }

struct Unit { int pm, pn, b; const char* a; const char* bt; };

__device__ __forceinline__ int dil_token0(int n0, int r) {
    const int sb = n0 < 8192 ? 0 : (n0 < 16384 ? 8192 : 16384), S = n0 < 16384 ? 8192 : 16384, L = S / r;
    const int c = (n0 - sb) / L, l0 = (n0 - sb) % L;
    return sb + l0 * r + c;
}

struct Sched {
    const char* A; const char* Bt;
    int a_tile, b_tile, a_batch, b_batch, seqB;
    int nM, nN, nB, G, c, mode, r;
    __device__ __forceinline__ bool next(int i, Unit& u) const {
        const int per = nM * nN; const long tot = (long)per * nB;
        const long L = (long)i * G + c; if (L >= tot) return false;
        int b = (int)(L / per); int wgid = (int)(L % per);
        { const int q = per / NXCD, rr = per % NXCD, xcd = wgid % NXCD, off = wgid / NXCD; wgid = (xcd < rr ? xcd * (q + 1) : rr * (q + 1) + (xcd - rr) * q) + off; }
        const int nig = WGM * nN, gid = wgid / nig, fm = gid * WGM, gsz = (nM - fm) < WGM ? (nM - fm) : WGM;
        u.pm = fm + ((wgid % nig) % gsz); u.pn = (wgid % nig) / gsz; u.b = b;
        const char* a = A + (long)b * a_batch; const char* bt = Bt + (long)b * b_batch;
        if (mode == 2) a += (long)dil_token0(u.pm * 256, r) * (DM * 2); else a += (long)u.pm * a_tile;
        if (mode == 3) bt += (long)dil_token0(u.pn * 256, r) * (DM * 2); else bt += (long)u.pn * b_tile;
        if (mode == 1) { const int s = u.pm < 32 ? 0 : (u.pm < 64 ? 1 : 2); bt += (long)s * seqB; }
        u.a = a; u.bt = bt; return true;
    }
};

__device__ __forceinline__ float rstd_of(const float* part, int row) {
    const f32x4 p = *(const f32x4*)(part + (size_t)row * 4);
    return rsqrtf(((p[0] + p[1]) + (p[2] + p[3])) * (1.0f / 1024.0f) + EPS);
}

#define LBAR() do { asm volatile("s_waitcnt lgkmcnt(0)" ::: "memory"); __builtin_amdgcn_s_barrier(); asm volatile("" ::: "memory"); } while (0)

struct EpiPlain {
    bf16_t* O; int ldc; int bstride;
    __device__ __forceinline__ void operator()(const f32x4 (&acc)[2][2][4][2], const Unit& u, int wr, int wc, int fr, int fq) const {
        bf16_t* base = O + (long)u.b * bstride;
#pragma unroll
        for (int ai = 0; ai < 2; ++ai)
#pragma unroll
            for (int m = 0; m < 4; ++m) { const int row = u.pm * 256 + ai * 128 + wr * 64 + m * 16 + fr;
#pragma unroll
                for (int bj = 0; bj < 2; ++bj) { const int col = u.pn * 256 + bj * 128 + wc * 32 + 8 * fq;
                    const f32x4 v0 = acc[ai][bj][m][0], v1 = acc[ai][bj][m][1];
                    u32x4 w; w.x = cvt_pk_bf16(v0[0], v0[1]); w.y = cvt_pk_bf16(v0[2], v0[3]); w.z = cvt_pk_bf16(v1[0], v1[1]); w.w = cvt_pk_bf16(v1[2], v1[3]);
                    *(u32x4*)(base + (long)row * ldc + col) = w; } }
    }
};
struct EpiSwiGLU {
    bf16_t* H; const float* part;
    __device__ __forceinline__ void operator()(const f32x4 (&acc)[2][2][4][2], const Unit& u, int wr, int wc, int fr, int fq) const {
#pragma unroll
        for (int ai = 0; ai < 2; ++ai)
#pragma unroll
            for (int m = 0; m < 4; ++m) { const int row = u.pm * 256 + ai * 128 + wr * 64 + m * 16 + fr; const float rs = rstd_of(part, row);
                float h[8];
#pragma unroll
                for (int n = 0; n < 2; ++n)
#pragma unroll
                    for (int j = 0; j < 4; ++j) { const float a = acc[ai][0][m][n][j] * rs, b = acc[ai][1][m][n][j] * rs; h[n * 4 + j] = a * b / (1.0f + __expf(-a)); }
                u32x4 w; w.x = cvt_pk_bf16(h[0], h[1]); w.y = cvt_pk_bf16(h[2], h[3]); w.z = cvt_pk_bf16(h[4], h[5]); w.w = cvt_pk_bf16(h[6], h[7]);
                *(u32x4*)(H + (long)row * DFF + u.pn * 128 + wc * 32 + 8 * fq) = w; }
    }
};
struct EpiResid {
    float* X; bf16_t* XB; float* part; float scale; LAS float* xt;
    __device__ __forceinline__ void operator()(const f32x4 (&acc)[2][2][4][2], const Unit& u, int wr, int wc, int fr, int fq) const {
#pragma unroll
        for (int ai = 0; ai < 2; ++ai)
#pragma unroll
            for (int m = 0; m < 4; ++m) { const int rl = ai * 128 + wr * 64 + m * 16 + fr; const long row = (long)u.pm * 256 + rl; float ss = 0.f;
#pragma unroll
                for (int bj = 0; bj < 2; ++bj) { const int col = u.pn * 256 + bj * 128 + wc * 32 + 8 * fq;
                    float* xp = X + row * DM + col;
                    f32x4 x0 = *(const f32x4*)xp, x1 = *(const f32x4*)(xp + 4);
                    x0 += acc[ai][bj][m][0] * scale; x1 += acc[ai][bj][m][1] * scale;
                    *(f32x4*)xp = x0; *(f32x4*)(xp + 4) = x1;
                    u32x4 w; w.x = cvt_pk_bf16(x0[0], x0[1]); w.y = cvt_pk_bf16(x0[2], x0[3]); w.z = cvt_pk_bf16(x1[0], x1[1]); w.w = cvt_pk_bf16(x1[2], x1[3]);
                    *(u32x4*)(XB + row * DM + col) = w;
                    ss += (x0[0] * x0[0] + x0[1] * x0[1]) + (x0[2] * x0[2] + x0[3] * x0[3]) + (x1[0] * x1[0] + x1[1] * x1[1]) + (x1[2] * x1[2] + x1[3] * x1[3]); }
                ss += __shfl_xor(ss, 16); ss += __shfl_xor(ss, 32);
                if (fq == 0) xt[rl * 4 + wc] = ss;
                asm volatile("" ::: "memory"); }
        LBAR();
        const int lane = fq * 16 + fr;
        if (lane < 32) { const int q = wc * 32 + lane, rl = (q >> 6) * 128 + wr * 64 + (q & 63);
            const f32x4 s = *(const LAS f32x4*)(xt + rl * 4);
            part[((size_t)u.pm * 256 + rl) * 4 + u.pn] = (s[0] + s[1]) + (s[2] + s[3]); }
    }
};
struct EpiGlaProj {
    bf16_t* QK; float* GG; bf16_t* VV; bf16_t* AB; const float* part; const float* bgf; const float* bgb; int h;
    __device__ __forceinline__ void operator()(const f32x4 (&acc)[2][2][4][2], const Unit& u, int wr, int wc, int fr, int fq) const {
#pragma unroll
        for (int ai = 0; ai < 2; ++ai)
#pragma unroll
            for (int m = 0; m < 4; ++m) { const long row = (long)u.pm * 256 + ai * 128 + wr * 64 + m * 16 + fr; const float rs = rstd_of(part, (int)row);
#pragma unroll
                for (int bj = 0; bj < 2; ++bj) { const int col = bj * 128 + wc * 32 + 8 * fq;
                    f32x4 v0 = acc[ai][bj][m][0] * rs, v1 = acc[ai][bj][m][1] * rs;
                    if (u.pn == 1) {
                        const float* bp = (bj == 0 ? bgf : bgb) + h * 128 + wc * 32 + 8 * fq;
                        const f32x4 b0 = *(const f32x4*)bp, b1 = *(const f32x4*)(bp + 4);
#pragma unroll
                        for (int j = 0; j < 4; ++j) { float z = v0[j] + b0[j]; v0[j] = (fminf(z, 0.f) - log1pf(__expf(-fabsf(z)))) * (1.0f / 16.0f);
                                                      z = v1[j] + b1[j]; v1[j] = (fminf(z, 0.f) - log1pf(__expf(-fabsf(z)))) * (1.0f / 16.0f); }
                        float* gp = GG + row * 256 + col; *(f32x4*)gp = v0; *(f32x4*)(gp + 4) = v1;
                    } else {
                        if (u.pn == 3) {
#pragma unroll
                            for (int j = 0; j < 4; ++j) { v0[j] = v0[j] / (1.0f + __expf(-v0[j])); v1[j] = v1[j] / (1.0f + __expf(-v1[j])); } }
                        u32x4 w; w.x = cvt_pk_bf16(v0[0], v0[1]); w.y = cvt_pk_bf16(v0[2], v0[3]); w.z = cvt_pk_bf16(v1[0], v1[1]); w.w = cvt_pk_bf16(v1[2], v1[3]);
                        bf16_t* dst = u.pn == 0 ? QK + row * 256 + col : (u.pn == 2 ? VV + row * 256 + col : AB + row * DM + h * 256 + col);
                        *(u32x4*)dst = w; } } }
    }
};
struct EpiDilQK {
    bf16_t* O; const float* part; int r;
    __device__ __forceinline__ void operator()(const f32x4 (&acc)[2][2][4][2], const Unit& u, int wr, int wc, int fr, int fq) const {
        const int tok0 = dil_token0(u.pm * 256, r);
#pragma unroll
        for (int ai = 0; ai < 2; ++ai)
#pragma unroll
            for (int m = 0; m < 4; ++m) { const int rl = ai * 128 + wr * 64 + m * 16 + fr; const long row = (long)u.pm * 256 + rl; const float rs = rstd_of(part, tok0 + rl * r);
#pragma unroll
                for (int bj = 0; bj < 2; ++bj) { const int col = u.pn * 256 + bj * 128 + wc * 32 + 8 * fq;
                    const f32x4 v0 = acc[ai][bj][m][0] * rs, v1 = acc[ai][bj][m][1] * rs;
                    u32x4 w; w.x = cvt_pk_bf16(v0[0], v0[1]); w.y = cvt_pk_bf16(v0[2], v0[3]); w.z = cvt_pk_bf16(v1[0], v1[1]); w.w = cvt_pk_bf16(v1[2], v1[3]);
                    *(u32x4*)(O + row * 512 + col) = w; }
                asm volatile("" ::: "memory"); }
    }
};
struct EpiDilVT {
    bf16_t* O; const float* part; int r;
    __device__ __forceinline__ void operator()(const f32x4 (&acc)[2][2][4][2], const Unit& u, int wr, int wc, int fr, int fq) const {
        const int tok0 = dil_token0(u.pn * 256, r);
#pragma unroll
        for (int bj = 0; bj < 2; ++bj) { const int cl = bj * 128 + wc * 32 + 8 * fq; float rs[8];
#pragma unroll
            for (int j = 0; j < 8; ++j) { rs[j] = rstd_of(part, tok0 + (cl + j) * r); asm volatile("" : "+v"(rs[j])); }
#pragma unroll
            for (int ai = 0; ai < 2; ++ai)
#pragma unroll
                for (int m = 0; m < 4; ++m) { const int row = ai * 128 + wr * 64 + m * 16 + fr;
                    const f32x4 v0 = acc[ai][bj][m][0], v1 = acc[ai][bj][m][1];
                    u32x4 w; w.x = cvt_pk_bf16(v0[0] * rs[0], v0[1] * rs[1]); w.y = cvt_pk_bf16(v0[2] * rs[2], v0[3] * rs[3]);
                    w.z = cvt_pk_bf16(v1[0] * rs[4], v1[1] * rs[5]); w.w = cvt_pk_bf16(v1[2] * rs[6], v1[3] * rs[7]);
                    *(u32x4*)(O + (long)row * T + u.pn * 256 + cl) = w;
                    asm volatile("" ::: "memory"); } }
    }
};
struct EpiScores {
    bf16_t* P; const float* part; LAS f32x2* xt;
    __device__ __forceinline__ void operator()(const f32x4 (&acc)[2][2][4][2], const Unit& u, int wr, int wc, int fr, int fq) const {
#pragma unroll
        for (int ai = 0; ai < 2; ++ai)
#pragma unroll
            for (int m = 0; m < 4; ++m) { const int rl = ai * 128 + wr * 64 + m * 16 + fr; const float r_ = rstd_of(part, u.pm * 256 + rl);
                float mx = -3.0e38f;
#pragma unroll
                for (int bj = 0; bj < 2; ++bj)
#pragma unroll
                    for (int n = 0; n < 2; ++n)
#pragma unroll
                        for (int j = 0; j < 4; ++j) mx = fmaxf(mx, acc[ai][bj][m][n][j] * r_);
                mx = fmaxf(mx, __shfl_xor(mx, 16)); mx = fmaxf(mx, __shfl_xor(mx, 32));
                float l = 0.f;
#pragma unroll
                for (int bj = 0; bj < 2; ++bj)
#pragma unroll
                    for (int n = 0; n < 2; ++n)
#pragma unroll
                        for (int j = 0; j < 4; ++j) l += __expf(acc[ai][bj][m][n][j] * r_ - mx);
                l += __shfl_xor(l, 16); l += __shfl_xor(l, 32);
                if (fq == 0) xt[rl * 4 + wc] = (f32x2){mx, l};
                asm volatile("" ::: "memory"); }
        LBAR();
#pragma unroll
        for (int ai = 0; ai < 2; ++ai)
#pragma unroll
            for (int m = 0; m < 4; ++m) { const int rl = ai * 128 + wr * 64 + m * 16 + fr; const long row = (long)u.pm * 256 + rl; const float r_ = rstd_of(part, u.pm * 256 + rl);
                const f32x2 a = xt[rl * 4 + 0], b = xt[rl * 4 + 1], c = xt[rl * 4 + 2], d = xt[rl * 4 + 3];
                const float M = fmaxf(fmaxf(a.x, b.x), fmaxf(c.x, d.x));
                const float Ls = a.y * __expf(a.x - M) + b.y * __expf(b.x - M) + c.y * __expf(c.x - M) + d.y * __expf(d.x - M);
                const float inv = 1.0f / Ls;
#pragma unroll
                for (int bj = 0; bj < 2; ++bj) { const int col = u.pn * 256 + bj * 128 + wc * 32 + 8 * fq; float p[8];
#pragma unroll
                    for (int n = 0; n < 2; ++n)
#pragma unroll
                        for (int j = 0; j < 4; ++j) p[n * 4 + j] = __expf(acc[ai][bj][m][n][j] * r_ - M) * inv;
                    u32x4 w; w.x = cvt_pk_bf16(p[0], p[1]); w.y = cvt_pk_bf16(p[2], p[3]); w.z = cvt_pk_bf16(p[4], p[5]); w.w = cvt_pk_bf16(p[6], p[7]);
                    *(u32x4*)(P + row * DM + col) = w; }
                asm volatile("" ::: "memory"); }
    }
};


struct EpiAny {
    int kind;
    long o_off;
    int ldc, bstride; float scale; int h, r;
    __device__ __forceinline__ void operator()(const f32x4 (&acc)[2][2][4][2], const Unit& u, int wr, int wc, int fr, int fq, const Params& p, LAS unsigned char* lds) const {
        unsigned char* ws = p.ws; unsigned char* st = ws + OFF_STAGE; const float* part = (const float*)(ws + OFF_PART);
        if (EN(22) && kind == 0) { EpiPlain e{(bf16_t*)(ws + o_off), ldc, bstride}; e(acc, u, wr, wc, fr, fq); }
        else if (EN(23) && kind == 1) { EpiSwiGLU e{(bf16_t*)(ws + o_off), part}; e(acc, u, wr, wc, fr, fq); }
        else if (EN(24) && kind == 2) { EpiResid e{p.X, (bf16_t*)(ws + OFF_XB), (float*)(ws + OFF_PART), scale, (LAS float*)(lds + LDS_X)}; e(acc, u, wr, wc, fr, fq); }
        else if (EN(25) && kind == 3) { EpiGlaProj e{(bf16_t*)(st + ST_QK), (float*)(st + ST_GG), (bf16_t*)(st + ST_VV), (bf16_t*)(st + ST_ABUF), part, p.in[11], p.in[13], h}; e(acc, u, wr, wc, fr, fq); }
        else if (EN(26) && kind == 4) { EpiDilQK e{(bf16_t*)(ws + o_off), part, r}; e(acc, u, wr, wc, fr, fq); }
        else if (EN(27) && kind == 5) { EpiDilVT e{(bf16_t*)(ws + o_off), part, r}; e(acc, u, wr, wc, fr, fq); }
        else if (EN(28)) { EpiScores e{(bf16_t*)(ws + o_off), part, (LAS f32x2*)(lds + LDS_X)}; e(acc, u, wr, wc, fr, fq); }
    }
};

template <class Epi>
__device__ __forceinline__ void gemm_phase(LAS unsigned char* lds, const int K, const int lda, const int ldb, const Sched& S, const Epi& E) {
    int tid = threadIdx.x; asm volatile("" : "+v"(tid));
    const int wid = __builtin_amdgcn_readfirstlane(tid >> 6), lane = tid & 63, wr = wid >> 2, wc = wid & 3, fr = lane & 15, fq = lane >> 4;
    const int nt = K / BK;
    unsigned voffA[2], voffB[2];
#pragma unroll
    for (int i = 0; i < 2; ++i) { int R, C; stage_rc(tid * 16 + i * 8192, R, C); const int Rb = (R & ~31) + perm32(R & 31);
        voffA[i] = (unsigned)(R * lda + C) * 2u; voffB[i] = (unsigned)(Rb * ldb + C) * 2u; }
    const size_t kstep = (size_t)(BK * 2);
    const size_t hstepA = (size_t)HALF * lda * 2, hstepB = (size_t)HALF * ldb * 2;
    const unsigned ldsw = (unsigned)wid * 1024u;
    const int aoff = lds_byte(wr * 64 + fr, fq * 8), boff = lds_byte(wc * 32 + fr, fq * 8);
#define PG8_SA(b, h) (((b) * 2 + (h)) * HTB)
#define PG8_SB(b, h) ((4 + (b) * 2 + (h)) * HTB)
#define PG8_STAGE(bufoff, gbase, voff) do { _Pragma("unroll") for (int _i = 0; _i < 2; ++_i) \
        __builtin_amdgcn_global_load_lds((const unsigned*)((const char*)(gbase) + (voff)[_i]), (LAS unsigned*)(lds + (bufoff) + ldsw + _i * 8192), 16, 0, 0); } while (0)
#define PG8_LDA(dst, b, h) do { _Pragma("unroll") for (int m = 0; m < 4; ++m) _Pragma("unroll") for (int k = 0; k < 2; ++k) dst[m][k] = *(const LAS bf16x8*)(lds + PG8_SA(b, h) + aoff + m * 2048 + k * 1024); } while (0)
#define PG8_LDB(dst, b, h) do { _Pragma("unroll") for (int n = 0; n < 2; ++n) _Pragma("unroll") for (int k = 0; k < 2; ++k) dst[n][k] = *(const LAS bf16x8*)(lds + PG8_SB(b, h) + boff + n * 2048 + k * 1024); } while (0)
#define PG8_MMA(ai, bj, At, Bt) do { __builtin_amdgcn_s_setprio(1); _Pragma("unroll") for (int m = 0; m < 4; ++m) _Pragma("unroll") for (int n = 0; n < 2; ++n) _Pragma("unroll") for (int k = 0; k < 2; ++k) \
        acc[ai][bj][m][n] = __builtin_amdgcn_mfma_f32_16x16x32_bf16(Bt[n][k], At[m][k], acc[ai][bj][m][n], 0, 0, 0); __builtin_amdgcn_s_setprio(0); } while (0)
#define PG8_WAIT_V(n) asm volatile("s_waitcnt vmcnt(" #n ")" ::: "memory")
#define PG8_WAIT_L(n) asm volatile("s_waitcnt lgkmcnt(" #n ")" ::: "memory")
#define PG8_BAR __builtin_amdgcn_s_barrier()
#define PG8_SCHED __builtin_amdgcn_sched_barrier(0)
    Unit cur, nxt; int ui = 0;
    if (!S.next(0, cur)) return;
    f32x4 acc[2][2][4][2];
#pragma unroll
    for (int a = 0; a < 2; ++a)
#pragma unroll
        for (int b = 0; b < 2; ++b)
#pragma unroll
            for (int m = 0; m < 4; ++m)
#pragma unroll
                for (int n = 0; n < 2; ++n) acc[a][b][m][n] = (f32x4){0.f, 0.f, 0.f, 0.f};
    bf16x8 At[4][2], B0[2][2], B1[2][2];
    const char* cA = cur.a; const char* cB = cur.bt;
    PG8_STAGE(PG8_SB(0, 0), cB, voffB); PG8_STAGE(PG8_SA(0, 0), cA, voffA); PG8_STAGE(PG8_SB(0, 1), cB + hstepB, voffB); PG8_STAGE(PG8_SA(0, 1), cA + hstepA, voffA);
    if (wr == 1) PG8_BAR;
    PG8_WAIT_V(4); PG8_BAR;
    PG8_STAGE(PG8_SB(1, 0), cB + kstep, voffB); PG8_STAGE(PG8_SA(1, 0), cA + kstep, voffA); PG8_STAGE(PG8_SB(1, 1), cB + hstepB + kstep, voffB);
    PG8_WAIT_V(6); PG8_BAR;
    for (;;) {
        const bool has_next = S.next(ui + 1, nxt);
        const char* nA = has_next ? nxt.a : cA; const char* nB = has_next ? nxt.bt : cB;
        for (int t = 0; t < nt; t += 2) {
            const bool last = (t == nt - 2);
            const char* a1 = cA + (size_t)(t + 1) * kstep;
            const char* a2 = last ? nA : cA + (size_t)(t + 2) * kstep; const char* b2 = last ? nB : cB + (size_t)(t + 2) * kstep;
            const char* a3 = a2 + kstep; const char* b3 = b2 + kstep;
            PG8_LDB(B0, 0, 0); PG8_SCHED; PG8_LDA(At, 0, 0); PG8_STAGE(PG8_SA(1, 1), a1 + hstepA, voffA);
            PG8_WAIT_L(8); PG8_BAR; PG8_WAIT_L(0); PG8_MMA(0, 0, At, B0); PG8_BAR; PG8_SCHED;
            PG8_LDB(B1, 0, 1); PG8_STAGE(PG8_SB(0, 0), b2, voffB);
            PG8_BAR; PG8_WAIT_L(0); PG8_MMA(0, 1, At, B1); PG8_BAR;
            PG8_LDA(At, 0, 1); PG8_STAGE(PG8_SA(0, 0), a2, voffA);
            PG8_BAR; PG8_WAIT_L(0); PG8_MMA(1, 0, At, B0); PG8_BAR; PG8_SCHED;
            PG8_STAGE(PG8_SB(0, 1), b2 + hstepB, voffB);
            PG8_WAIT_V(6); PG8_BAR; PG8_MMA(1, 1, At, B1); PG8_BAR;
            PG8_LDB(B0, 1, 0); PG8_SCHED; PG8_LDA(At, 1, 0); PG8_STAGE(PG8_SA(0, 1), a2 + hstepA, voffA);
            PG8_WAIT_L(8); PG8_BAR; PG8_WAIT_L(0); PG8_MMA(0, 0, At, B0); PG8_BAR; PG8_SCHED;
            PG8_LDB(B1, 1, 1); PG8_STAGE(PG8_SB(1, 0), b3, voffB);
            PG8_BAR; PG8_WAIT_L(0); PG8_MMA(0, 1, At, B1); PG8_BAR;
            PG8_LDA(At, 1, 1); PG8_STAGE(PG8_SA(1, 0), a3, voffA);
            PG8_BAR; PG8_WAIT_L(0); PG8_MMA(1, 0, At, B0); PG8_BAR; PG8_SCHED;
            PG8_STAGE(PG8_SB(1, 1), b3 + hstepB, voffB);
            PG8_WAIT_V(6); PG8_BAR; PG8_MMA(1, 1, At, B1); PG8_BAR;
        }
        { int t2 = threadIdx.x; asm volatile("" : "+v"(t2)); const int w2 = __builtin_amdgcn_readfirstlane(t2 >> 6), l2 = t2 & 63;
          E(acc, cur, w2 >> 2, w2 & 3, l2 & 15, l2 >> 4); }
        if (!has_next) break;
#pragma unroll
        for (int a = 0; a < 2; ++a)
#pragma unroll
            for (int b = 0; b < 2; ++b)
#pragma unroll
                for (int m = 0; m < 4; ++m)
#pragma unroll
                    for (int n = 0; n < 2; ++n) acc[a][b][m][n] = (f32x4){0.f, 0.f, 0.f, 0.f};
        cur = nxt; cA = nA; cB = nB; ++ui;
    }
    PG8_WAIT_V(0);
    if (wr == 0) PG8_BAR;
    PG8_BAR;
#undef PG8_SA
#undef PG8_SB
#undef PG8_STAGE
#undef PG8_LDA
#undef PG8_LDB
#undef PG8_MMA
#undef PG8_WAIT_V
#undef PG8_WAIT_L
#undef PG8_BAR
#undef PG8_SCHED
}

__device__ __forceinline__ Sched mk_sched(const void* A, const void* Bt, int M, int N, int lda, int ldb, int rot) {
    Sched s; s.A = (const char*)A; s.Bt = (const char*)Bt; s.a_tile = 256 * lda * 2; s.b_tile = 256 * ldb * 2; s.a_batch = 0; s.b_batch = 0; s.seqB = 0;
    s.nM = M / 256; s.nN = N / 256; s.nB = 1; s.G = gridDim.x; s.c = (int)((blockIdx.x + (unsigned)rot) % gridDim.x); s.mode = 0; s.r = 1; return s;
}


struct GemmJob { int K, lda, ldb; Sched s; EpiAny e; };
__device__ __forceinline__ int rotc(int rot) { return (int)((blockIdx.x + gridDim.x - ((unsigned)rot % gridDim.x)) % gridDim.x); }
__device__ __forceinline__ bool get_job(const Params& p, int op, int arg, int j, GemmJob& J) {
    unsigned char* ws = p.ws; bf16_t* WB = (bf16_t*)ws; bf16_t* XB = (bf16_t*)(ws + OFF_XB); unsigned char* st = ws + OFF_STAGE;
    EpiAny e; e.kind = 0; e.o_off = 0; e.ldc = DM; e.bstride = 0; e.scale = 1.0f; e.h = 0; e.r = 1;
    J.K = DM; J.lda = DM; J.ldb = DM;
    if (op == 1) {
        if (j == 0) { J.s = mk_sched(st + ST_MEMN, WB + E_CKV, 768, 2048, DM, DM, 0); e.o_off = OFF_STAGE + ST_KV; e.ldc = 2048; }
        else if (j == 1) { J.s = mk_sched(XB, WB + E_FFN1_IN, T, 2 * DFF, DM, DM, 0); J.s.c = rotc(24); e.kind = 1; e.o_off = OFF_STAGE + ST_HID; }
        else return false;
    } else if (op == 2) {
        if (j == 0) { J.s = mk_sched(st + ST_HID, WB + E_FFN1_OUT, T, DM, DFF, DFF, 0); J.K = DFF; J.lda = DFF; J.ldb = DFF; e.kind = 2; e.scale = 0.5f; }
        else if (j <= 3) { const int sq = j - 1;
            J.s = mk_sched((const char*)(st + ST_KV) + (size_t)sq * 256 * 2048 * 2, WB + E_CQ, 256, 1024, 2048, DM, 0); J.s.nB = 4; J.s.a_batch = 512; J.s.b_batch = 512; J.s.c = rotc(sq * 16);
            J.K = 256; J.lda = 2048; J.ldb = DM; e.o_off = (E_GT + (size_t)sq * DM * DM) * 2; e.ldc = DM; e.bstride = 256 * DM; }
        else if (j <= 6) { const int sq = j - 4;
            J.s = mk_sched(WB + E_CO, (const char*)(st + ST_KV) + (size_t)sq * 256 * 2048 * 2 + 1024 * 2, 1024, 256, DM, 2048, 0); J.s.nB = 4; J.s.a_batch = 512; J.s.b_batch = 512; J.s.c = rotc(48 + sq * 16);
            J.K = 256; J.lda = DM; J.ldb = 2048; e.o_off = (E_HM + (size_t)sq * DM * DM) * 2; e.ldc = DM; e.bstride = 256; }
        else return false;
    } else if (op == 3) { if (j) return false; J.s = mk_sched(st + ST_ABUF, WB + E_MIX_OUT, T, DM, DM, DM, 0); e.kind = 2; }
    else if (op == 4) { if (j) return false; J.s = mk_sched(XB, WB + E_GT, T, DM, DM, DM, 0); J.s.mode = 1; J.s.seqB = DM * DM * 2; e.kind = 6; e.o_off = OFF_STAGE + ST_ABUF; }
    else if (op == 5) { if (j) return false; J.s = mk_sched(st + ST_ABUF, WB + E_HM, T, DM, DM, DM, 0); J.s.mode = 1; J.s.seqB = DM * DM * 2; e.kind = 2; }
    else if (op == 6) { if (j) return false; J.s = mk_sched(XB, WB + E_FFN2_IN, T, 2 * DFF, DM, DM, 0); e.kind = 1; e.o_off = OFF_STAGE + ST_HID; }
    else if (op == 7) { if (j) return false; J.s = mk_sched(st + ST_HID, WB + E_FFN2_OUT, T, DM, DFF, DFF, 0); J.K = DFF; J.lda = DFF; J.ldb = DFF; e.kind = 2; e.scale = 0.5f; }
    else if (op == 10) { if (j) return false; J.s = mk_sched(XB, WB + E_MIX_IN + (size_t)arg * 1024 * DM, T, 1024, DM, DM, 0); e.kind = 3; e.h = arg; }
    else if (op == 20) { if (j >= 6) return false; const int g = j >> 1, r = g == 0 ? 1 : (g == 1 ? 4 : 16); e.r = r;
        if ((j & 1) == 0) { J.s = mk_sched(XB, WB + E_MIX_IN + (size_t)(arg * 2304 + g * 512) * DM, T, 512, r * DM, DM, 0); J.s.mode = 2; J.s.r = r; J.s.c = rotc(g * 384);
            J.lda = r * DM; e.kind = 4; e.o_off = OFF_STAGE + ST_QKG + (size_t)g * T * 512 * 2; }
        else { J.s = mk_sched(WB + E_MIX_IN + (size_t)(arg * 2304 + 1536 + g * 256) * DM, XB, 256, T, DM, r * DM, 0); J.s.mode = 3; J.s.r = r; J.s.c = rotc(g * 384 + 256);
            J.ldb = r * DM; e.kind = 5; e.o_off = OFF_STAGE + ST_VTG + (size_t)g * 256 * T * 2; } }
    else return false;
    J.e = e; return true;
}

__device__ __forceinline__ void conv_tile(const float* src, int ld_src, int k0, int n0, bf16_t* dst, int ld_dst, int dr0, const float* gain, float scale, LAS float* tile) {
    int tid = threadIdx.x; asm volatile("" : "+v"(tid)); const int tx = tid & 63, ty = tid >> 6;
    for (int i = ty; i < 64; i += 8) { float v = src[(size_t)(k0 + i) * ld_src + n0 + tx] * scale; if (gain) v *= gain[k0 + i]; tile[i * 65 + tx] = v; }
    __syncthreads();
    const int i2 = tid & 31;
    for (int j = tid >> 5; j < 64; j += 16) { const float a = tile[(2 * i2) * 65 + j], b = tile[(2 * i2 + 1) * 65 + j];
        *(unsigned*)(dst + (size_t)(dr0 + j) * ld_dst + k0 + 2 * i2) = cvt_pk_bf16(a, b); }
    __syncthreads();
}
__device__ __forceinline__ int map_row(int kind, int n0, float& scale) {
    scale = 1.0f;
    if (EN(23) && kind == 1) { if (n0 < DFF) return (n0 / 128) * 256 + (n0 % 128); const int j = n0 - DFF; return (j / 128) * 256 + 128 + (j % 128); }
    if (EN(24) && kind == 2) {
        if (n0 < 512) { scale = 0.08838834764831845f; return (n0 / 128) * 1024 + (n0 % 128); }
        if (n0 < 1024) { const int j = n0 - 512; return (j / 128) * 1024 + 128 + (j % 128); }
        if (n0 < 2048) { const int j = n0 - 1024; return (j / 256) * 1024 + 512 + (j % 256); }
        const int j = n0 - 2048; return (j / 256) * 1024 + 768 + (j % 256);
    }
    if (EN(25) && kind == 3) { const int tg = n0 / 1024, h = (n0 % 1024) / 64, t = tg / 3, g = tg % 3, hc = h >> 2, hl = h & 3;
        if (t == 0) scale = 0.125f;
        if (t < 2) return hc * 2304 + g * 512 + t * 256 + hl * 64;
        return hc * 2304 + 1536 + g * 256 + hl * 64; }
    return n0;
}
__device__ void conv_weight(const float* src, int K, int N, int ld_src, bf16_t* dst, const float* gain, int kind, LAS float* tile, int& rot) {
    const int nk = K / 64, nn = N / 64, tot = nk * nn;
    for (int t = (int)((blockIdx.x + gridDim.x - (rot % gridDim.x)) % gridDim.x); t < tot; t += gridDim.x) {
        const int kt = t % nk, ntile = t / nk; float sc; const int dr0 = map_row(kind, ntile * 64, sc);
        conv_tile(src, ld_src, kt * 64, ntile * 64, dst, K, dr0, gain, sc, tile);
    }
    rot += tot;
}
__device__ __forceinline__ const float* x_in_row(const Params& p, int t) { return t < 16384 ? p.in[0] + (size_t)t * DM : p.in[1] + (size_t)(t - 16384) * DM; }

__device__ void phase_prologue(const Params& p, int layer, LAS unsigned char* lds) {
    unsigned char* ws = p.ws; bf16_t* WB = (bf16_t*)ws; LAS float* tile = (LAS float*)lds;
    int tid = threadIdx.x; asm volatile("" : "+v"(tid)); const int lane = tid & 63, wid = tid >> 6, nwv = gridDim.x * 8, gw = blockIdx.x * 8 + wid;
    int rot = 0;
    conv_weight(p.in[6] + (size_t)layer * DM * 2 * DFF, DM, 2 * DFF, 2 * DFF, WB + E_FFN1_IN, p.in[5] + layer * DM, 1, tile, rot);
    conv_weight(p.in[7] + (size_t)layer * DFF * DM, DFF, DM, DM, WB + E_FFN1_OUT, nullptr, 0, tile, rot);
    conv_weight(p.in[24] + (size_t)layer * DM * 2 * DFF, DM, 2 * DFF, 2 * DFF, WB + E_FFN2_IN, p.in[23] + layer * DM, 1, tile, rot);
    conv_weight(p.in[25] + (size_t)layer * DFF * DM, DFF, DM, DM, WB + E_FFN2_OUT, nullptr, 0, tile, rot);
    conv_weight(p.in[21] + (size_t)layer * DM * 2048, DM, 2048, 2048, WB + E_CKV, nullptr, 0, tile, rot);
    conv_weight(p.in[22] + (size_t)layer * DM * DM, DM, DM, DM, WB + E_CO, nullptr, 0, tile, rot);
    if (layer == 0) {
        conv_weight(p.in[9], DM, 3072, 3104, WB + E_MIX_IN, p.in[8], 2, tile, rot);
        conv_weight(p.in[15], DM, DM, DM, WB + E_MIX_OUT, nullptr, 0, tile, rot);
        for (size_t idx = (size_t)blockIdx.x * 512 + tid; idx < (size_t)2 * 512 * 1024; idx += (size_t)gridDim.x * 512) {
            const int c = (int)(idx & 1023), n = (int)((idx >> 10) & 511), dir = (int)(idx >> 19);
            const float* wi = p.in[9] + (size_t)c * 3104 + 3072 + dir * 16; const float* wg = (dir ? p.in[12] : p.in[10]) + n;
            float s = 0.f;
#pragma unroll
            for (int r = 0; r < 16; ++r) s += wi[r] * wg[r * 512];
            s *= p.in[8][c];
            WB[E_MIX_IN + (size_t)((n >> 7) * 1024 + 256 + dir * 128 + (n & 127)) * DM + c] = f2bf(s);
        }
    } else {
        conv_weight(p.in[16], DM, 9216, 9216, WB + E_MIX_IN, p.in[8] + DM, 3, tile, rot);
        conv_weight(p.in[17], DM, DM, DM, WB + E_MIX_OUT, nullptr, 0, tile, rot);
    }
    { const float* src = p.in[20] + (size_t)layer * DM * DM; const float* g = p.in[18] + layer * DM;
      for (size_t idx = ((size_t)blockIdx.x * 512 + tid) * 4; idx < (size_t)DM * DM; idx += (size_t)gridDim.x * 512 * 4) {
          const f32x4 v = *(const f32x4*)(src + idx); const float s = g[idx >> 10] * 0.0625f;
          u32x2 w; w.x = cvt_pk_bf16(v[0] * s, v[1] * s); w.y = cvt_pk_bf16(v[2] * s, v[3] * s);
          *(u32x2*)(WB + E_CQ + idx) = w; } }
    { bf16_t* MEMN = (bf16_t*)(ws + OFF_STAGE + ST_MEMN); const float* g = p.in[19] + layer * DM;
      for (int row = gw; row < 768; row += nwv) {
          const float* src = row < 512 ? p.in[2] + (size_t)row * DM : p.in[3] + (size_t)(row - 512) * DM;
          f32x4 v[4]; float ss = 0.f;
#pragma unroll
          for (int i = 0; i < 4; ++i) { v[i] = *(const f32x4*)(src + i * 256 + lane * 4); ss += (v[i][0] * v[i][0] + v[i][1] * v[i][1]) + (v[i][2] * v[i][2] + v[i][3] * v[i][3]); }
#pragma unroll
          for (int o = 1; o < 64; o <<= 1) ss += __shfl_xor(ss, o);
          const float rs = rsqrtf(ss * (1.0f / 1024.0f) + EPS);
#pragma unroll
          for (int i = 0; i < 4; ++i) { const f32x4 gg = *(const f32x4*)(g + i * 256 + lane * 4);
              u32x2 w; w.x = cvt_pk_bf16(v[i][0] * rs * gg[0], v[i][1] * rs * gg[1]); w.y = cvt_pk_bf16(v[i][2] * rs * gg[2], v[i][3] * rs * gg[3]);
              *(u32x2*)(MEMN + (size_t)row * DM + i * 256 + lane * 4) = w; } } }
    if (layer == 0) {
        bf16_t* XB = (bf16_t*)(ws + OFF_XB); float* part = (float*)(ws + OFF_PART);
        for (int row = gw; row < T; row += nwv) {
            const float* src = x_in_row(p, row); f32x4 v[4]; float ss = 0.f;
#pragma unroll
            for (int i = 0; i < 4; ++i) { v[i] = *(const f32x4*)(src + i * 256 + lane * 4); ss += (v[i][0] * v[i][0] + v[i][1] * v[i][1]) + (v[i][2] * v[i][2] + v[i][3] * v[i][3]); }
#pragma unroll
            for (int o = 1; o < 64; o <<= 1) ss += __shfl_xor(ss, o);
#pragma unroll
            for (int i = 0; i < 4; ++i) { *(f32x4*)(p.X + (size_t)row * DM + i * 256 + lane * 4) = v[i];
                u32x2 w; w.x = cvt_pk_bf16(v[i][0], v[i][1]); w.y = cvt_pk_bf16(v[i][2], v[i][3]);
                *(u32x2*)(XB + (size_t)row * DM + i * 256 + lane * 4) = w; }
            if (lane == 0) *(f32x4*)(part + (size_t)row * 4) = (f32x4){ss, 0.f, 0.f, 0.f};
        }
        float* bt = (float*)(ws + OFF_BTAB);
        for (int idx = blockIdx.x * 512 + tid; idx < 3 * 16 * 129; idx += gridDim.x * 512) {
            const int rel = idx % 129 - 64, h = (idx / 129) % 16, g = idx / (129 * 16); const int r = g == 0 ? 1 : (g == 1 ? 4 : 16);
            const int rr = rel * r, n = rr < 0 ? -rr : rr; int bk;
            if (n < 8) bk = n; else { int lg = 8 + (int)(log((double)n / 8.0) / log(128.0) * 8.0); bk = lg < 15 ? lg : 15; }
            if (rr > 0) bk += 16;
            bt[idx] = p.in[4][bk * 48 + g * 16 + h];
        }
    }
}

__device__ void phase_final(const Params& p) {
    const float* part = (const float*)(p.ws + OFF_PART); const float* g = p.in[26];
    int tid = threadIdx.x; asm volatile("" : "+v"(tid)); const int lane = tid & 63, wid = tid >> 6, nwv = gridDim.x * 8, gw = blockIdx.x * 8 + wid;
    for (int row = gw; row < T; row += nwv) { const float rs = rstd_of(part, row);
#pragma unroll
        for (int i = 0; i < 4; ++i) { float* xp = p.X + (size_t)row * DM + i * 256 + lane * 4; const f32x4 v = *(const f32x4*)xp; const f32x4 gg = *(const f32x4*)(g + i * 256 + lane * 4);
            *(f32x4*)xp = (f32x4){v[0] * rs * gg[0], v[1] * rs * gg[1], v[2] * rs * gg[2], v[3] * rs * gg[3]}; } }
}

__device__ void gla_combine(const Params& p, int h) {
    unsigned char* st = p.ws + OFF_STAGE; const float* OF = (const float*)(st + ST_OF); const float* OB = (const float*)(st + ST_OB); bf16_t* AB = (bf16_t*)(st + ST_ABUF);
    const float* gn = p.in[14] + h * 256;
    int tid = threadIdx.x; asm volatile("" : "+v"(tid)); const int lane = tid & 63, wid = tid >> 6, nwv = gridDim.x * 8, gw = blockIdx.x * 8 + wid;
    const f32x4 gg = *(const f32x4*)(gn + lane * 4);
    for (int row = gw; row < T; row += nwv) {
        const f32x4 a = *(const f32x4*)(OF + (size_t)row * 256 + lane * 4), b = *(const f32x4*)(OB + (size_t)row * 256 + lane * 4);
        const f32x4 o = a + b; float ss = (o[0] * o[0] + o[1] * o[1]) + (o[2] * o[2] + o[3] * o[3]);
#pragma unroll
        for (int s = 1; s < 64; s <<= 1) ss += __shfl_xor(ss, s);
        const float rs = rsqrtf(ss * (1.0f / 256.0f) + EPS);
        bf16_t* ap = AB + (size_t)row * DM + h * 256 + lane * 4; const u32x2 rr = *(const u32x2*)ap;
        const float r0 = __uint_as_float(rr.x << 16), r1 = __uint_as_float(rr.x & 0xffff0000u), r2 = __uint_as_float(rr.y << 16), r3 = __uint_as_float(rr.y & 0xffff0000u);
        u32x2 w; w.x = cvt_pk_bf16(o[0] * rs * gg[0] * r0, o[1] * rs * gg[1] * r1); w.y = cvt_pk_bf16(o[2] * rs * gg[2] * r2, o[3] * rs * gg[3] * r3);
        *(u32x2*)ap = w;
    }
}

constexpr int SC_QP = 0, SC_KP = 17408, SC_KT = 34816, SC_VT = 53248, SC_ATT = 62464, SC_SS = 71680, SC_QS = 89088, SC_BL = 91136;

template <bool OUT>
__device__ void gla_scan(const Params& p, LAS unsigned char* lds) {
    unsigned char* st = p.ws + OFF_STAGE;
    const bf16_t* QK = (const bf16_t*)(st + ST_QK); const float* GG = (const float*)(st + ST_GG); const bf16_t* VV = (const bf16_t*)(st + ST_VV);
    float* SLOC = (float*)(st + ST_SLOC); float* DVEC = (float*)(st + ST_DVEC);
    int tid = threadIdx.x; asm volatile("" : "+v"(tid)); const int lane = tid & 63, w = tid >> 6, l15 = lane & 15, quad = lane >> 4;
    LAS bf16_t* QP = (LAS bf16_t*)(lds + SC_QP); LAS bf16_t* KP = (LAS bf16_t*)(lds + SC_KP); LAS bf16_t* KT = (LAS bf16_t*)(lds + SC_KT);
    LAS bf16_t* VT = (LAS bf16_t*)(lds + SC_VT); LAS bf16_t* ATT = (LAS bf16_t*)(lds + SC_ATT); LAS bf16_t* SS = (LAS bf16_t*)(lds + SC_SS);
    LAS float* QS = (LAS float*)(lds + SC_QS); LAS float* BL = (LAS float*)(lds + SC_BL);
    for (int unit = blockIdx.x; unit < 256; unit += gridDim.x) {
        const int slice = unit & 3, dir = (unit >> 2) & 1, seg = unit >> 3;
        const int sfirst = seg < 8 ? 0 : (seg < 16 ? 8 : 16), nseg = seg < 16 ? 8 : 16;
        const int sigma = dir == 0 ? seg - sfirst : sfirst + nseg - 1 - seg;
        float* oout = (float*)(st + (dir == 0 ? ST_OF : ST_OB));
        f32x4 S[4];
#pragma unroll
        for (int d = 0; d < 4; ++d) S[d] = (f32x4){0.f, 0.f, 0.f, 0.f};
        if (OUT) {
            for (int sp = 0; sp < sigma; ++sp) {
                const int sg = dir == 0 ? sfirst + sp : sfirst + nseg - 1 - sp;
                const float* sl = SLOC + (size_t)(sg * 2 + dir) * 128 * 256; const float* dv = DVEC + (size_t)(sg * 2 + dir) * 128;
#pragma unroll
                for (int r = 0; r < 4; ++r) { const int dk = 16 * w + 4 * quad + r; const float dd = dv[dk];
#pragma unroll
                    for (int d = 0; d < 4; ++d) S[d][r] = S[d][r] * dd + sl[(size_t)dk * 256 + slice * 64 + d * 16 + l15]; }
            }
        }
        float dsum = 0.f;
        const int dkc = tid & 127, qr = tid >> 7;
        const int dvc = tid & 63, jr = tid >> 6;
        for (int ch = 0; ch < 16; ++ch) {
            const int tb = seg * 1024 + (dir == 0 ? ch * 64 : (15 - ch) * 64);
            float g[16]; float q[16], k[16];
#pragma unroll
            for (int ii = 0; ii < 16; ++ii) { const int ip = qr * 16 + ii; const int tok = tb + (dir == 0 ? ip : 63 - ip);
                g[ii] = GG[(size_t)tok * 256 + dir * 128 + dkc];
                if (OUT) q[ii] = bf2f(QK[(size_t)tok * 256 + dkc]);
                k[ii] = bf2f(QK[(size_t)tok * 256 + 128 + dkc]); }
            unsigned vpk[4];
            { float v[8];
#pragma unroll
              for (int jj = 0; jj < 8; ++jj) { const int jp = jr * 8 + jj; const int tok = tb + (dir == 0 ? jp : 63 - jp); v[jj] = bf2f(VV[(size_t)tok * 256 + slice * 64 + dvc]); }
#pragma unroll
              for (int jj = 0; jj < 4; ++jj) vpk[jj] = cvt_pk_bf16(v[2 * jj], v[2 * jj + 1]); }
#pragma unroll
            for (int ii = 1; ii < 16; ++ii) g[ii] += g[ii - 1];
            QS[qr * 128 + dkc] = g[15];
            *(LAS u32x4*)(VT + dvc * 72 + jr * 8) = (u32x4){vpk[0], vpk[1], vpk[2], vpk[3]};
            __syncthreads();
            float off = 0.f, tot = 0.f;
#pragma unroll
            for (int qq = 0; qq < 4; ++qq) { const float s = QS[qq * 128 + dkc]; tot += s; if (qq < qr) off += s; }
            if (qr == 0) { BL[dkc] = __expf(tot); dsum += tot; }
            unsigned kt[8];
#pragma unroll
            for (int ii = 0; ii < 16; ii += 2) {
                const float b0 = off + g[ii], b1 = off + g[ii + 1];
                if (OUT) { const int ip = qr * 16 + ii;
                    QP[ip * 136 + dkc] = f2bf(q[ii] * __expf(b0)); QP[(ip + 1) * 136 + dkc] = f2bf(q[ii + 1] * __expf(b1));
                    KP[ip * 136 + dkc] = f2bf(k[ii] * __expf(-b0)); KP[(ip + 1) * 136 + dkc] = f2bf(k[ii + 1] * __expf(-b1)); }
                kt[ii >> 1] = cvt_pk_bf16(k[ii] * __expf(tot - b0), k[ii + 1] * __expf(tot - b1));
            }
            *(LAS u32x4*)(KT + dkc * 72 + qr * 16) = (u32x4){kt[0], kt[1], kt[2], kt[3]};
            *(LAS u32x4*)(KT + dkc * 72 + qr * 16 + 8) = (u32x4){kt[4], kt[5], kt[6], kt[7]};
            if (OUT) {
#pragma unroll
                for (int d = 0; d < 4; ++d) { u32x2 sw; sw.x = cvt_pk_bf16(S[d][0], S[d][1]); sw.y = cvt_pk_bf16(S[d][2], S[d][3]);
                    *(LAS u32x2*)(SS + (d * 16 + l15) * 136 + 16 * w + 4 * quad) = sw; }
            }
            __syncthreads();
            f32x4 O[2];
            if (OUT) {
                const int it = w >> 1, c0 = (w & 1) * 2;
                f32x4 at[2] = {(f32x4){0.f, 0.f, 0.f, 0.f}, (f32x4){0.f, 0.f, 0.f, 0.f}};
                O[0] = (f32x4){0.f, 0.f, 0.f, 0.f}; O[1] = (f32x4){0.f, 0.f, 0.f, 0.f};
#pragma unroll
                for (int kk = 0; kk < 4; ++kk) {
                    const bf16x8 af = *(const LAS bf16x8*)(QP + (it * 16 + l15) * 136 + kk * 32 + quad * 8);
#pragma unroll
                    for (int x = 0; x < 2; ++x) {
                        const bf16x8 kf = *(const LAS bf16x8*)(KP + ((c0 + x) * 16 + l15) * 136 + kk * 32 + quad * 8);
                        at[x] = __builtin_amdgcn_mfma_f32_16x16x32_bf16(af, kf, at[x], 0, 0, 0);
                        const bf16x8 sf = *(const LAS bf16x8*)(SS + ((c0 + x) * 16 + l15) * 136 + kk * 32 + quad * 8);
                        O[x] = __builtin_amdgcn_mfma_f32_16x16x32_bf16(af, sf, O[x], 0, 0, 0);
                    }
                }
#pragma unroll
                for (int x = 0; x < 2; ++x)
#pragma unroll
                    for (int r = 0; r < 4; ++r) { const int i = it * 16 + quad * 4 + r, j = (c0 + x) * 16 + l15;
                        ATT[i * 72 + j] = f2bf(j <= i ? at[x][r] : 0.f); }
            }
            {
#pragma unroll
                for (int r = 0; r < 4; ++r) { const float dd = BL[16 * w + 4 * quad + r];
#pragma unroll
                    for (int d = 0; d < 4; ++d) S[d][r] *= dd; }
#pragma unroll
                for (int kk = 0; kk < 2; ++kk) {
                    const bf16x8 af = *(const LAS bf16x8*)(KT + (16 * w + l15) * 72 + kk * 32 + quad * 8);
#pragma unroll
                    for (int d = 0; d < 4; ++d) { const bf16x8 vf = *(const LAS bf16x8*)(VT + (d * 16 + l15) * 72 + kk * 32 + quad * 8);
                        S[d] = __builtin_amdgcn_mfma_f32_16x16x32_bf16(af, vf, S[d], 0, 0, 0); }
                }
            }
            if (OUT) {
                __syncthreads();
                const int it = w >> 1, c0 = (w & 1) * 2;
#pragma unroll
                for (int kk = 0; kk < 2; ++kk) {
                    const bf16x8 af = *(const LAS bf16x8*)(ATT + (it * 16 + l15) * 72 + kk * 32 + quad * 8);
#pragma unroll
                    for (int x = 0; x < 2; ++x) { const bf16x8 vf = *(const LAS bf16x8*)(VT + ((c0 + x) * 16 + l15) * 72 + kk * 32 + quad * 8);
                        O[x] = __builtin_amdgcn_mfma_f32_16x16x32_bf16(af, vf, O[x], 0, 0, 0); }
                }
#pragma unroll
                for (int x = 0; x < 2; ++x)
#pragma unroll
                    for (int r = 0; r < 4; ++r) { const int ip = it * 16 + quad * 4 + r; const int tok = tb + (dir == 0 ? ip : 63 - ip);
                        oout[(size_t)tok * 256 + slice * 64 + (c0 + x) * 16 + l15] = O[x][r]; }
            }
            __syncthreads();
        }
        if (!OUT) {
            float* sl = SLOC + (size_t)(seg * 2 + dir) * 128 * 256;
#pragma unroll
            for (int r = 0; r < 4; ++r) { const int dk = 16 * w + 4 * quad + r;
#pragma unroll
                for (int d = 0; d < 4; ++d) sl[(size_t)dk * 256 + slice * 64 + d * 16 + l15] = S[d][r]; }
            if (slice == 0 && tid < 128) DVEC[(size_t)(seg * 2 + dir) * 128 + tid] = __expf(dsum);
        }
    }
}

__device__ void dil_attn(const Params& p, int hc, LAS unsigned char* lds) {
    unsigned char* st = p.ws + OFF_STAGE; bf16_t* AB = (bf16_t*)(st + ST_ABUF); const float* btab = (const float*)(p.ws + OFF_BTAB);
    LAS float* OST = (LAS float*)lds; LAS float* MST = (LAS float*)(lds + 69632); LAS float* LST = (LAS float*)(lds + 70656);
    int tid = threadIdx.x; asm volatile("" : "+v"(tid)); const int lane = tid & 63, w = tid >> 6, l15 = lane & 15, quad = lane >> 4;
    for (int unit = blockIdx.x; unit < 512; unit += gridDim.x) {
        const int hl = unit & 3, tbk = unit >> 2, t0 = tbk * 256;
        const int sb = t0 < 8192 ? 0 : (t0 < 16384 ? 8192 : 16384), Sq = t0 < 16384 ? 8192 : 16384;
        const int h = hc * 4 + hl;
#pragma unroll 1
        for (int g = 0; g < 3; ++g) {
            const int r = g == 0 ? 1 : (g == 1 ? 4 : 16), L = Sq / r;
            const bf16_t* QKg = (const bf16_t*)(st + ST_QKG) + (size_t)g * T * 512; const bf16_t* VTg = (const bf16_t*)(st + ST_VTG) + (size_t)g * 256 * T;
            const float* bt = btab + (g * 16 + h) * 129;
#pragma unroll 1
            for (int itx = 0; itx < 2; ++itx) {
                const int item = 2 * w + itx;
                int c, l0;
                if (g == 0) { c = 0; l0 = (t0 - sb) + 16 * item; } else if (g == 1) { c = item & 3; l0 = (t0 - sb) / 4 + 16 * (item >> 2); } else { c = item; l0 = (t0 - sb) / 16; }
                const int nq0 = sb + c * L + l0;
                const int tokl = (l0 + l15) * r + c - (t0 - sb);
                bf16x8 qf[2];
#pragma unroll
                for (int kk = 0; kk < 2; ++kk) qf[kk] = *(const bf16x8*)(QKg + (size_t)(nq0 + l15) * 512 + hl * 64 + kk * 32 + quad * 8);
                f32x4 sT[10];
#pragma unroll
                for (int kt = 0; kt < 10; ++kt) {
                    const int lk0 = l0 - 64 + 16 * kt; const bool inr = (lk0 >= 0) && (lk0 < L);
                    int nk = sb + c * L + lk0; nk = inr ? nk : nq0;
                    f32x4 a = (f32x4){0.f, 0.f, 0.f, 0.f};
#pragma unroll
                    for (int kk = 0; kk < 2; ++kk) { const bf16x8 kf = *(const bf16x8*)(QKg + (size_t)(nk + l15) * 512 + 256 + hl * 64 + kk * 32 + quad * 8);
                        a = __builtin_amdgcn_mfma_f32_16x16x32_bf16(kf, qf[kk], a, 0, 0, 0); }
#pragma unroll
                    for (int rr = 0; rr < 4; ++rr) { const int rel = -64 + 16 * kt + quad * 4 + rr - l15; const bool ok = inr && rel >= -64 && rel <= 64;
                        const int ri = rel < -64 ? 0 : (rel > 64 ? 128 : rel + 64);
                        a[rr] = ok ? a[rr] + bt[ri] : -1.0e30f; }
                    sT[kt] = a;
                }
                float mo = -1.0e30f, lo = 0.f;
                f32x4 O[4];
#pragma unroll
                for (int d = 0; d < 4; ++d) O[d] = (f32x4){0.f, 0.f, 0.f, 0.f};
                if (g > 0) { mo = MST[tokl]; lo = LST[tokl];
#pragma unroll
                    for (int d = 0; d < 4; ++d) O[d] = *(const LAS f32x4*)(OST + tokl * 68 + d * 16 + quad * 4); }
                float mx = mo;
#pragma unroll
                for (int kt = 0; kt < 10; ++kt)
#pragma unroll
                    for (int rr = 0; rr < 4; ++rr) mx = fmaxf(mx, sT[kt][rr]);
                mx = fmaxf(mx, __shfl_xor(mx, 16)); mx = fmaxf(mx, __shfl_xor(mx, 32));
                const float alpha = __expf(mo - mx);
                float ls = 0.f;
#pragma unroll
                for (int kt = 0; kt < 10; ++kt)
#pragma unroll
                    for (int rr = 0; rr < 4; ++rr) { const float e = __expf(sT[kt][rr] - mx); sT[kt][rr] = e; ls += e; }
                ls += __shfl_xor(ls, 16); ls += __shfl_xor(ls, 32);
                const float ln = lo * alpha + ls;
#pragma unroll
                for (int d = 0; d < 4; ++d) O[d] *= alpha;
#pragma unroll
                for (int kp = 0; kp < 5; ++kp) {
                    const int lka = l0 - 64 + 32 * kp, lkb = lka + 16;
                    const int na = (lka >= 0 && lka < L) ? sb + c * L + lka : nq0, nb = (lkb >= 0 && lkb < L) ? sb + c * L + lkb : nq0;
                    bf16x8 pf; { const unsigned p0 = cvt_pk_bf16(sT[2 * kp][0], sT[2 * kp][1]), p1 = cvt_pk_bf16(sT[2 * kp][2], sT[2 * kp][3]),
                                                p2 = cvt_pk_bf16(sT[2 * kp + 1][0], sT[2 * kp + 1][1]), p3 = cvt_pk_bf16(sT[2 * kp + 1][2], sT[2 * kp + 1][3]);
                                 u32x4 pw = (u32x4){p0, p1, p2, p3}; pf = __builtin_bit_cast(bf16x8, pw); }
#pragma unroll
                    for (int d = 0; d < 4; ++d) {
                        const bf16_t* vrow = VTg + (size_t)(hl * 64 + d * 16 + l15) * T;
                        const u32x2 va = *(const u32x2*)(vrow + na + quad * 4), vb = *(const u32x2*)(vrow + nb + quad * 4);
                        u32x4 vw = (u32x4){va.x, va.y, vb.x, vb.y}; const bf16x8 vf = __builtin_bit_cast(bf16x8, vw);
                        O[d] = __builtin_amdgcn_mfma_f32_16x16x32_bf16(vf, pf, O[d], 0, 0, 0);
                    }
                }
                if (g < 2) {
                    if (quad == 0) { MST[tokl] = mx; LST[tokl] = ln; }
#pragma unroll
                    for (int d = 0; d < 4; ++d) *(LAS f32x4*)(OST + tokl * 68 + d * 16 + quad * 4) = O[d];
                } else {
                    const float inv = 1.0f / ln;
#pragma unroll
                    for (int d = 0; d < 4; ++d) { u32x2 ow; ow.x = cvt_pk_bf16(O[d][0] * inv, O[d][1] * inv); ow.y = cvt_pk_bf16(O[d][2] * inv, O[d][3] * inv);
                        *(u32x2*)(AB + (size_t)(t0 + tokl) * DM + h * 64 + d * 16 + quad * 4) = ow; }
                }
            }
            __syncthreads();
        }
    }
}

__global__ void __launch_bounds__(512, 2) fwd_megakernel(Params p) {
    extern __shared__ __attribute__((aligned(16))) unsigned char smem[];
    LAS unsigned char* lds = (LAS unsigned char*)smem;
    cg::grid_group grid = cg::this_grid();
    unsigned char* ws = p.ws; bf16_t* WB = (bf16_t*)ws; bf16_t* XB = (bf16_t*)(ws + OFF_XB); float* part = (float*)(ws + OFF_PART);
    unsigned char* st = ws + OFF_STAGE;
    for (int ph = p.ph_lo; ph < p.ph_hi; ++ph) {
        if (ph > p.ph_lo) grid.sync();
        if (ph == 37) { phase_final(p); continue; }
        const int layer = ph >= 21 ? 1 : 0, q = ph - layer * 21;
        int op = -1, arg = 0;
        if (q == 0) op = 0; else if (q == 1) op = 1; else if (q == 2) op = 2;
        else if (layer == 0) {
            if (q <= 14) { const int hh = (q - 3) / 3, s = (q - 3) % 3; arg = hh; op = 10 + s; }
            else if (q == 15) { op = 13; arg = 3; } else op = q - 16 + 3;
        } else {
            if (q <= 10) { arg = (q - 3) >> 1; op = 20 + ((q - 3) & 1); } else op = q - 11 + 3;
        }
        if (op == 0) { if (EN(0)) phase_prologue(p, layer, lds); }
        else if (op == 11) { if (EN(11)) gla_scan<false>(p, lds); }
        else if (op == 12) { if (EN(12)) gla_scan<true>(p, lds); }
        else if (op == 13) { if (EN(13)) gla_combine(p, arg); }
        else if (op == 21) { if (EN(21)) dil_attn(p, arg, lds); }
        else if (EN(1)) {
            if (op == 10 && arg > 0) gla_combine(p, arg - 1);
            GemmJob J;
            for (int j = 0; j < 8; ++j) { if (!get_job(p, op, arg, j, J)) break;
                const float* part = (const float*)(ws + OFF_PART); const int kind = J.e.kind;
                if (EN(22) && kind == 0) { EpiPlain e{(bf16_t*)(ws + J.e.o_off), J.e.ldc, J.e.bstride}; gemm_phase(lds, J.K, J.lda, J.ldb, J.s, e); }
                else if (EN(23) && kind == 1) { EpiSwiGLU e{(bf16_t*)(ws + J.e.o_off), part}; gemm_phase(lds, DM, DM, DM, J.s, e); }
                else if (EN(24) && kind == 2) { EpiResid e{p.X, XB, (float*)(ws + OFF_PART), J.e.scale, (LAS float*)(lds + LDS_X)}; gemm_phase(lds, J.K, J.K, J.K, J.s, e); }
                else if (EN(25) && kind == 3) { EpiGlaProj e{(bf16_t*)(st + ST_QK), (float*)(st + ST_GG), (bf16_t*)(st + ST_VV), (bf16_t*)(st + ST_ABUF), part, p.in[11], p.in[13], J.e.h}; gemm_phase(lds, DM, DM, DM, J.s, e); }
                else if (EN(26) && kind == 4) { EpiDilQK e{(bf16_t*)(ws + J.e.o_off), part, J.e.r}; gemm_phase(lds, DM, J.lda, DM, J.s, e); }
                else if (EN(27) && kind == 5) { EpiDilVT e{(bf16_t*)(ws + J.e.o_off), part, J.e.r}; gemm_phase(lds, DM, DM, J.ldb, J.s, e); }
                else if (EN(28) && kind == 6) { EpiScores e{(bf16_t*)(ws + J.e.o_off), part, (LAS f32x2*)(lds + LDS_X)}; gemm_phase(lds, DM, DM, DM, J.s, e); }
            }
        }
        __syncthreads();
    }
}

extern "C" void kernel_launch(void* const* d_in, const int* in_sizes, int n_in, void* d_out, int out_size, void* d_ws, size_t ws_size, hipStream_t stream) {
    static int grid_blocks = 0;
    if (!grid_blocks) {
        int dev = 0, cus = 0, per_cu = 0;
        hipGetDevice(&dev);
        hipDeviceGetAttribute(&cus, hipDeviceAttributeMultiprocessorCount, dev);
        hipFuncSetAttribute((const void*)fwd_megakernel, hipFuncAttributeMaxDynamicSharedMemorySize, LDS_BYTES);
        hipOccupancyMaxActiveBlocksPerMultiprocessor(&per_cu, fwd_megakernel, 512, LDS_BYTES);
        if (per_cu < 1) per_cu = 1;
        if (per_cu > 1) per_cu = 1;
        grid_blocks = cus * per_cu;
    }
    if (n_in != 27 || ws_size < WS_NEED) { fprintf(stderr, "kernel_launch: unexpected n_in %d / ws_size %zu (need %zu)\n", n_in, ws_size, (size_t)WS_NEED); return; }
    Params p{};
    for (int i = 0; i < 27; ++i) p.in[i] = (const float*)d_in[i];
    p.X = (float*)d_out; p.ws = (unsigned char*)d_ws; p.ph_lo = 0; p.ph_hi = 38;
    void* args[] = {&p};
    hipError_t e = hipLaunchCooperativeKernel((const void*)fwd_megakernel, dim3(grid_blocks), dim3(512), args, LDS_BYTES, stream);
    if (e != hipSuccess) fprintf(stderr, "cooperative launch failed: %s (grid %d)\n", hipGetErrorString(e), grid_blocks);
}
```

```cpp
#include <hip/hip_runtime.h>
#include <hip/hip_cooperative_groups.h>
#include <cstdio>
#include <cstdint>
namespace cg = cooperative_groups;

#define LAS __attribute__((address_space(3)))
typedef unsigned short bf16_t;
typedef short bf16x8 __attribute__((ext_vector_type(8)));
typedef short bf16x4 __attribute__((ext_vector_type(4)));
typedef float f32x4 __attribute__((ext_vector_type(4)));
typedef float f32x2 __attribute__((ext_vector_type(2)));
typedef unsigned u32x4 __attribute__((ext_vector_type(4)));
typedef unsigned u32x2 __attribute__((ext_vector_type(2)));

#ifndef OPMASK
#define OPMASK 0xFFFFFFFFu
#endif
#define EN(o) ((OPMASK >> (o)) & 1u)
#ifndef PROBE_REP
#define PROBE_REP 0u
#endif
#ifndef PROBE_SYNC
#define PROBE_SYNC 0
#endif
constexpr int T = 32768, DM = 1024, DFF = 2816;
constexpr float EPS = 1e-6f;
constexpr int BM = 256, BK = 64, HALF = 128, HTB = HALF * BK * 2, STAGE_BYTES = 8 * HTB, NXCD = 8, WGM = 8;
constexpr int LDS_X = STAGE_BYTES;
constexpr int LDS_CTL = STAGE_BYTES + 8192;
constexpr int LDS_BYTES = STAGE_BYTES + 8192 + 64;

constexpr size_t E_FFN1_IN = 0, E_FFN1_OUT = 5767168, E_FFN2_IN = 8650752, E_FFN2_OUT = 14417920, E_CQ = 17301504, E_CKV = 18350080,
                 E_CO = 20447232, E_MIX_IN = 21495808, E_MIX_OUT = 30932992, E_GT = 31981568, E_HM = 35127296, E_WEND = 38273024;
constexpr size_t OFF_XB = E_WEND * 2, OFF_PART = OFF_XB + (size_t)T * DM * 2, OFF_BTAB = OFF_PART + (size_t)T * 16, OFF_STAGE = OFF_BTAB + 32768;
constexpr size_t ST_HID = 0, ST_MEMN = 184549376, ST_KV = 186122240;
constexpr size_t ST_ABUF = 0, ST_QK = 67108864, ST_GG = 83886080, ST_VV = 117440512, ST_OF = 134217728, ST_OB = 167772160, ST_SLOC = 201326592, ST_DVEC = 209715200;
constexpr size_t ST_QKG = 67108864, ST_VTG = 167772160;
constexpr size_t OFF_CTL = OFF_STAGE + 218103808;
constexpr size_t CTL_BYTES = 16384;
constexpr size_t WS_NEED = OFF_CTL + CTL_BYTES;

struct Params {
    const float* in[27];
    float* X;
    unsigned char* ws;
    int ph_lo, ph_hi;
};

__device__ __forceinline__ unsigned cvt_pk_bf16(float lo, float hi) { unsigned r; asm volatile("v_cvt_pk_bf16_f32 %0, %1, %2" : "=v"(r) : "v"(lo), "v"(hi)); return r; }
__device__ __forceinline__ float bf2f(bf16_t b) { return __uint_as_float(((unsigned)b) << 16); }
__device__ __forceinline__ bf16_t f2bf(float f) { return (bf16_t)(cvt_pk_bf16(f, 0.f) & 0xffffu); }

__host__ __device__ __forceinline__ int lds_byte(int r, int c) { const int st = (r >> 4) * 2 + (c >> 5), rr = r & 15, cc = c & 31, ob = rr * 64 + cc * 2; return st * 1024 + (ob ^ (((ob >> 9) & 1) << 5)); }
__host__ __device__ __forceinline__ void stage_rc(int b, int& R, int& C) { const int st = b / 1024, sb = b % 1024, swz = sb ^ (((sb >> 9) & 1) << 5); R = (st >> 1) * 16 + swz / 64; C = (st & 1) * 32 + (swz % 64) / 2; }
__host__ __device__ __forceinline__ int perm32(int rho) { const int n = rho >> 4, i = rho & 15; return 8 * (i >> 2) + 4 * n + (i & 3); }

struct Unit { int pm, pn, b; const char* a; const char* bt; };

__device__ __forceinline__ int dil_token0(int n0, int r) {
    const int sb = n0 < 8192 ? 0 : (n0 < 16384 ? 8192 : 16384), S = n0 < 16384 ? 8192 : 16384, L = S / r;
    const int c = (n0 - sb) / L, l0 = (n0 - sb) % L;
    return sb + l0 * r + c;
}

struct Sched {
    const char* A; const char* Bt;
    int a_tile, b_tile, a_batch, b_batch, seqB;
    int nM, nN, nB, G, c, mode, r;
    __device__ __forceinline__ bool next(int i, Unit& u) const {
        const int per = nM * nN; const long tot = (long)per * nB;
        const long L = (long)i * G + c; if (L >= tot) return false;
        int b = (int)(L / per); int wgid = (int)(L % per);
        { const int q = per / NXCD, rr = per % NXCD, xcd = wgid % NXCD, off = wgid / NXCD; wgid = (xcd < rr ? xcd * (q + 1) : rr * (q + 1) + (xcd - rr) * q) + off; }
        const int nig = WGM * nN, gid = wgid / nig, fm = gid * WGM, gsz = (nM - fm) < WGM ? (nM - fm) : WGM;
        u.pm = fm + ((wgid % nig) % gsz); u.pn = (wgid % nig) / gsz; u.b = b;
        const char* a = A + (long)b * a_batch; const char* bt = Bt + (long)b * b_batch;
        if (mode == 2) a += (long)dil_token0(u.pm * 256, r) * (DM * 2); else a += (long)u.pm * a_tile;
        if (mode == 3) bt += (long)dil_token0(u.pn * 256, r) * (DM * 2); else bt += (long)u.pn * b_tile;
        if (mode == 1) { const int s = u.pm < 32 ? 0 : (u.pm < 64 ? 1 : 2); bt += (long)s * seqB; }
        u.a = a; u.bt = bt; return true;
    }
};


typedef unsigned long long u64_t;
__device__ __forceinline__ float ldsys_f(const float* p) { return __hip_atomic_load(p, __ATOMIC_RELAXED, __HIP_MEMORY_SCOPE_SYSTEM); }
__device__ __forceinline__ bf16_t ldsys_h(const bf16_t* p) { return __hip_atomic_load(p, __ATOMIC_RELAXED, __HIP_MEMORY_SCOPE_SYSTEM); }
__device__ __forceinline__ u32x2 ld_sys8(const void* p) {
    const u64_t a = __hip_atomic_load((const u64_t*)p, __ATOMIC_RELAXED, __HIP_MEMORY_SCOPE_SYSTEM); return (u32x2){(unsigned)a, (unsigned)(a >> 32)};
}
__device__ __forceinline__ u32x4 ld_sys16u(const void* p) {
    const u64_t* q = (const u64_t*)p;
    const u64_t a = __hip_atomic_load(q, __ATOMIC_RELAXED, __HIP_MEMORY_SCOPE_SYSTEM), b = __hip_atomic_load(q + 1, __ATOMIC_RELAXED, __HIP_MEMORY_SCOPE_SYSTEM);
    return (u32x4){(unsigned)a, (unsigned)(a >> 32), (unsigned)b, (unsigned)(b >> 32)};
}
__device__ __forceinline__ bf16x8 ld_sys16(const void* p) { return __builtin_bit_cast(bf16x8, ld_sys16u(p)); }
__device__ __forceinline__ f32x4 ld_sys16f(const void* p) { return __builtin_bit_cast(f32x4, ld_sys16u(p)); }

__device__ __forceinline__ float rstd_of(const float* part, int row) {
    const f32x4 p = ld_sys16f(part + (size_t)row * 4);
    return rsqrtf(((p[0] + p[1]) + (p[2] + p[3])) * (1.0f / 1024.0f) + EPS);
}

#define LBAR() do { asm volatile("s_waitcnt lgkmcnt(0)" ::: "memory"); __builtin_amdgcn_s_barrier(); asm volatile("" ::: "memory"); } while (0)

struct EpiPlain {
    bf16_t* O; int ldc; int bstride;
    __device__ __forceinline__ void operator()(const f32x4 (&acc)[2][2][4][2], const Unit& u, int wr, int wc, int fr, int fq) const {
        bf16_t* base = O + (long)u.b * bstride;
#pragma unroll
        for (int ai = 0; ai < 2; ++ai)
#pragma unroll
            for (int m = 0; m < 4; ++m) { const int row = u.pm * 256 + ai * 128 + wr * 64 + m * 16 + fr;
#pragma unroll
                for (int bj = 0; bj < 2; ++bj) { const int col = u.pn * 256 + bj * 128 + wc * 32 + 8 * fq;
                    const f32x4 v0 = acc[ai][bj][m][0], v1 = acc[ai][bj][m][1];
                    u32x4 w; w.x = cvt_pk_bf16(v0[0], v0[1]); w.y = cvt_pk_bf16(v0[2], v0[3]); w.z = cvt_pk_bf16(v1[0], v1[1]); w.w = cvt_pk_bf16(v1[2], v1[3]);
                    *(u32x4*)(base + (long)row * ldc + col) = w; } }
    }
};
struct EpiSwiGLU {
    bf16_t* H; const float* part;
    __device__ __forceinline__ void operator()(const f32x4 (&acc)[2][2][4][2], const Unit& u, int wr, int wc, int fr, int fq) const {
#pragma unroll
        for (int ai = 0; ai < 2; ++ai)
#pragma unroll
            for (int m = 0; m < 4; ++m) { const int row = u.pm * 256 + ai * 128 + wr * 64 + m * 16 + fr; const float rs = rstd_of(part, row);
                float h[8];
#pragma unroll
                for (int n = 0; n < 2; ++n)
#pragma unroll
                    for (int j = 0; j < 4; ++j) { const float a = acc[ai][0][m][n][j] * rs, b = acc[ai][1][m][n][j] * rs; h[n * 4 + j] = a * b / (1.0f + __expf(-a)); }
                u32x4 w; w.x = cvt_pk_bf16(h[0], h[1]); w.y = cvt_pk_bf16(h[2], h[3]); w.z = cvt_pk_bf16(h[4], h[5]); w.w = cvt_pk_bf16(h[6], h[7]);
                *(u32x4*)(H + (long)row * DFF + u.pn * 128 + wc * 32 + 8 * fq) = w; }
    }
};
struct EpiResid {
    float* X; bf16_t* XB; float* part; float scale; LAS float* xt;
    __device__ __forceinline__ void operator()(const f32x4 (&acc)[2][2][4][2], const Unit& u, int wr, int wc, int fr, int fq) const {
#pragma unroll
        for (int ai = 0; ai < 2; ++ai)
#pragma unroll
            for (int m = 0; m < 4; ++m) { const int rl = ai * 128 + wr * 64 + m * 16 + fr; const long row = (long)u.pm * 256 + rl; float ss = 0.f;
#pragma unroll
                for (int bj = 0; bj < 2; ++bj) { const int col = u.pn * 256 + bj * 128 + wc * 32 + 8 * fq;
                    float* xp = X + row * DM + col;
                    f32x4 x0 = *(const f32x4*)xp, x1 = *(const f32x4*)(xp + 4);
                    x0 += acc[ai][bj][m][0] * scale; x1 += acc[ai][bj][m][1] * scale;
                    *(f32x4*)xp = x0; *(f32x4*)(xp + 4) = x1;
                    u32x4 w; w.x = cvt_pk_bf16(x0[0], x0[1]); w.y = cvt_pk_bf16(x0[2], x0[3]); w.z = cvt_pk_bf16(x1[0], x1[1]); w.w = cvt_pk_bf16(x1[2], x1[3]);
                    *(u32x4*)(XB + row * DM + col) = w;
                    ss += (x0[0] * x0[0] + x0[1] * x0[1]) + (x0[2] * x0[2] + x0[3] * x0[3]) + (x1[0] * x1[0] + x1[1] * x1[1]) + (x1[2] * x1[2] + x1[3] * x1[3]); }
                ss += __shfl_xor(ss, 16); ss += __shfl_xor(ss, 32);
                if (fq == 0) xt[rl * 4 + wc] = ss;
                asm volatile("" ::: "memory"); }
        LBAR();
        const int lane = fq * 16 + fr;
        if (lane < 32) { const int q = wc * 32 + lane, rl = (q >> 6) * 128 + wr * 64 + (q & 63);
            const f32x4 s = *(const LAS f32x4*)(xt + rl * 4);
            part[((size_t)u.pm * 256 + rl) * 4 + u.pn] = (s[0] + s[1]) + (s[2] + s[3]); }
    }
};
struct EpiGlaProj {
    bf16_t* QK; float* GG; bf16_t* VV; bf16_t* AB; const float* part; const float* bgf; const float* bgb; int h;
    __device__ __forceinline__ void operator()(const f32x4 (&acc)[2][2][4][2], const Unit& u, int wr, int wc, int fr, int fq) const {
#pragma unroll
        for (int ai = 0; ai < 2; ++ai)
#pragma unroll
            for (int m = 0; m < 4; ++m) { const long row = (long)u.pm * 256 + ai * 128 + wr * 64 + m * 16 + fr; const float rs = rstd_of(part, (int)row);
#pragma unroll
                for (int bj = 0; bj < 2; ++bj) { const int col = bj * 128 + wc * 32 + 8 * fq;
                    f32x4 v0 = acc[ai][bj][m][0] * rs, v1 = acc[ai][bj][m][1] * rs;
                    if (u.pn == 1) {
                        const float* bp = (bj == 0 ? bgf : bgb) + h * 128 + wc * 32 + 8 * fq;
                        const f32x4 b0 = *(const f32x4*)bp, b1 = *(const f32x4*)(bp + 4);
#pragma unroll
                        for (int j = 0; j < 4; ++j) { float z = v0[j] + b0[j]; v0[j] = (fminf(z, 0.f) - log1pf(__expf(-fabsf(z)))) * (1.0f / 16.0f);
                                                      z = v1[j] + b1[j]; v1[j] = (fminf(z, 0.f) - log1pf(__expf(-fabsf(z)))) * (1.0f / 16.0f); }
                        float* gp = GG + row * 256 + col; *(f32x4*)gp = v0; *(f32x4*)(gp + 4) = v1;
                    } else {
                        if (u.pn == 3) {
#pragma unroll
                            for (int j = 0; j < 4; ++j) { v0[j] = v0[j] / (1.0f + __expf(-v0[j])); v1[j] = v1[j] / (1.0f + __expf(-v1[j])); } }
                        u32x4 w; w.x = cvt_pk_bf16(v0[0], v0[1]); w.y = cvt_pk_bf16(v0[2], v0[3]); w.z = cvt_pk_bf16(v1[0], v1[1]); w.w = cvt_pk_bf16(v1[2], v1[3]);
                        bf16_t* dst = u.pn == 0 ? QK + row * 256 + col : (u.pn == 2 ? VV + row * 256 + col : AB + row * DM + h * 256 + col);
                        *(u32x4*)dst = w; } } }
    }
};
struct EpiDilQK {
    bf16_t* O; const float* part; int r;
    __device__ __forceinline__ void operator()(const f32x4 (&acc)[2][2][4][2], const Unit& u, int wr, int wc, int fr, int fq) const {
        const int tok0 = dil_token0(u.pm * 256, r);
#pragma unroll
        for (int ai = 0; ai < 2; ++ai)
#pragma unroll
            for (int m = 0; m < 4; ++m) { const int rl = ai * 128 + wr * 64 + m * 16 + fr; const long row = (long)u.pm * 256 + rl; const float rs = rstd_of(part, tok0 + rl * r);
#pragma unroll
                for (int bj = 0; bj < 2; ++bj) { const int col = u.pn * 256 + bj * 128 + wc * 32 + 8 * fq;
                    const f32x4 v0 = acc[ai][bj][m][0] * rs, v1 = acc[ai][bj][m][1] * rs;
                    u32x4 w; w.x = cvt_pk_bf16(v0[0], v0[1]); w.y = cvt_pk_bf16(v0[2], v0[3]); w.z = cvt_pk_bf16(v1[0], v1[1]); w.w = cvt_pk_bf16(v1[2], v1[3]);
                    *(u32x4*)(O + row * 512 + col) = w; }
                asm volatile("" ::: "memory"); }
    }
};
struct EpiDilVT {
    bf16_t* O; const float* part; int r;
    __device__ __forceinline__ void operator()(const f32x4 (&acc)[2][2][4][2], const Unit& u, int wr, int wc, int fr, int fq) const {
        const int tok0 = dil_token0(u.pn * 256, r);
#pragma unroll
        for (int bj = 0; bj < 2; ++bj) { const int cl = bj * 128 + wc * 32 + 8 * fq; float rs[8];
#pragma unroll
            for (int j = 0; j < 8; ++j) { rs[j] = rstd_of(part, tok0 + (cl + j) * r); asm volatile("" : "+v"(rs[j])); }
#pragma unroll
            for (int ai = 0; ai < 2; ++ai)
#pragma unroll
                for (int m = 0; m < 4; ++m) { const int row = ai * 128 + wr * 64 + m * 16 + fr;
                    const f32x4 v0 = acc[ai][bj][m][0], v1 = acc[ai][bj][m][1];
                    u32x4 w; w.x = cvt_pk_bf16(v0[0] * rs[0], v0[1] * rs[1]); w.y = cvt_pk_bf16(v0[2] * rs[2], v0[3] * rs[3]);
                    w.z = cvt_pk_bf16(v1[0] * rs[4], v1[1] * rs[5]); w.w = cvt_pk_bf16(v1[2] * rs[6], v1[3] * rs[7]);
                    *(u32x4*)(O + (long)row * T + u.pn * 256 + cl) = w;
                    asm volatile("" ::: "memory"); } }
    }
};
struct EpiScores {
    bf16_t* P; const float* part; LAS f32x2* xt;
    __device__ __forceinline__ void operator()(const f32x4 (&acc)[2][2][4][2], const Unit& u, int wr, int wc, int fr, int fq) const {
#pragma unroll
        for (int ai = 0; ai < 2; ++ai)
#pragma unroll
            for (int m = 0; m < 4; ++m) { const int rl = ai * 128 + wr * 64 + m * 16 + fr; const float r_ = rstd_of(part, u.pm * 256 + rl);
                float mx = -3.0e38f;
#pragma unroll
                for (int bj = 0; bj < 2; ++bj)
#pragma unroll
                    for (int n = 0; n < 2; ++n)
#pragma unroll
                        for (int j = 0; j < 4; ++j) mx = fmaxf(mx, acc[ai][bj][m][n][j] * r_);
                mx = fmaxf(mx, __shfl_xor(mx, 16)); mx = fmaxf(mx, __shfl_xor(mx, 32));
                float l = 0.f;
#pragma unroll
                for (int bj = 0; bj < 2; ++bj)
#pragma unroll
                    for (int n = 0; n < 2; ++n)
#pragma unroll
                        for (int j = 0; j < 4; ++j) l += __expf(acc[ai][bj][m][n][j] * r_ - mx);
                l += __shfl_xor(l, 16); l += __shfl_xor(l, 32);
                if (fq == 0) xt[rl * 4 + wc] = (f32x2){mx, l};
                asm volatile("" ::: "memory"); }
        LBAR();
#pragma unroll
        for (int ai = 0; ai < 2; ++ai)
#pragma unroll
            for (int m = 0; m < 4; ++m) { const int rl = ai * 128 + wr * 64 + m * 16 + fr; const long row = (long)u.pm * 256 + rl; const float r_ = rstd_of(part, u.pm * 256 + rl);
                const f32x2 a = xt[rl * 4 + 0], b = xt[rl * 4 + 1], c = xt[rl * 4 + 2], d = xt[rl * 4 + 3];
                const float M = fmaxf(fmaxf(a.x, b.x), fmaxf(c.x, d.x));
                const float Ls = a.y * __expf(a.x - M) + b.y * __expf(b.x - M) + c.y * __expf(c.x - M) + d.y * __expf(d.x - M);
                const float inv = 1.0f / Ls;
#pragma unroll
                for (int bj = 0; bj < 2; ++bj) { const int col = u.pn * 256 + bj * 128 + wc * 32 + 8 * fq; float p[8];
#pragma unroll
                    for (int n = 0; n < 2; ++n)
#pragma unroll
                        for (int j = 0; j < 4; ++j) p[n * 4 + j] = __expf(acc[ai][bj][m][n][j] * r_ - M) * inv;
                    u32x4 w; w.x = cvt_pk_bf16(p[0], p[1]); w.y = cvt_pk_bf16(p[2], p[3]); w.z = cvt_pk_bf16(p[4], p[5]); w.w = cvt_pk_bf16(p[6], p[7]);
                    *(u32x4*)(P + row * DM + col) = w; }
                asm volatile("" ::: "memory"); }
    }
};


struct EpiAny {
    int kind;
    long o_off;
    int ldc, bstride; float scale; int h, r;
    __device__ __forceinline__ void operator()(const f32x4 (&acc)[2][2][4][2], const Unit& u, int wr, int wc, int fr, int fq, const Params& p, LAS unsigned char* lds) const {
        unsigned char* ws = p.ws; unsigned char* st = ws + OFF_STAGE; const float* part = (const float*)(ws + OFF_PART);
        if (EN(22) && kind == 0) { EpiPlain e{(bf16_t*)(ws + o_off), ldc, bstride}; e(acc, u, wr, wc, fr, fq); }
        else if (EN(23) && kind == 1) { EpiSwiGLU e{(bf16_t*)(ws + o_off), part}; e(acc, u, wr, wc, fr, fq); }
        else if (EN(24) && kind == 2) { EpiResid e{p.X, (bf16_t*)(ws + OFF_XB), (float*)(ws + OFF_PART), scale, (LAS float*)(lds + LDS_X)}; e(acc, u, wr, wc, fr, fq); }
        else if (EN(25) && kind == 3) { EpiGlaProj e{(bf16_t*)(st + ST_QK), (float*)(st + ST_GG), (bf16_t*)(st + ST_VV), (bf16_t*)(st + ST_ABUF), part, p.in[11], p.in[13], h}; e(acc, u, wr, wc, fr, fq); }
        else if (EN(26) && kind == 4) { EpiDilQK e{(bf16_t*)(ws + o_off), part, r}; e(acc, u, wr, wc, fr, fq); }
        else if (EN(27) && kind == 5) { EpiDilVT e{(bf16_t*)(ws + o_off), part, r}; e(acc, u, wr, wc, fr, fq); }
        else if (EN(28)) { EpiScores e{(bf16_t*)(ws + o_off), part, (LAS f32x2*)(lds + LDS_X)}; e(acc, u, wr, wc, fr, fq); }
    }
};

template <class Epi>
__device__ __forceinline__ void gemm_phase(LAS unsigned char* lds, const int K, const int lda, const int ldb, const Sched& S, const Epi& E) {
    int tid = threadIdx.x; asm volatile("" : "+v"(tid));
    const int wid = __builtin_amdgcn_readfirstlane(tid >> 6), lane = tid & 63, wr = wid >> 2, wc = wid & 3, fr = lane & 15, fq = lane >> 4;
    const int nt = K / BK;
    unsigned voffA[2], voffB[2];
#pragma unroll
    for (int i = 0; i < 2; ++i) { int R, C; stage_rc(tid * 16 + i * 8192, R, C); const int Rb = (R & ~31) + perm32(R & 31);
        voffA[i] = (unsigned)(R * lda + C) * 2u; voffB[i] = (unsigned)(Rb * ldb + C) * 2u; }
    const size_t kstep = (size_t)(BK * 2);
    const size_t hstepA = (size_t)HALF * lda * 2, hstepB = (size_t)HALF * ldb * 2;
    const unsigned ldsw = (unsigned)wid * 1024u;
    const int aoff = lds_byte(wr * 64 + fr, fq * 8), boff = lds_byte(wc * 32 + fr, fq * 8);
#define PG8_SA(b, h) (((b) * 2 + (h)) * HTB)
#define PG8_SB(b, h) ((4 + (b) * 2 + (h)) * HTB)
#define PG8_STAGE(bufoff, gbase, voff) do { _Pragma("unroll") for (int _i = 0; _i < 2; ++_i) \
        __builtin_amdgcn_global_load_lds((const unsigned*)((const char*)(gbase) + (voff)[_i]), (LAS unsigned*)(lds + (bufoff) + ldsw + _i * 8192), 16, 0, 0); } while (0)
#define PG8_LDA(dst, b, h) do { _Pragma("unroll") for (int m = 0; m < 4; ++m) _Pragma("unroll") for (int k = 0; k < 2; ++k) dst[m][k] = *(const LAS bf16x8*)(lds + PG8_SA(b, h) + aoff + m * 2048 + k * 1024); } while (0)
#define PG8_LDB(dst, b, h) do { _Pragma("unroll") for (int n = 0; n < 2; ++n) _Pragma("unroll") for (int k = 0; k < 2; ++k) dst[n][k] = *(const LAS bf16x8*)(lds + PG8_SB(b, h) + boff + n * 2048 + k * 1024); } while (0)
#define PG8_MMA(ai, bj, At, Bt) do { __builtin_amdgcn_s_setprio(1); _Pragma("unroll") for (int m = 0; m < 4; ++m) _Pragma("unroll") for (int n = 0; n < 2; ++n) _Pragma("unroll") for (int k = 0; k < 2; ++k) \
        acc[ai][bj][m][n] = __builtin_amdgcn_mfma_f32_16x16x32_bf16(Bt[n][k], At[m][k], acc[ai][bj][m][n], 0, 0, 0); __builtin_amdgcn_s_setprio(0); } while (0)
#define PG8_WAIT_V(n) asm volatile("s_waitcnt vmcnt(" #n ")" ::: "memory")
#define PG8_WAIT_L(n) asm volatile("s_waitcnt lgkmcnt(" #n ")" ::: "memory")
#define PG8_BAR __builtin_amdgcn_s_barrier()
#define PG8_SCHED __builtin_amdgcn_sched_barrier(0)
    Unit cur, nxt; int ui = 0;
    if (!S.next(0, cur)) return;
    f32x4 acc[2][2][4][2];
#pragma unroll
    for (int a = 0; a < 2; ++a)
#pragma unroll
        for (int b = 0; b < 2; ++b)
#pragma unroll
            for (int m = 0; m < 4; ++m)
#pragma unroll
                for (int n = 0; n < 2; ++n) acc[a][b][m][n] = (f32x4){0.f, 0.f, 0.f, 0.f};
    bf16x8 At[4][2], B0[2][2], B1[2][2];
    const char* cA = cur.a; const char* cB = cur.bt;
    PG8_STAGE(PG8_SB(0, 0), cB, voffB); PG8_STAGE(PG8_SA(0, 0), cA, voffA); PG8_STAGE(PG8_SB(0, 1), cB + hstepB, voffB); PG8_STAGE(PG8_SA(0, 1), cA + hstepA, voffA);
    if (wr == 1) PG8_BAR;
    PG8_WAIT_V(4); PG8_BAR;
    PG8_STAGE(PG8_SB(1, 0), cB + kstep, voffB); PG8_STAGE(PG8_SA(1, 0), cA + kstep, voffA); PG8_STAGE(PG8_SB(1, 1), cB + hstepB + kstep, voffB);
    PG8_WAIT_V(6); PG8_BAR;
    for (;;) {
        const bool has_next = S.next(ui + 1, nxt);
        const char* nA = has_next ? nxt.a : cA; const char* nB = has_next ? nxt.bt : cB;
        for (int t = 0; t < nt; t += 2) {
            const bool last = (t == nt - 2);
            const char* a1 = cA + (size_t)(t + 1) * kstep;
            const char* a2 = last ? nA : cA + (size_t)(t + 2) * kstep; const char* b2 = last ? nB : cB + (size_t)(t + 2) * kstep;
            const char* a3 = a2 + kstep; const char* b3 = b2 + kstep;
            PG8_LDB(B0, 0, 0); PG8_SCHED; PG8_LDA(At, 0, 0); PG8_STAGE(PG8_SA(1, 1), a1 + hstepA, voffA);
            PG8_WAIT_L(8); PG8_BAR; PG8_WAIT_L(0); PG8_MMA(0, 0, At, B0); PG8_BAR; PG8_SCHED;
            PG8_LDB(B1, 0, 1); PG8_STAGE(PG8_SB(0, 0), b2, voffB);
            PG8_BAR; PG8_WAIT_L(0); PG8_MMA(0, 1, At, B1); PG8_BAR;
            PG8_LDA(At, 0, 1); PG8_STAGE(PG8_SA(0, 0), a2, voffA);
            PG8_BAR; PG8_WAIT_L(0); PG8_MMA(1, 0, At, B0); PG8_BAR; PG8_SCHED;
            PG8_STAGE(PG8_SB(0, 1), b2 + hstepB, voffB);
            PG8_WAIT_V(6); PG8_BAR; PG8_MMA(1, 1, At, B1); PG8_BAR;
            PG8_LDB(B0, 1, 0); PG8_SCHED; PG8_LDA(At, 1, 0); PG8_STAGE(PG8_SA(0, 1), a2 + hstepA, voffA);
            PG8_WAIT_L(8); PG8_BAR; PG8_WAIT_L(0); PG8_MMA(0, 0, At, B0); PG8_BAR; PG8_SCHED;
            PG8_LDB(B1, 1, 1); PG8_STAGE(PG8_SB(1, 0), b3, voffB);
            PG8_BAR; PG8_WAIT_L(0); PG8_MMA(0, 1, At, B1); PG8_BAR;
            PG8_LDA(At, 1, 1); PG8_STAGE(PG8_SA(1, 0), a3, voffA);
            PG8_BAR; PG8_WAIT_L(0); PG8_MMA(1, 0, At, B0); PG8_BAR; PG8_SCHED;
            PG8_STAGE(PG8_SB(1, 1), b3 + hstepB, voffB);
            PG8_WAIT_V(6); PG8_BAR; PG8_MMA(1, 1, At, B1); PG8_BAR;
        }
        { int t2 = threadIdx.x; asm volatile("" : "+v"(t2)); const int w2 = __builtin_amdgcn_readfirstlane(t2 >> 6), l2 = t2 & 63;
          E(acc, cur, w2 >> 2, w2 & 3, l2 & 15, l2 >> 4); }
        if (!has_next) break;
#pragma unroll
        for (int a = 0; a < 2; ++a)
#pragma unroll
            for (int b = 0; b < 2; ++b)
#pragma unroll
                for (int m = 0; m < 4; ++m)
#pragma unroll
                    for (int n = 0; n < 2; ++n) acc[a][b][m][n] = (f32x4){0.f, 0.f, 0.f, 0.f};
        cur = nxt; cA = nA; cB = nB; ++ui;
    }
    PG8_WAIT_V(0);
    if (wr == 0) PG8_BAR;
    PG8_BAR;
#undef PG8_SA
#undef PG8_SB
#undef PG8_STAGE
#undef PG8_LDA
#undef PG8_LDB
#undef PG8_MMA
#undef PG8_WAIT_V
#undef PG8_WAIT_L
#undef PG8_BAR
#undef PG8_SCHED
}

__device__ __forceinline__ Sched mk_sched(const void* A, const void* Bt, int M, int N, int lda, int ldb, int rot) {
    Sched s; s.A = (const char*)A; s.Bt = (const char*)Bt; s.a_tile = 256 * lda * 2; s.b_tile = 256 * ldb * 2; s.a_batch = 0; s.b_batch = 0; s.seqB = 0;
    s.nM = M / 256; s.nN = N / 256; s.nB = 1; s.G = gridDim.x; s.c = (int)((blockIdx.x + (unsigned)rot) % gridDim.x); s.mode = 0; s.r = 1; return s;
}


struct GemmJob { int K, lda, ldb; Sched s; EpiAny e; };
__device__ __forceinline__ int rotc(int rot) { return (int)((blockIdx.x + gridDim.x - ((unsigned)rot % gridDim.x)) % gridDim.x); }
__device__ __forceinline__ bool get_job(const Params& p, int op, int arg, int j, GemmJob& J) {
    unsigned char* ws = p.ws; bf16_t* WB = (bf16_t*)ws; bf16_t* XB = (bf16_t*)(ws + OFF_XB); unsigned char* st = ws + OFF_STAGE;
    EpiAny e; e.kind = 0; e.o_off = 0; e.ldc = DM; e.bstride = 0; e.scale = 1.0f; e.h = 0; e.r = 1;
    J.K = DM; J.lda = DM; J.ldb = DM;
    if (op == 1) {
        if (j == 0) { J.s = mk_sched(st + ST_MEMN, WB + E_CKV, 768, 2048, DM, DM, 0); e.o_off = OFF_STAGE + ST_KV; e.ldc = 2048; }
        else if (j == 1) { J.s = mk_sched(XB, WB + E_FFN1_IN, T, 2 * DFF, DM, DM, 0); J.s.c = rotc(24); e.kind = 1; e.o_off = OFF_STAGE + ST_HID; }
        else return false;
    } else if (op == 2) {
        if (j == 0) { J.s = mk_sched(st + ST_HID, WB + E_FFN1_OUT, T, DM, DFF, DFF, 0); J.K = DFF; J.lda = DFF; J.ldb = DFF; e.kind = 2; e.scale = 0.5f; }
        else if (j <= 3) { const int sq = j - 1;
            J.s = mk_sched((const char*)(st + ST_KV) + (size_t)sq * 256 * 2048 * 2, WB + E_CQ, 256, 1024, 2048, DM, 0); J.s.nB = 4; J.s.a_batch = 512; J.s.b_batch = 512; J.s.c = rotc(sq * 16);
            J.K = 256; J.lda = 2048; J.ldb = DM; e.o_off = (E_GT + (size_t)sq * DM * DM) * 2; e.ldc = DM; e.bstride = 256 * DM; }
        else if (j <= 6) { const int sq = j - 4;
            J.s = mk_sched(WB + E_CO, (const char*)(st + ST_KV) + (size_t)sq * 256 * 2048 * 2 + 1024 * 2, 1024, 256, DM, 2048, 0); J.s.nB = 4; J.s.a_batch = 512; J.s.b_batch = 512; J.s.c = rotc(48 + sq * 16);
            J.K = 256; J.lda = DM; J.ldb = 2048; e.o_off = (E_HM + (size_t)sq * DM * DM) * 2; e.ldc = DM; e.bstride = 256; }
        else return false;
    } else if (op == 3) { if (j) return false; J.s = mk_sched(st + ST_ABUF, WB + E_MIX_OUT, T, DM, DM, DM, 0); e.kind = 2; }
    else if (op == 4) { if (j) return false; J.s = mk_sched(XB, WB + E_GT, T, DM, DM, DM, 0); J.s.mode = 1; J.s.seqB = DM * DM * 2; e.kind = 6; e.o_off = OFF_STAGE + ST_ABUF; }
    else if (op == 5) { if (j) return false; J.s = mk_sched(st + ST_ABUF, WB + E_HM, T, DM, DM, DM, 0); J.s.mode = 1; J.s.seqB = DM * DM * 2; e.kind = 2; }
    else if (op == 6) { if (j) return false; J.s = mk_sched(XB, WB + E_FFN2_IN, T, 2 * DFF, DM, DM, 0); e.kind = 1; e.o_off = OFF_STAGE + ST_HID; }
    else if (op == 7) { if (j) return false; J.s = mk_sched(st + ST_HID, WB + E_FFN2_OUT, T, DM, DFF, DFF, 0); J.K = DFF; J.lda = DFF; J.ldb = DFF; e.kind = 2; e.scale = 0.5f; }
    else if (op == 10) { if (j) return false; J.s = mk_sched(XB, WB + E_MIX_IN + (size_t)arg * 1024 * DM, T, 1024, DM, DM, 0); e.kind = 3; e.h = arg; }
    else if (op == 20) { if (j >= 6) return false; const int g = j >> 1, r = g == 0 ? 1 : (g == 1 ? 4 : 16); e.r = r;
        if ((j & 1) == 0) { J.s = mk_sched(XB, WB + E_MIX_IN + (size_t)(arg * 2304 + g * 512) * DM, T, 512, r * DM, DM, 0); J.s.mode = 2; J.s.r = r; J.s.c = rotc(g * 384);
            J.lda = r * DM; e.kind = 4; e.o_off = OFF_STAGE + ST_QKG + (size_t)g * T * 512 * 2; }
        else { J.s = mk_sched(WB + E_MIX_IN + (size_t)(arg * 2304 + 1536 + g * 256) * DM, XB, 256, T, DM, r * DM, 0); J.s.mode = 3; J.s.r = r; J.s.c = rotc(g * 384 + 256);
            J.ldb = r * DM; e.kind = 5; e.o_off = OFF_STAGE + ST_VTG + (size_t)g * 256 * T * 2; } }
    else return false;
    J.e = e; return true;
}

__device__ __forceinline__ void conv_tile(const float* src, int ld_src, int k0, int n0, bf16_t* dst, int ld_dst, int dr0, const float* gain, float scale, LAS float* tile) {
    int tid = threadIdx.x; asm volatile("" : "+v"(tid)); const int tx = tid & 63, ty = tid >> 6;
    for (int i = ty; i < 64; i += 8) { float v = src[(size_t)(k0 + i) * ld_src + n0 + tx] * scale; if (gain) v *= gain[k0 + i]; tile[i * 65 + tx] = v; }
    __syncthreads();
    const int i2 = tid & 31;
    for (int j = tid >> 5; j < 64; j += 16) { const float a = tile[(2 * i2) * 65 + j], b = tile[(2 * i2 + 1) * 65 + j];
        *(unsigned*)(dst + (size_t)(dr0 + j) * ld_dst + k0 + 2 * i2) = cvt_pk_bf16(a, b); }
    __syncthreads();
}
__device__ __forceinline__ int map_row(int kind, int n0, float& scale) {
    scale = 1.0f;
    if (EN(23) && kind == 1) { if (n0 < DFF) return (n0 / 128) * 256 + (n0 % 128); const int j = n0 - DFF; return (j / 128) * 256 + 128 + (j % 128); }
    if (EN(24) && kind == 2) {
        if (n0 < 512) { scale = 0.08838834764831845f; return (n0 / 128) * 1024 + (n0 % 128); }
        if (n0 < 1024) { const int j = n0 - 512; return (j / 128) * 1024 + 128 + (j % 128); }
        if (n0 < 2048) { const int j = n0 - 1024; return (j / 256) * 1024 + 512 + (j % 256); }
        const int j = n0 - 2048; return (j / 256) * 1024 + 768 + (j % 256);
    }
    if (EN(25) && kind == 3) { const int tg = n0 / 1024, h = (n0 % 1024) / 64, t = tg / 3, g = tg % 3, hc = h >> 2, hl = h & 3;
        if (t == 0) scale = 0.125f;
        if (t < 2) return hc * 2304 + g * 512 + t * 256 + hl * 64;
        return hc * 2304 + 1536 + g * 256 + hl * 64; }
    return n0;
}
__device__ void conv_weight(const float* src, int K, int N, int ld_src, bf16_t* dst, const float* gain, int kind, LAS float* tile, int& rot) {
    const int nk = K / 64, nn = N / 64, tot = nk * nn;
    for (int t = (int)((blockIdx.x + gridDim.x - (rot % gridDim.x)) % gridDim.x); t < tot; t += gridDim.x) {
        const int kt = t % nk, ntile = t / nk; float sc; const int dr0 = map_row(kind, ntile * 64, sc);
        conv_tile(src, ld_src, kt * 64, ntile * 64, dst, K, dr0, gain, sc, tile);
    }
    rot += tot;
}
__device__ __forceinline__ const float* x_in_row(const Params& p, int t) { return t < 16384 ? p.in[0] + (size_t)t * DM : p.in[1] + (size_t)(t - 16384) * DM; }

__device__ void phase_prologue(const Params& p, int layer, LAS unsigned char* lds) {
    unsigned char* ws = p.ws; bf16_t* WB = (bf16_t*)ws; LAS float* tile = (LAS float*)lds;
    int tid = threadIdx.x; asm volatile("" : "+v"(tid)); const int lane = tid & 63, wid = tid >> 6, nwv = gridDim.x * 8, gw = blockIdx.x * 8 + wid;
    int rot = 0;
    conv_weight(p.in[6] + (size_t)layer * DM * 2 * DFF, DM, 2 * DFF, 2 * DFF, WB + E_FFN1_IN, p.in[5] + layer * DM, 1, tile, rot);
    conv_weight(p.in[7] + (size_t)layer * DFF * DM, DFF, DM, DM, WB + E_FFN1_OUT, nullptr, 0, tile, rot);
    conv_weight(p.in[24] + (size_t)layer * DM * 2 * DFF, DM, 2 * DFF, 2 * DFF, WB + E_FFN2_IN, p.in[23] + layer * DM, 1, tile, rot);
    conv_weight(p.in[25] + (size_t)layer * DFF * DM, DFF, DM, DM, WB + E_FFN2_OUT, nullptr, 0, tile, rot);
    conv_weight(p.in[21] + (size_t)layer * DM * 2048, DM, 2048, 2048, WB + E_CKV, nullptr, 0, tile, rot);
    conv_weight(p.in[22] + (size_t)layer * DM * DM, DM, DM, DM, WB + E_CO, nullptr, 0, tile, rot);
    if (layer == 0) {
        conv_weight(p.in[9], DM, 3072, 3104, WB + E_MIX_IN, p.in[8], 2, tile, rot);
        conv_weight(p.in[15], DM, DM, DM, WB + E_MIX_OUT, nullptr, 0, tile, rot);
        for (size_t idx = (size_t)blockIdx.x * 512 + tid; idx < (size_t)2 * 512 * 1024; idx += (size_t)gridDim.x * 512) {
            const int c = (int)(idx & 1023), n = (int)((idx >> 10) & 511), dir = (int)(idx >> 19);
            const float* wi = p.in[9] + (size_t)c * 3104 + 3072 + dir * 16; const float* wg = (dir ? p.in[12] : p.in[10]) + n;
            float s = 0.f;
#pragma unroll
            for (int r = 0; r < 16; ++r) s += wi[r] * wg[r * 512];
            s *= p.in[8][c];
            WB[E_MIX_IN + (size_t)((n >> 7) * 1024 + 256 + dir * 128 + (n & 127)) * DM + c] = f2bf(s);
        }
    } else {
        conv_weight(p.in[16], DM, 9216, 9216, WB + E_MIX_IN, p.in[8] + DM, 3, tile, rot);
        conv_weight(p.in[17], DM, DM, DM, WB + E_MIX_OUT, nullptr, 0, tile, rot);
    }
    { const float* src = p.in[20] + (size_t)layer * DM * DM; const float* g = p.in[18] + layer * DM;
      for (size_t idx = ((size_t)blockIdx.x * 512 + tid) * 4; idx < (size_t)DM * DM; idx += (size_t)gridDim.x * 512 * 4) {
          const f32x4 v = *(const f32x4*)(src + idx); const float s = g[idx >> 10] * 0.0625f;
          u32x2 w; w.x = cvt_pk_bf16(v[0] * s, v[1] * s); w.y = cvt_pk_bf16(v[2] * s, v[3] * s);
          *(u32x2*)(WB + E_CQ + idx) = w; } }
    { bf16_t* MEMN = (bf16_t*)(ws + OFF_STAGE + ST_MEMN); const float* g = p.in[19] + layer * DM;
      for (int row = gw; row < 768; row += nwv) {
          const float* src = row < 512 ? p.in[2] + (size_t)row * DM : p.in[3] + (size_t)(row - 512) * DM;
          f32x4 v[4]; float ss = 0.f;
#pragma unroll
          for (int i = 0; i < 4; ++i) { v[i] = *(const f32x4*)(src + i * 256 + lane * 4); ss += (v[i][0] * v[i][0] + v[i][1] * v[i][1]) + (v[i][2] * v[i][2] + v[i][3] * v[i][3]); }
#pragma unroll
          for (int o = 1; o < 64; o <<= 1) ss += __shfl_xor(ss, o);
          const float rs = rsqrtf(ss * (1.0f / 1024.0f) + EPS);
#pragma unroll
          for (int i = 0; i < 4; ++i) { const f32x4 gg = *(const f32x4*)(g + i * 256 + lane * 4);
              u32x2 w; w.x = cvt_pk_bf16(v[i][0] * rs * gg[0], v[i][1] * rs * gg[1]); w.y = cvt_pk_bf16(v[i][2] * rs * gg[2], v[i][3] * rs * gg[3]);
              *(u32x2*)(MEMN + (size_t)row * DM + i * 256 + lane * 4) = w; } } }
    if (layer == 0) {
        bf16_t* XB = (bf16_t*)(ws + OFF_XB); float* part = (float*)(ws + OFF_PART);
        for (int row = gw; row < T; row += nwv) {
            const float* src = x_in_row(p, row); f32x4 v[4]; float ss = 0.f;
#pragma unroll
            for (int i = 0; i < 4; ++i) { v[i] = *(const f32x4*)(src + i * 256 + lane * 4); ss += (v[i][0] * v[i][0] + v[i][1] * v[i][1]) + (v[i][2] * v[i][2] + v[i][3] * v[i][3]); }
#pragma unroll
            for (int o = 1; o < 64; o <<= 1) ss += __shfl_xor(ss, o);
#pragma unroll
            for (int i = 0; i < 4; ++i) { *(f32x4*)(p.X + (size_t)row * DM + i * 256 + lane * 4) = v[i];
                u32x2 w; w.x = cvt_pk_bf16(v[i][0], v[i][1]); w.y = cvt_pk_bf16(v[i][2], v[i][3]);
                *(u32x2*)(XB + (size_t)row * DM + i * 256 + lane * 4) = w; }
            if (lane == 0) *(f32x4*)(part + (size_t)row * 4) = (f32x4){ss, 0.f, 0.f, 0.f};
        }
        float* bt = (float*)(ws + OFF_BTAB);
        for (int idx = blockIdx.x * 512 + tid; idx < 3 * 16 * 129; idx += gridDim.x * 512) {
            const int rel = idx % 129 - 64, h = (idx / 129) % 16, g = idx / (129 * 16); const int r = g == 0 ? 1 : (g == 1 ? 4 : 16);
            const int rr = rel * r, n = rr < 0 ? -rr : rr; int bk;
            if (n < 8) bk = n; else { int lg = 8 + (int)(log((double)n / 8.0) / log(128.0) * 8.0); bk = lg < 15 ? lg : 15; }
            if (rr > 0) bk += 16;
            bt[idx] = p.in[4][bk * 48 + g * 16 + h];
        }
    }
}

__device__ void phase_final(const Params& p) {
    const float* part = (const float*)(p.ws + OFF_PART); const float* g = p.in[26];
    int tid = threadIdx.x; asm volatile("" : "+v"(tid)); const int lane = tid & 63, wid = tid >> 6, nwv = gridDim.x * 8, gw = blockIdx.x * 8 + wid;
    for (int row = gw; row < T; row += nwv) { const float rs = rstd_of(part, row);
#pragma unroll
        for (int i = 0; i < 4; ++i) { float* xp = p.X + (size_t)row * DM + i * 256 + lane * 4; const f32x4 v = ld_sys16f(xp); const f32x4 gg = *(const f32x4*)(g + i * 256 + lane * 4);
            *(f32x4*)xp = (f32x4){v[0] * rs * gg[0], v[1] * rs * gg[1], v[2] * rs * gg[2], v[3] * rs * gg[3]}; } }
}

__device__ void gla_combine(const Params& p, int h) {
    unsigned char* st = p.ws + OFF_STAGE; const float* OF = (const float*)(st + ST_OF); const float* OB = (const float*)(st + ST_OB); bf16_t* AB = (bf16_t*)(st + ST_ABUF);
    const float* gn = p.in[14] + h * 256;
    int tid = threadIdx.x; asm volatile("" : "+v"(tid)); const int lane = tid & 63, wid = tid >> 6, nwv = gridDim.x * 8, gw = blockIdx.x * 8 + wid;
    const f32x4 gg = *(const f32x4*)(gn + lane * 4);
    for (int row = gw; row < T; row += nwv) {
        const f32x4 a = ld_sys16f(OF + (size_t)row * 256 + lane * 4), b = ld_sys16f(OB + (size_t)row * 256 + lane * 4);
        const f32x4 o = a + b; float ss = (o[0] * o[0] + o[1] * o[1]) + (o[2] * o[2] + o[3] * o[3]);
#pragma unroll
        for (int s = 1; s < 64; s <<= 1) ss += __shfl_xor(ss, s);
        const float rs = rsqrtf(ss * (1.0f / 256.0f) + EPS);
        bf16_t* ap = AB + (size_t)row * DM + h * 256 + lane * 4; const u32x2 rr = ld_sys8(ap);
        const float r0 = __uint_as_float(rr.x << 16), r1 = __uint_as_float(rr.x & 0xffff0000u), r2 = __uint_as_float(rr.y << 16), r3 = __uint_as_float(rr.y & 0xffff0000u);
        u32x2 w; w.x = cvt_pk_bf16(o[0] * rs * gg[0] * r0, o[1] * rs * gg[1] * r1); w.y = cvt_pk_bf16(o[2] * rs * gg[2] * r2, o[3] * rs * gg[3] * r3);
        *(u32x2*)ap = w;
    }
}

constexpr int SC_QP = 0, SC_KP = 17408, SC_KT = 34816, SC_VT = 53248, SC_ATT = 62464, SC_SS = 71680, SC_QS = 89088, SC_BL = 91136;

template <bool OUT>
__device__ void gla_scan(const Params& p, LAS unsigned char* lds) {
    unsigned char* st = p.ws + OFF_STAGE;
    const bf16_t* QK = (const bf16_t*)(st + ST_QK); const float* GG = (const float*)(st + ST_GG); const bf16_t* VV = (const bf16_t*)(st + ST_VV);
    float* SLOC = (float*)(st + ST_SLOC); float* DVEC = (float*)(st + ST_DVEC);
    int tid = threadIdx.x; asm volatile("" : "+v"(tid)); const int lane = tid & 63, w = tid >> 6, l15 = lane & 15, quad = lane >> 4;
    LAS bf16_t* QP = (LAS bf16_t*)(lds + SC_QP); LAS bf16_t* KP = (LAS bf16_t*)(lds + SC_KP); LAS bf16_t* KT = (LAS bf16_t*)(lds + SC_KT);
    LAS bf16_t* VT = (LAS bf16_t*)(lds + SC_VT); LAS bf16_t* ATT = (LAS bf16_t*)(lds + SC_ATT); LAS bf16_t* SS = (LAS bf16_t*)(lds + SC_SS);
    LAS float* QS = (LAS float*)(lds + SC_QS); LAS float* BL = (LAS float*)(lds + SC_BL);
    for (int unit = blockIdx.x; unit < 256; unit += gridDim.x) {
        const int slice = unit & 3, dir = (unit >> 2) & 1, seg = unit >> 3;
        const int sfirst = seg < 8 ? 0 : (seg < 16 ? 8 : 16), nseg = seg < 16 ? 8 : 16;
        const int sigma = dir == 0 ? seg - sfirst : sfirst + nseg - 1 - seg;
        float* oout = (float*)(st + (dir == 0 ? ST_OF : ST_OB));
        f32x4 S[4];
#pragma unroll
        for (int d = 0; d < 4; ++d) S[d] = (f32x4){0.f, 0.f, 0.f, 0.f};
        if (OUT) {
            for (int sp = 0; sp < sigma; ++sp) {
                const int sg = dir == 0 ? sfirst + sp : sfirst + nseg - 1 - sp;
                const float* sl = SLOC + (size_t)(sg * 2 + dir) * 128 * 256; const float* dv = DVEC + (size_t)(sg * 2 + dir) * 128;
#pragma unroll
                for (int r = 0; r < 4; ++r) { const int dk = 16 * w + 4 * quad + r; const float dd = ldsys_f(dv + dk);
#pragma unroll
                    for (int d = 0; d < 4; ++d) S[d][r] = S[d][r] * dd + ldsys_f(sl + (size_t)dk * 256 + slice * 64 + d * 16 + l15); }
            }
        }
        float dsum = 0.f;
        const int dkc = tid & 127, qr = tid >> 7;
        const int dvc = tid & 63, jr = tid >> 6;
        for (int ch = 0; ch < 16; ++ch) {
            const int tb = seg * 1024 + (dir == 0 ? ch * 64 : (15 - ch) * 64);
            float g[16]; float q[16], k[16];
#pragma unroll
            for (int ii = 0; ii < 16; ++ii) { const int ip = qr * 16 + ii; const int tok = tb + (dir == 0 ? ip : 63 - ip);
                g[ii] = ldsys_f(GG + (size_t)tok * 256 + dir * 128 + dkc);
                if (OUT) q[ii] = bf2f(ldsys_h(QK + (size_t)tok * 256 + dkc));
                k[ii] = bf2f(ldsys_h(QK + (size_t)tok * 256 + 128 + dkc)); }
            unsigned vpk[4];
            { float v[8];
#pragma unroll
              for (int jj = 0; jj < 8; ++jj) { const int jp = jr * 8 + jj; const int tok = tb + (dir == 0 ? jp : 63 - jp); v[jj] = bf2f(ldsys_h(VV + (size_t)tok * 256 + slice * 64 + dvc)); }
#pragma unroll
              for (int jj = 0; jj < 4; ++jj) vpk[jj] = cvt_pk_bf16(v[2 * jj], v[2 * jj + 1]); }
#pragma unroll
            for (int ii = 1; ii < 16; ++ii) g[ii] += g[ii - 1];
            QS[qr * 128 + dkc] = g[15];
            *(LAS u32x4*)(VT + dvc * 72 + jr * 8) = (u32x4){vpk[0], vpk[1], vpk[2], vpk[3]};
            __syncthreads();
            float off = 0.f, tot = 0.f;
#pragma unroll
            for (int qq = 0; qq < 4; ++qq) { const float s = QS[qq * 128 + dkc]; tot += s; if (qq < qr) off += s; }
            if (qr == 0) { BL[dkc] = __expf(tot); dsum += tot; }
            unsigned kt[8];
#pragma unroll
            for (int ii = 0; ii < 16; ii += 2) {
                const float b0 = off + g[ii], b1 = off + g[ii + 1];
                if (OUT) { const int ip = qr * 16 + ii;
                    QP[ip * 136 + dkc] = f2bf(q[ii] * __expf(b0)); QP[(ip + 1) * 136 + dkc] = f2bf(q[ii + 1] * __expf(b1));
                    KP[ip * 136 + dkc] = f2bf(k[ii] * __expf(-b0)); KP[(ip + 1) * 136 + dkc] = f2bf(k[ii + 1] * __expf(-b1)); }
                kt[ii >> 1] = cvt_pk_bf16(k[ii] * __expf(tot - b0), k[ii + 1] * __expf(tot - b1));
            }
            *(LAS u32x4*)(KT + dkc * 72 + qr * 16) = (u32x4){kt[0], kt[1], kt[2], kt[3]};
            *(LAS u32x4*)(KT + dkc * 72 + qr * 16 + 8) = (u32x4){kt[4], kt[5], kt[6], kt[7]};
            if (OUT) {
#pragma unroll
                for (int d = 0; d < 4; ++d) { u32x2 sw; sw.x = cvt_pk_bf16(S[d][0], S[d][1]); sw.y = cvt_pk_bf16(S[d][2], S[d][3]);
                    *(LAS u32x2*)(SS + (d * 16 + l15) * 136 + 16 * w + 4 * quad) = sw; }
            }
            __syncthreads();
            f32x4 O[2];
            if (OUT) {
                const int it = w >> 1, c0 = (w & 1) * 2;
                f32x4 at[2] = {(f32x4){0.f, 0.f, 0.f, 0.f}, (f32x4){0.f, 0.f, 0.f, 0.f}};
                O[0] = (f32x4){0.f, 0.f, 0.f, 0.f}; O[1] = (f32x4){0.f, 0.f, 0.f, 0.f};
#pragma unroll
                for (int kk = 0; kk < 4; ++kk) {
                    const bf16x8 af = *(const LAS bf16x8*)(QP + (it * 16 + l15) * 136 + kk * 32 + quad * 8);
#pragma unroll
                    for (int x = 0; x < 2; ++x) {
                        const bf16x8 kf = *(const LAS bf16x8*)(KP + ((c0 + x) * 16 + l15) * 136 + kk * 32 + quad * 8);
                        at[x] = __builtin_amdgcn_mfma_f32_16x16x32_bf16(af, kf, at[x], 0, 0, 0);
                        const bf16x8 sf = *(const LAS bf16x8*)(SS + ((c0 + x) * 16 + l15) * 136 + kk * 32 + quad * 8);
                        O[x] = __builtin_amdgcn_mfma_f32_16x16x32_bf16(af, sf, O[x], 0, 0, 0);
                    }
                }
#pragma unroll
                for (int x = 0; x < 2; ++x)
#pragma unroll
                    for (int r = 0; r < 4; ++r) { const int i = it * 16 + quad * 4 + r, j = (c0 + x) * 16 + l15;
                        ATT[i * 72 + j] = f2bf(j <= i ? at[x][r] : 0.f); }
            }
            {
#pragma unroll
                for (int r = 0; r < 4; ++r) { const float dd = BL[16 * w + 4 * quad + r];
#pragma unroll
                    for (int d = 0; d < 4; ++d) S[d][r] *= dd; }
#pragma unroll
                for (int kk = 0; kk < 2; ++kk) {
                    const bf16x8 af = *(const LAS bf16x8*)(KT + (16 * w + l15) * 72 + kk * 32 + quad * 8);
#pragma unroll
                    for (int d = 0; d < 4; ++d) { const bf16x8 vf = *(const LAS bf16x8*)(VT + (d * 16 + l15) * 72 + kk * 32 + quad * 8);
                        S[d] = __builtin_amdgcn_mfma_f32_16x16x32_bf16(af, vf, S[d], 0, 0, 0); }
                }
            }
            if (OUT) {
                __syncthreads();
                const int it = w >> 1, c0 = (w & 1) * 2;
#pragma unroll
                for (int kk = 0; kk < 2; ++kk) {
                    const bf16x8 af = *(const LAS bf16x8*)(ATT + (it * 16 + l15) * 72 + kk * 32 + quad * 8);
#pragma unroll
                    for (int x = 0; x < 2; ++x) { const bf16x8 vf = *(const LAS bf16x8*)(VT + ((c0 + x) * 16 + l15) * 72 + kk * 32 + quad * 8);
                        O[x] = __builtin_amdgcn_mfma_f32_16x16x32_bf16(af, vf, O[x], 0, 0, 0); }
                }
#pragma unroll
                for (int x = 0; x < 2; ++x)
#pragma unroll
                    for (int r = 0; r < 4; ++r) { const int ip = it * 16 + quad * 4 + r; const int tok = tb + (dir == 0 ? ip : 63 - ip);
                        oout[(size_t)tok * 256 + slice * 64 + (c0 + x) * 16 + l15] = O[x][r]; }
            }
            __syncthreads();
        }
        if (!OUT) {
            float* sl = SLOC + (size_t)(seg * 2 + dir) * 128 * 256;
#pragma unroll
            for (int r = 0; r < 4; ++r) { const int dk = 16 * w + 4 * quad + r;
#pragma unroll
                for (int d = 0; d < 4; ++d) sl[(size_t)dk * 256 + slice * 64 + d * 16 + l15] = S[d][r]; }
            if (slice == 0 && tid < 128) DVEC[(size_t)(seg * 2 + dir) * 128 + tid] = __expf(dsum);
        }
    }
}

__device__ void dil_attn(const Params& p, int hc, LAS unsigned char* lds) {
    unsigned char* st = p.ws + OFF_STAGE; bf16_t* AB = (bf16_t*)(st + ST_ABUF); const float* btab = (const float*)(p.ws + OFF_BTAB);
    LAS float* OST = (LAS float*)lds; LAS float* MST = (LAS float*)(lds + 69632); LAS float* LST = (LAS float*)(lds + 70656);
    int tid = threadIdx.x; asm volatile("" : "+v"(tid)); const int lane = tid & 63, w = tid >> 6, l15 = lane & 15, quad = lane >> 4;
    for (int unit = blockIdx.x; unit < 512; unit += gridDim.x) {
        const int hl = unit & 3, tbk = unit >> 2, t0 = tbk * 256;
        const int sb = t0 < 8192 ? 0 : (t0 < 16384 ? 8192 : 16384), Sq = t0 < 16384 ? 8192 : 16384;
        const int h = hc * 4 + hl;
#pragma unroll 1
        for (int g = 0; g < 3; ++g) {
            const int r = g == 0 ? 1 : (g == 1 ? 4 : 16), L = Sq / r;
            const bf16_t* QKg = (const bf16_t*)(st + ST_QKG) + (size_t)g * T * 512; const bf16_t* VTg = (const bf16_t*)(st + ST_VTG) + (size_t)g * 256 * T;
            const float* bt = btab + (g * 16 + h) * 129;
#pragma unroll 1
            for (int itx = 0; itx < 2; ++itx) {
                const int item = 2 * w + itx;
                int c, l0;
                if (g == 0) { c = 0; l0 = (t0 - sb) + 16 * item; } else if (g == 1) { c = item & 3; l0 = (t0 - sb) / 4 + 16 * (item >> 2); } else { c = item; l0 = (t0 - sb) / 16; }
                const int nq0 = sb + c * L + l0;
                const int tokl = (l0 + l15) * r + c - (t0 - sb);
                bf16x8 qf[2];
#pragma unroll
                for (int kk = 0; kk < 2; ++kk) qf[kk] = ld_sys16(QKg + (size_t)(nq0 + l15) * 512 + hl * 64 + kk * 32 + quad * 8);
                f32x4 sT[10];
#pragma unroll
                for (int kt = 0; kt < 10; ++kt) {
                    const int lk0 = l0 - 64 + 16 * kt; const bool inr = (lk0 >= 0) && (lk0 < L);
                    int nk = sb + c * L + lk0; nk = inr ? nk : nq0;
                    f32x4 a = (f32x4){0.f, 0.f, 0.f, 0.f};
#pragma unroll
                    for (int kk = 0; kk < 2; ++kk) { const bf16x8 kf = ld_sys16(QKg + (size_t)(nk + l15) * 512 + 256 + hl * 64 + kk * 32 + quad * 8);
                        a = __builtin_amdgcn_mfma_f32_16x16x32_bf16(kf, qf[kk], a, 0, 0, 0); }
#pragma unroll
                    for (int rr = 0; rr < 4; ++rr) { const int rel = -64 + 16 * kt + quad * 4 + rr - l15; const bool ok = inr && rel >= -64 && rel <= 64;
                        const int ri = rel < -64 ? 0 : (rel > 64 ? 128 : rel + 64);
                        a[rr] = ok ? a[rr] + bt[ri] : -1.0e30f; }
                    sT[kt] = a;
                }
                float mo = -1.0e30f, lo = 0.f;
                f32x4 O[4];
#pragma unroll
                for (int d = 0; d < 4; ++d) O[d] = (f32x4){0.f, 0.f, 0.f, 0.f};
                if (g > 0) { mo = MST[tokl]; lo = LST[tokl];
#pragma unroll
                    for (int d = 0; d < 4; ++d) O[d] = *(const LAS f32x4*)(OST + tokl * 68 + d * 16 + quad * 4); }
                float mx = mo;
#pragma unroll
                for (int kt = 0; kt < 10; ++kt)
#pragma unroll
                    for (int rr = 0; rr < 4; ++rr) mx = fmaxf(mx, sT[kt][rr]);
                mx = fmaxf(mx, __shfl_xor(mx, 16)); mx = fmaxf(mx, __shfl_xor(mx, 32));
                const float alpha = __expf(mo - mx);
                float ls = 0.f;
#pragma unroll
                for (int kt = 0; kt < 10; ++kt)
#pragma unroll
                    for (int rr = 0; rr < 4; ++rr) { const float e = __expf(sT[kt][rr] - mx); sT[kt][rr] = e; ls += e; }
                ls += __shfl_xor(ls, 16); ls += __shfl_xor(ls, 32);
                const float ln = lo * alpha + ls;
#pragma unroll
                for (int d = 0; d < 4; ++d) O[d] *= alpha;
#pragma unroll
                for (int kp = 0; kp < 5; ++kp) {
                    const int lka = l0 - 64 + 32 * kp, lkb = lka + 16;
                    const int na = (lka >= 0 && lka < L) ? sb + c * L + lka : nq0, nb = (lkb >= 0 && lkb < L) ? sb + c * L + lkb : nq0;
                    bf16x8 pf; { const unsigned p0 = cvt_pk_bf16(sT[2 * kp][0], sT[2 * kp][1]), p1 = cvt_pk_bf16(sT[2 * kp][2], sT[2 * kp][3]),
                                                p2 = cvt_pk_bf16(sT[2 * kp + 1][0], sT[2 * kp + 1][1]), p3 = cvt_pk_bf16(sT[2 * kp + 1][2], sT[2 * kp + 1][3]);
                                 u32x4 pw = (u32x4){p0, p1, p2, p3}; pf = __builtin_bit_cast(bf16x8, pw); }
#pragma unroll
                    for (int d = 0; d < 4; ++d) {
                        const bf16_t* vrow = VTg + (size_t)(hl * 64 + d * 16 + l15) * T;
                        const u32x2 va = ld_sys8(vrow + na + quad * 4), vb = ld_sys8(vrow + nb + quad * 4);
                        u32x4 vw = (u32x4){va.x, va.y, vb.x, vb.y}; const bf16x8 vf = __builtin_bit_cast(bf16x8, vw);
                        O[d] = __builtin_amdgcn_mfma_f32_16x16x32_bf16(vf, pf, O[d], 0, 0, 0);
                    }
                }
                if (g < 2) {
                    if (quad == 0) { MST[tokl] = mx; LST[tokl] = ln; }
#pragma unroll
                    for (int d = 0; d < 4; ++d) *(LAS f32x4*)(OST + tokl * 68 + d * 16 + quad * 4) = O[d];
                } else {
                    const float inv = 1.0f / ln;
#pragma unroll
                    for (int d = 0; d < 4; ++d) { u32x2 ow; ow.x = cvt_pk_bf16(O[d][0] * inv, O[d][1] * inv); ow.y = cvt_pk_bf16(O[d][2] * inv, O[d][3] * inv);
                        *(u32x2*)(AB + (size_t)(t0 + tokl) * DM + h * 64 + d * 16 + quad * 4) = ow; }
                }
            }
            __syncthreads();
        }
    }
}

#define XB_TMO      128
#define XB_XCNT(j)  (256  + 64 * (j))
#define XB_XSUB(j)  (1280 + 64 * (j))
#define XB_XGEN(j)  (2304 + 64 * (j))
#define XB_TOP      3328
#define XB_TOPGEN   3392
#define XCD_BAR_WORDS 3456
#define XB_SPIN_CAP (1u << 22)
__device__ __forceinline__ unsigned xb_ld(unsigned* p)              { return __hip_atomic_load(p, __ATOMIC_RELAXED, __HIP_MEMORY_SCOPE_AGENT); }
__device__ __forceinline__ unsigned xb_add(unsigned* p, unsigned v) { return __hip_atomic_fetch_add(p, v, __ATOMIC_RELAXED, __HIP_MEMORY_SCOPE_AGENT); }
__device__ __forceinline__ unsigned xb_xcc_id() { return (unsigned)__builtin_amdgcn_s_getreg((3 << 11) | 20) & 0xFu; }
#define XB_SPIN(cond, bar) do { unsigned _sp = 0; while (cond) { __builtin_amdgcn_s_sleep(1); \
    if ((++_sp & 255u) == 0u) { if (xb_ld(&(bar)[XB_TMO])) break; if (_sp > XB_SPIN_CAP) { atomicAdd(&(bar)[XB_TMO], 1u); break; } } } } while (0)
struct XcdBarrier { unsigned* bar; unsigned x; volatile LAS unsigned* st; };
__device__ __forceinline__ XcdBarrier xcd_barrier_post(unsigned* bar, volatile LAS unsigned* st) {
    XcdBarrier b; b.bar = bar; b.x = xb_xcc_id(); b.st = st;
    if (threadIdx.x == 0) (void)xb_add(&bar[XB_XCNT(b.x)], 1u);
    return b;
}
__device__ __forceinline__ void xcd_barrier_complete(unsigned* bar, unsigned x, unsigned& nloc, unsigned& nx) {
    const unsigned G = gridDim.x * gridDim.y * gridDim.z;
    unsigned sum, cnt, mine, sp = 0u;
    for (;;) {
        sum = 0u; cnt = 0u; mine = 0u;
#pragma unroll
        for (unsigned j = 0; j < 16; ++j) { const unsigned c = xb_ld(&bar[XB_XCNT(j)]); sum += c; cnt += (c > 0u) ? 1u : 0u; mine = (j == x) ? c : mine; }
        if (sum == G) break;
        __builtin_amdgcn_s_sleep(1);
        if ((++sp & 255u) == 0u) { if (xb_ld(&bar[XB_TMO])) break; if (sp > XB_SPIN_CAP) { atomicAdd(&bar[XB_TMO], 1u); break; } }
    }
    nloc = mine > 0u ? mine : 1u; nx = cnt > 0u ? cnt : 1u;
}
__device__ __forceinline__ void xcd_barrier(const XcdBarrier& b) {
    asm volatile("s_waitcnt vmcnt(0)" ::: "memory");
    __syncthreads();
    if (threadIdx.x == 0) {
        unsigned* bar = b.bar;
        __builtin_amdgcn_s_waitcnt(0);
        unsigned nloc = b.st[0], nx = b.st[1];
        if (nloc == 0u) { xcd_barrier_complete(bar, b.x, nloc, nx); b.st[0] = nloc; b.st[1] = nx; }
        const unsigned old = xb_add(&bar[XB_XSUB(b.x)], 1u);
        const unsigned gen = old / nloc;
        if (old + 1u == (gen + 1u) * nloc) {
            __builtin_amdgcn_fence(__ATOMIC_RELEASE, "agent");
            asm volatile("s_waitcnt vmcnt(0)" ::: "memory");
            const unsigned og = xb_add(&bar[XB_TOP], 1u);
            const unsigned tg = og / nx;
            if (og + 1u == (tg + 1u) * nx) xb_add(&bar[XB_TOPGEN], 1u);
            else XB_SPIN(xb_ld(&bar[XB_TOPGEN]) == tg, bar);
            __builtin_amdgcn_fence(__ATOMIC_ACQUIRE, "agent");
            xb_add(&bar[XB_XGEN(b.x)], 1u);
            asm volatile("s_waitcnt vmcnt(0)" ::: "memory");
        } else {
            XB_SPIN(xb_ld(&bar[XB_XGEN(b.x)]) == gen, bar);
            __builtin_amdgcn_fence(__ATOMIC_ACQUIRE, "agent");
            asm volatile("s_waitcnt vmcnt(0)" ::: "memory");
        }
    }
    __syncthreads();
}

__global__ void __launch_bounds__(512, 2) fwd_megakernel(Params p) {
    extern __shared__ __attribute__((aligned(16))) unsigned char smem[];
    LAS unsigned char* lds = (LAS unsigned char*)smem;
    cg::grid_group grid = cg::this_grid();
    if (threadIdx.x < 2) ((volatile LAS unsigned*)(lds + LDS_CTL))[threadIdx.x] = 0u;
    __syncthreads();
    const XcdBarrier bar = xcd_barrier_post((unsigned*)(p.ws + OFF_CTL), (volatile LAS unsigned*)(lds + LDS_CTL));
    grid.sync();
    unsigned char* ws = p.ws; bf16_t* WB = (bf16_t*)ws; bf16_t* XB = (bf16_t*)(ws + OFF_XB); float* part = (float*)(ws + OFF_PART);
    unsigned char* st = ws + OFF_STAGE;
    for (int ph = p.ph_lo; ph < p.ph_hi; ++ph) {
        if (ph > p.ph_lo) { for (int xs = 0; xs <= PROBE_SYNC; ++xs) xcd_barrier(bar); }
        if (ph == 37) { phase_final(p); continue; }
        const int layer = ph >= 21 ? 1 : 0, q = ph - layer * 21;
        int op = -1, arg = 0;
        if (q == 0) op = 0; else if (q == 1) op = 1; else if (q == 2) op = 2;
        else if (layer == 0) {
            if (q <= 14) { const int hh = (q - 3) / 3, s = (q - 3) % 3; arg = hh; op = 10 + s; }
            else if (q == 15) { op = 13; arg = 3; } else op = q - 16 + 3;
        } else {
            if (q <= 10) { arg = (q - 3) >> 1; op = 20 + ((q - 3) & 1); } else op = q - 11 + 3;
        }
        if (op == 10 && arg > 0) gla_combine(p, arg - 1);
        for (int rep = 0; rep < (((PROBE_REP >> op) & 1u) ? 2 : 1); ++rep) {
        if (op == 0) { if (EN(0)) phase_prologue(p, layer, lds); }
        else if (op == 11) { if (EN(11)) gla_scan<false>(p, lds); }
        else if (op == 12) { if (EN(12)) gla_scan<true>(p, lds); }
        else if (op == 13) { if (EN(13)) gla_combine(p, arg); }
        else if (op == 21) { if (EN(21)) dil_attn(p, arg, lds); }
        else if (EN(1)) {
            GemmJob J;
            for (int j = 0; j < 8; ++j) { if (!get_job(p, op, arg, j, J)) break;
                const float* part = (const float*)(ws + OFF_PART); const int kind = J.e.kind;
                if (EN(22) && kind == 0) { EpiPlain e{(bf16_t*)(ws + J.e.o_off), J.e.ldc, J.e.bstride}; gemm_phase(lds, J.K, J.lda, J.ldb, J.s, e); }
                else if (EN(23) && kind == 1) { EpiSwiGLU e{(bf16_t*)(ws + J.e.o_off), part}; gemm_phase(lds, DM, DM, DM, J.s, e); }
                else if (EN(24) && kind == 2) { EpiResid e{p.X, XB, (float*)(ws + OFF_PART), J.e.scale, (LAS float*)(lds + LDS_X)}; gemm_phase(lds, J.K, J.K, J.K, J.s, e); }
                else if (EN(25) && kind == 3) { EpiGlaProj e{(bf16_t*)(st + ST_QK), (float*)(st + ST_GG), (bf16_t*)(st + ST_VV), (bf16_t*)(st + ST_ABUF), part, p.in[11], p.in[13], J.e.h}; gemm_phase(lds, DM, DM, DM, J.s, e); }
                else if (EN(26) && kind == 4) { EpiDilQK e{(bf16_t*)(ws + J.e.o_off), part, J.e.r}; gemm_phase(lds, DM, J.lda, DM, J.s, e); }
                else if (EN(27) && kind == 5) { EpiDilVT e{(bf16_t*)(ws + J.e.o_off), part, J.e.r}; gemm_phase(lds, DM, DM, J.ldb, J.s, e); }
                else if (EN(28) && kind == 6) { EpiScores e{(bf16_t*)(ws + J.e.o_off), part, (LAS f32x2*)(lds + LDS_X)}; gemm_phase(lds, DM, DM, DM, J.s, e); }
            }
        }
        __syncthreads();
        }
    }
}

extern "C" void kernel_launch(void* const* d_in, const int* in_sizes, int n_in, void* d_out, int out_size, void* d_ws, size_t ws_size, hipStream_t stream) {
    static int grid_blocks = 0;
    if (!grid_blocks) {
        int dev = 0, cus = 0, per_cu = 0;
        hipGetDevice(&dev);
        hipDeviceGetAttribute(&cus, hipDeviceAttributeMultiprocessorCount, dev);
        hipFuncSetAttribute((const void*)fwd_megakernel, hipFuncAttributeMaxDynamicSharedMemorySize, LDS_BYTES);
        hipOccupancyMaxActiveBlocksPerMultiprocessor(&per_cu, fwd_megakernel, 512, LDS_BYTES);
        if (per_cu < 1) per_cu = 1;
        if (per_cu > 1) per_cu = 1;
        grid_blocks = cus * per_cu;
    }
    if (n_in != 27 || ws_size < WS_NEED) { fprintf(stderr, "kernel_launch: unexpected n_in %d / ws_size %zu (need %zu)\n", n_in, ws_size, (size_t)WS_NEED); return; }
    hipMemsetAsync((char*)d_ws + OFF_CTL, 0, CTL_BYTES, stream);
    Params p{};
    for (int i = 0; i < 27; ++i) p.in[i] = (const float*)d_in[i];
    p.X = (float*)d_out; p.ws = (unsigned char*)d_ws; p.ph_lo = 0; p.ph_hi = 38;
    void* args[] = {&p};
    hipError_t e = hipLaunchCooperativeKernel((const void*)fwd_megakernel, dim3(grid_blocks), dim3(512), args, LDS_BYTES, stream);
    if (e != hipSuccess) fprintf(stderr, "cooperative launch failed: %s (grid %d)\n", hipGetErrorString(e), grid_blocks);
}
```

```cpp
#include <hip/hip_runtime.h>
#include <hip/hip_cooperative_groups.h>
#include <cstdio>
#include <cstdint>
namespace cg = cooperative_groups;

#define LAS __attribute__((address_space(3)))
typedef unsigned short bf16_t;
typedef short bf16x8 __attribute__((ext_vector_type(8)));
typedef short bf16x4 __attribute__((ext_vector_type(4)));
typedef float f32x4 __attribute__((ext_vector_type(4)));
typedef float f32x2 __attribute__((ext_vector_type(2)));
typedef unsigned u32x4 __attribute__((ext_vector_type(4)));
typedef unsigned u32x2 __attribute__((ext_vector_type(2)));

#ifndef OPMASK
#define OPMASK 0xFFFFFFFFu
#endif
#define EN(o) ((OPMASK >> (o)) & 1u)
#ifndef PROBE_REP
#define PROBE_REP 0u
#endif
#ifndef PROBE_SYNC
#define PROBE_SYNC 0
#endif
constexpr int T = 32768, DM = 1024, DFF = 2816;
constexpr float EPS = 1e-6f;
constexpr int BM = 256, BK = 64, HALF = 128, HTB = HALF * BK * 2, STAGE_BYTES = 8 * HTB, NXCD = 8, WGM = 8;
constexpr int LDS_X = STAGE_BYTES;
constexpr int LDS_CTL = STAGE_BYTES + 8192;
constexpr int LDS_BYTES = STAGE_BYTES + 8192 + 64;

constexpr size_t E_FFN1_IN = 0, E_FFN1_OUT = 5767168, E_FFN2_IN = 8650752, E_FFN2_OUT = 14417920, E_CQ = 17301504, E_CKV = 18350080,
                 E_CO = 20447232, E_MIX_IN = 21495808, E_MIX_OUT = 30932992, E_GT = 31981568, E_HM = 35127296, E_WEND = 38273024;
constexpr size_t OFF_XB = E_WEND * 2, OFF_PART = OFF_XB + (size_t)T * DM * 2, OFF_BTAB = OFF_PART + (size_t)T * 16, OFF_STAGE = OFF_BTAB + 32768;
constexpr size_t ST_HID = 0, ST_MEMN = 184549376, ST_KV = 186122240;
constexpr size_t ST_ABUF = 0, ST_QK = 67108864, ST_GG = 83886080, ST_VV = 117440512, ST_OF = 134217728, ST_OB = 167772160, ST_SLOC = 201326592, ST_DVEC = 209715200;
constexpr size_t ST_QKG = 67108864, ST_VTG = 167772160;
constexpr size_t OFF_CTL = OFF_STAGE + 218103808;
constexpr size_t CTL_BYTES = 16384;
constexpr size_t WS_NEED = OFF_CTL + CTL_BYTES;

struct Params {
    const float* in[27];
    float* X;
    unsigned char* ws;
    int ph_lo, ph_hi;
};

__device__ __forceinline__ unsigned cvt_pk_bf16(float lo, float hi) { unsigned r; asm volatile("v_cvt_pk_bf16_f32 %0, %1, %2" : "=v"(r) : "v"(lo), "v"(hi)); return r; }
__device__ __forceinline__ float bf2f(bf16_t b) { return __uint_as_float(((unsigned)b) << 16); }
__device__ __forceinline__ bf16_t f2bf(float f) { return (bf16_t)(cvt_pk_bf16(f, 0.f) & 0xffffu); }

__host__ __device__ __forceinline__ int lds_byte(int r, int c) { const int st = (r >> 4) * 2 + (c >> 5), rr = r & 15, cc = c & 31, ob = rr * 64 + cc * 2; return st * 1024 + (ob ^ (((ob >> 9) & 1) << 5)); }
__host__ __device__ __forceinline__ void stage_rc(int b, int& R, int& C) { const int st = b / 1024, sb = b % 1024, swz = sb ^ (((sb >> 9) & 1) << 5); R = (st >> 1) * 16 + swz / 64; C = (st & 1) * 32 + (swz % 64) / 2; }
__host__ __device__ __forceinline__ int perm32(int rho) { const int n = rho >> 4, i = rho & 15; return 8 * (i >> 2) + 4 * n + (i & 3); }

struct Unit { int pm, pn, b; const char* a; const char* bt; };

__device__ __forceinline__ int dil_token0(int n0, int r) {
    const int sb = n0 < 8192 ? 0 : (n0 < 16384 ? 8192 : 16384), S = n0 < 16384 ? 8192 : 16384, L = S / r;
    const int c = (n0 - sb) / L, l0 = (n0 - sb) % L;
    return sb + l0 * r + c;
}

struct Sched {
    const char* A; const char* Bt;
    int a_tile, b_tile, a_batch, b_batch, seqB;
    int nM, nN, nB, G, c, mode, r;
    __device__ __forceinline__ bool next(int i, Unit& u) const {
        const int per = nM * nN; const long tot = (long)per * nB;
        const long L = (long)i * G + c; if (L >= tot) return false;
        int b = (int)(L / per); int wgid = (int)(L % per);
        { const int q = per / NXCD, rr = per % NXCD, xcd = wgid % NXCD, off = wgid / NXCD; wgid = (xcd < rr ? xcd * (q + 1) : rr * (q + 1) + (xcd - rr) * q) + off; }
        const int nig = WGM * nN, gid = wgid / nig, fm = gid * WGM, gsz = (nM - fm) < WGM ? (nM - fm) : WGM;
        u.pm = fm + ((wgid % nig) % gsz); u.pn = (wgid % nig) / gsz; u.b = b;
        const char* a = A + (long)b * a_batch; const char* bt = Bt + (long)b * b_batch;
        if (mode == 2) a += (long)dil_token0(u.pm * 256, r) * (DM * 2); else a += (long)u.pm * a_tile;
        if (mode == 3) bt += (long)dil_token0(u.pn * 256, r) * (DM * 2); else bt += (long)u.pn * b_tile;
        if (mode == 1) { const int s = u.pm < 32 ? 0 : (u.pm < 64 ? 1 : 2); bt += (long)s * seqB; }
        u.a = a; u.bt = bt; return true;
    }
};


typedef unsigned long long u64_t;
__device__ __forceinline__ float ldsys_f(const float* p) { return __hip_atomic_load(p, __ATOMIC_RELAXED, __HIP_MEMORY_SCOPE_SYSTEM); }
__device__ __forceinline__ bf16_t ldsys_h(const bf16_t* p) { return __hip_atomic_load(p, __ATOMIC_RELAXED, __HIP_MEMORY_SCOPE_SYSTEM); }
__device__ __forceinline__ u32x2 ld_sys8(const void* p) {
    const u64_t a = __hip_atomic_load((const u64_t*)p, __ATOMIC_RELAXED, __HIP_MEMORY_SCOPE_SYSTEM); return (u32x2){(unsigned)a, (unsigned)(a >> 32)};
}
__device__ __forceinline__ u32x4 ld_sys16u(const void* p) {
    const u64_t* q = (const u64_t*)p;
    const u64_t a = __hip_atomic_load(q, __ATOMIC_RELAXED, __HIP_MEMORY_SCOPE_SYSTEM), b = __hip_atomic_load(q + 1, __ATOMIC_RELAXED, __HIP_MEMORY_SCOPE_SYSTEM);
    return (u32x4){(unsigned)a, (unsigned)(a >> 32), (unsigned)b, (unsigned)(b >> 32)};
}
__device__ __forceinline__ bf16x8 ld_sys16(const void* p) { return __builtin_bit_cast(bf16x8, ld_sys16u(p)); }
__device__ __forceinline__ f32x4 ld_sys16f(const void* p) { return __builtin_bit_cast(f32x4, ld_sys16u(p)); }

__device__ __forceinline__ float rstd_of(const float* part, int row) {
    const f32x4 p = ld_sys16f(part + (size_t)row * 4);
    return rsqrtf(((p[0] + p[1]) + (p[2] + p[3])) * (1.0f / 1024.0f) + EPS);
}


__device__ __forceinline__ void rstd8(const float* part, int row0, float (&rs)[8]) {
    f32x4 pp[8];
#pragma unroll
    for (int i = 0; i < 8; ++i) pp[i] = ld_sys16f(part + (size_t)(row0 + (i >> 2) * 128 + (i & 3) * 16) * 4);
#pragma unroll
    for (int i = 0; i < 8; ++i) rs[i] = rsqrtf(((pp[i][0] + pp[i][1]) + (pp[i][2] + pp[i][3])) * (1.0f / 1024.0f) + EPS);
}

#define LBAR() do { asm volatile("s_waitcnt lgkmcnt(0)" ::: "memory"); __builtin_amdgcn_s_barrier(); asm volatile("" ::: "memory"); } while (0)

struct EpiPlain {
    bf16_t* O; int ldc; int bstride;
    __device__ __forceinline__ void operator()(const f32x4 (&acc)[2][2][4][2], const Unit& u, int wr, int wc, int fr, int fq) const {
        bf16_t* base = O + (long)u.b * bstride;
#pragma unroll
        for (int ai = 0; ai < 2; ++ai)
#pragma unroll
            for (int m = 0; m < 4; ++m) { const int row = u.pm * 256 + ai * 128 + wr * 64 + m * 16 + fr;
#pragma unroll
                for (int bj = 0; bj < 2; ++bj) { const int col = u.pn * 256 + bj * 128 + wc * 32 + 8 * fq;
                    const f32x4 v0 = acc[ai][bj][m][0], v1 = acc[ai][bj][m][1];
                    u32x4 w; w.x = cvt_pk_bf16(v0[0], v0[1]); w.y = cvt_pk_bf16(v0[2], v0[3]); w.z = cvt_pk_bf16(v1[0], v1[1]); w.w = cvt_pk_bf16(v1[2], v1[3]);
                    *(u32x4*)(base + (long)row * ldc + col) = w; } }
    }
};
struct EpiSwiGLU {
    bf16_t* H; const float* part;
    __device__ __forceinline__ void operator()(const f32x4 (&acc)[2][2][4][2], const Unit& u, int wr, int wc, int fr, int fq) const {
        float rs8[8]; rstd8(part, u.pm * 256 + wr * 64 + fr, rs8);
#pragma unroll
        for (int ai = 0; ai < 2; ++ai)
#pragma unroll
            for (int m = 0; m < 4; ++m) { const int row = u.pm * 256 + ai * 128 + wr * 64 + m * 16 + fr; const float rs = rs8[ai * 4 + m];
                float h[8];
#pragma unroll
                for (int n = 0; n < 2; ++n)
#pragma unroll
                    for (int j = 0; j < 4; ++j) { const float a = acc[ai][0][m][n][j] * rs, b = acc[ai][1][m][n][j] * rs; h[n * 4 + j] = a * b / (1.0f + __expf(-a)); }
                u32x4 w; w.x = cvt_pk_bf16(h[0], h[1]); w.y = cvt_pk_bf16(h[2], h[3]); w.z = cvt_pk_bf16(h[4], h[5]); w.w = cvt_pk_bf16(h[6], h[7]);
                *(u32x4*)(H + (long)row * DFF + u.pn * 128 + wc * 32 + 8 * fq) = w; }
    }
};
struct EpiResid {
    float* X; bf16_t* XB; float* part; float scale; LAS float* xt;
    __device__ __forceinline__ void operator()(const f32x4 (&acc)[2][2][4][2], const Unit& u, int wr, int wc, int fr, int fq) const {
#pragma unroll
        for (int ai = 0; ai < 2; ++ai)
#pragma unroll
            for (int m = 0; m < 4; ++m) { const int rl = ai * 128 + wr * 64 + m * 16 + fr; const long row = (long)u.pm * 256 + rl; float ss = 0.f;
#pragma unroll
                for (int bj = 0; bj < 2; ++bj) { const int col = u.pn * 256 + bj * 128 + wc * 32 + 8 * fq;
                    float* xp = X + row * DM + col;
                    f32x4 x0 = *(const f32x4*)xp, x1 = *(const f32x4*)(xp + 4);
                    x0 += acc[ai][bj][m][0] * scale; x1 += acc[ai][bj][m][1] * scale;
                    *(f32x4*)xp = x0; *(f32x4*)(xp + 4) = x1;
                    u32x4 w; w.x = cvt_pk_bf16(x0[0], x0[1]); w.y = cvt_pk_bf16(x0[2], x0[3]); w.z = cvt_pk_bf16(x1[0], x1[1]); w.w = cvt_pk_bf16(x1[2], x1[3]);
                    *(u32x4*)(XB + row * DM + col) = w;
                    ss += (x0[0] * x0[0] + x0[1] * x0[1]) + (x0[2] * x0[2] + x0[3] * x0[3]) + (x1[0] * x1[0] + x1[1] * x1[1]) + (x1[2] * x1[2] + x1[3] * x1[3]); }
                ss += __shfl_xor(ss, 16); ss += __shfl_xor(ss, 32);
                if (fq == 0) xt[rl * 4 + wc] = ss;
                asm volatile("" ::: "memory"); }
        LBAR();
        const int lane = fq * 16 + fr;
        if (lane < 32) { const int q = wc * 32 + lane, rl = (q >> 6) * 128 + wr * 64 + (q & 63);
            const f32x4 s = *(const LAS f32x4*)(xt + rl * 4);
            part[((size_t)u.pm * 256 + rl) * 4 + u.pn] = (s[0] + s[1]) + (s[2] + s[3]); }
    }
};
struct EpiGlaProj {
    bf16_t* QK; float* GG; bf16_t* VV; bf16_t* AB; const float* part; const float* bgf; const float* bgb; int h;
    __device__ __forceinline__ void operator()(const f32x4 (&acc)[2][2][4][2], const Unit& u, int wr, int wc, int fr, int fq) const {
        float rs8[8]; rstd8(part, u.pm * 256 + wr * 64 + fr, rs8);
#pragma unroll
        for (int ai = 0; ai < 2; ++ai)
#pragma unroll
            for (int m = 0; m < 4; ++m) { const long row = (long)u.pm * 256 + ai * 128 + wr * 64 + m * 16 + fr; const float rs = rs8[ai * 4 + m];
#pragma unroll
                for (int bj = 0; bj < 2; ++bj) { const int col = bj * 128 + wc * 32 + 8 * fq;
                    f32x4 v0 = acc[ai][bj][m][0] * rs, v1 = acc[ai][bj][m][1] * rs;
                    if (u.pn == 1) {
                        const float* bp = (bj == 0 ? bgf : bgb) + h * 128 + wc * 32 + 8 * fq;
                        const f32x4 b0 = *(const f32x4*)bp, b1 = *(const f32x4*)(bp + 4);
#pragma unroll
                        for (int j = 0; j < 4; ++j) { float z = v0[j] + b0[j]; v0[j] = (fminf(z, 0.f) - log1pf(__expf(-fabsf(z)))) * (1.0f / 16.0f);
                                                      z = v1[j] + b1[j]; v1[j] = (fminf(z, 0.f) - log1pf(__expf(-fabsf(z)))) * (1.0f / 16.0f); }
                        float* gp = GG + row * 256 + col; *(f32x4*)gp = v0; *(f32x4*)(gp + 4) = v1;
                    } else {
                        if (u.pn == 3) {
#pragma unroll
                            for (int j = 0; j < 4; ++j) { v0[j] = v0[j] / (1.0f + __expf(-v0[j])); v1[j] = v1[j] / (1.0f + __expf(-v1[j])); } }
                        u32x4 w; w.x = cvt_pk_bf16(v0[0], v0[1]); w.y = cvt_pk_bf16(v0[2], v0[3]); w.z = cvt_pk_bf16(v1[0], v1[1]); w.w = cvt_pk_bf16(v1[2], v1[3]);
                        bf16_t* dst = u.pn == 0 ? QK + row * 256 + col : (u.pn == 2 ? VV + row * 256 + col : AB + row * DM + h * 256 + col);
                        *(u32x4*)dst = w; } } }
    }
};
struct EpiDilQK {
    bf16_t* O; const float* part; int r;
    __device__ __forceinline__ void operator()(const f32x4 (&acc)[2][2][4][2], const Unit& u, int wr, int wc, int fr, int fq) const {
        const int tok0 = dil_token0(u.pm * 256, r);
        float rs8[8];
        { f32x4 pp[8];
#pragma unroll
          for (int i = 0; i < 8; ++i) pp[i] = ld_sys16f(part + (size_t)(tok0 + ((i >> 2) * 128 + wr * 64 + (i & 3) * 16 + fr) * r) * 4);
#pragma unroll
          for (int i = 0; i < 8; ++i) rs8[i] = rsqrtf(((pp[i][0] + pp[i][1]) + (pp[i][2] + pp[i][3])) * (1.0f / 1024.0f) + EPS); }
#pragma unroll
        for (int ai = 0; ai < 2; ++ai)
#pragma unroll
            for (int m = 0; m < 4; ++m) { const int rl = ai * 128 + wr * 64 + m * 16 + fr; const long row = (long)u.pm * 256 + rl; const float rs = rs8[ai * 4 + m];
#pragma unroll
                for (int bj = 0; bj < 2; ++bj) { const int col = u.pn * 256 + bj * 128 + wc * 32 + 8 * fq;
                    const f32x4 v0 = acc[ai][bj][m][0] * rs, v1 = acc[ai][bj][m][1] * rs;
                    u32x4 w; w.x = cvt_pk_bf16(v0[0], v0[1]); w.y = cvt_pk_bf16(v0[2], v0[3]); w.z = cvt_pk_bf16(v1[0], v1[1]); w.w = cvt_pk_bf16(v1[2], v1[3]);
                    *(u32x4*)(O + row * 512 + col) = w; }
                asm volatile("" ::: "memory"); }
    }
};
struct EpiDilVT {
    bf16_t* O; const float* part; int r;
    __device__ __forceinline__ void operator()(const f32x4 (&acc)[2][2][4][2], const Unit& u, int wr, int wc, int fr, int fq) const {
        const int tok0 = dil_token0(u.pn * 256, r);
#pragma unroll
        for (int bj = 0; bj < 2; ++bj) { const int cl = bj * 128 + wc * 32 + 8 * fq; float rs[8];
#pragma unroll
            for (int j = 0; j < 8; ++j) rs[j] = rstd_of(part, tok0 + (cl + j) * r);
#pragma unroll
            for (int ai = 0; ai < 2; ++ai)
#pragma unroll
                for (int m = 0; m < 4; ++m) { const int row = ai * 128 + wr * 64 + m * 16 + fr;
                    const f32x4 v0 = acc[ai][bj][m][0], v1 = acc[ai][bj][m][1];
                    u32x4 w; w.x = cvt_pk_bf16(v0[0] * rs[0], v0[1] * rs[1]); w.y = cvt_pk_bf16(v0[2] * rs[2], v0[3] * rs[3]);
                    w.z = cvt_pk_bf16(v1[0] * rs[4], v1[1] * rs[5]); w.w = cvt_pk_bf16(v1[2] * rs[6], v1[3] * rs[7]);
                    *(u32x4*)(O + (long)row * T + u.pn * 256 + cl) = w;
                    asm volatile("" ::: "memory"); } }
    }
};
struct EpiScores {
    bf16_t* P; const float* part; LAS f32x2* xt;
    __device__ __forceinline__ void operator()(const f32x4 (&acc)[2][2][4][2], const Unit& u, int wr, int wc, int fr, int fq) const {
        float rs8[8]; rstd8(part, u.pm * 256 + wr * 64 + fr, rs8);
#pragma unroll
        for (int ai = 0; ai < 2; ++ai)
#pragma unroll
            for (int m = 0; m < 4; ++m) { const int rl = ai * 128 + wr * 64 + m * 16 + fr; const float r_ = rs8[ai * 4 + m];
                float mx = -3.0e38f;
#pragma unroll
                for (int bj = 0; bj < 2; ++bj)
#pragma unroll
                    for (int n = 0; n < 2; ++n)
#pragma unroll
                        for (int j = 0; j < 4; ++j) mx = fmaxf(mx, acc[ai][bj][m][n][j] * r_);
                mx = fmaxf(mx, __shfl_xor(mx, 16)); mx = fmaxf(mx, __shfl_xor(mx, 32));
                float l = 0.f;
#pragma unroll
                for (int bj = 0; bj < 2; ++bj)
#pragma unroll
                    for (int n = 0; n < 2; ++n)
#pragma unroll
                        for (int j = 0; j < 4; ++j) l += __expf(acc[ai][bj][m][n][j] * r_ - mx);
                l += __shfl_xor(l, 16); l += __shfl_xor(l, 32);
                if (fq == 0) xt[rl * 4 + wc] = (f32x2){mx, l};
                asm volatile("" ::: "memory"); }
        LBAR();
#pragma unroll
        for (int ai = 0; ai < 2; ++ai)
#pragma unroll
            for (int m = 0; m < 4; ++m) { const int rl = ai * 128 + wr * 64 + m * 16 + fr; const long row = (long)u.pm * 256 + rl; const float r_ = rs8[ai * 4 + m];
                const f32x2 a = xt[rl * 4 + 0], b = xt[rl * 4 + 1], c = xt[rl * 4 + 2], d = xt[rl * 4 + 3];
                const float M = fmaxf(fmaxf(a.x, b.x), fmaxf(c.x, d.x));
                const float Ls = a.y * __expf(a.x - M) + b.y * __expf(b.x - M) + c.y * __expf(c.x - M) + d.y * __expf(d.x - M);
                const float inv = 1.0f / Ls;
#pragma unroll
                for (int bj = 0; bj < 2; ++bj) { const int col = u.pn * 256 + bj * 128 + wc * 32 + 8 * fq; float p[8];
#pragma unroll
                    for (int n = 0; n < 2; ++n)
#pragma unroll
                        for (int j = 0; j < 4; ++j) p[n * 4 + j] = __expf(acc[ai][bj][m][n][j] * r_ - M) * inv;
                    u32x4 w; w.x = cvt_pk_bf16(p[0], p[1]); w.y = cvt_pk_bf16(p[2], p[3]); w.z = cvt_pk_bf16(p[4], p[5]); w.w = cvt_pk_bf16(p[6], p[7]);
                    *(u32x4*)(P + row * DM + col) = w; }
                asm volatile("" ::: "memory"); }
    }
};


struct EpiAny {
    int kind;
    long o_off;
    int ldc, bstride; float scale; int h, r;
    __device__ __forceinline__ void operator()(const f32x4 (&acc)[2][2][4][2], const Unit& u, int wr, int wc, int fr, int fq, const Params& p, LAS unsigned char* lds) const {
        unsigned char* ws = p.ws; unsigned char* st = ws + OFF_STAGE; const float* part = (const float*)(ws + OFF_PART);
        if (EN(22) && kind == 0) { EpiPlain e{(bf16_t*)(ws + o_off), ldc, bstride}; e(acc, u, wr, wc, fr, fq); }
        else if (EN(23) && kind == 1) { EpiSwiGLU e{(bf16_t*)(ws + o_off), part}; e(acc, u, wr, wc, fr, fq); }
        else if (EN(24) && kind == 2) { EpiResid e{p.X, (bf16_t*)(ws + OFF_XB), (float*)(ws + OFF_PART), scale, (LAS float*)(lds + LDS_X)}; e(acc, u, wr, wc, fr, fq); }
        else if (EN(25) && kind == 3) { EpiGlaProj e{(bf16_t*)(st + ST_QK), (float*)(st + ST_GG), (bf16_t*)(st + ST_VV), (bf16_t*)(st + ST_ABUF), part, p.in[11], p.in[13], h}; e(acc, u, wr, wc, fr, fq); }
        else if (EN(26) && kind == 4) { EpiDilQK e{(bf16_t*)(ws + o_off), part, r}; e(acc, u, wr, wc, fr, fq); }
        else if (EN(27) && kind == 5) { EpiDilVT e{(bf16_t*)(ws + o_off), part, r}; e(acc, u, wr, wc, fr, fq); }
        else if (EN(28)) { EpiScores e{(bf16_t*)(ws + o_off), part, (LAS f32x2*)(lds + LDS_X)}; e(acc, u, wr, wc, fr, fq); }
    }
};

template <class Epi>
__device__ __forceinline__ void gemm_phase(LAS unsigned char* lds, const int K, const int lda, const int ldb, const Sched& S, const Epi& E) {
    int tid = threadIdx.x; asm volatile("" : "+v"(tid));
    const int wid = __builtin_amdgcn_readfirstlane(tid >> 6), lane = tid & 63, wr = wid >> 2, wc = wid & 3, fr = lane & 15, fq = lane >> 4;
    const int nt = K / BK;
    unsigned voffA[2], voffB[2];
#pragma unroll
    for (int i = 0; i < 2; ++i) { int R, C; stage_rc(tid * 16 + i * 8192, R, C); const int Rb = (R & ~31) + perm32(R & 31);
        voffA[i] = (unsigned)(R * lda + C) * 2u; voffB[i] = (unsigned)(Rb * ldb + C) * 2u; }
    const size_t kstep = (size_t)(BK * 2);
    const size_t hstepA = (size_t)HALF * lda * 2, hstepB = (size_t)HALF * ldb * 2;
    const unsigned ldsw = (unsigned)wid * 1024u;
    const int aoff = lds_byte(wr * 64 + fr, fq * 8), boff = lds_byte(wc * 32 + fr, fq * 8);
#define PG8_SA(b, h) (((b) * 2 + (h)) * HTB)
#define PG8_SB(b, h) ((4 + (b) * 2 + (h)) * HTB)
#define PG8_STAGE(bufoff, gbase, voff) do { _Pragma("unroll") for (int _i = 0; _i < 2; ++_i) \
        __builtin_amdgcn_global_load_lds((const unsigned*)((const char*)(gbase) + (voff)[_i]), (LAS unsigned*)(lds + (bufoff) + ldsw + _i * 8192), 16, 0, 0); } while (0)
#define PG8_LDA(dst, b, h) do { _Pragma("unroll") for (int m = 0; m < 4; ++m) _Pragma("unroll") for (int k = 0; k < 2; ++k) dst[m][k] = *(const LAS bf16x8*)(lds + PG8_SA(b, h) + aoff + m * 2048 + k * 1024); } while (0)
#define PG8_LDB(dst, b, h) do { _Pragma("unroll") for (int n = 0; n < 2; ++n) _Pragma("unroll") for (int k = 0; k < 2; ++k) dst[n][k] = *(const LAS bf16x8*)(lds + PG8_SB(b, h) + boff + n * 2048 + k * 1024); } while (0)
#define PG8_MMA(ai, bj, At, Bt) do { __builtin_amdgcn_s_setprio(1); _Pragma("unroll") for (int m = 0; m < 4; ++m) _Pragma("unroll") for (int n = 0; n < 2; ++n) _Pragma("unroll") for (int k = 0; k < 2; ++k) \
        acc[ai][bj][m][n] = __builtin_amdgcn_mfma_f32_16x16x32_bf16(Bt[n][k], At[m][k], acc[ai][bj][m][n], 0, 0, 0); __builtin_amdgcn_s_setprio(0); } while (0)
#define PG8_WAIT_V(n) asm volatile("s_waitcnt vmcnt(" #n ")" ::: "memory")
#define PG8_WAIT_L(n) asm volatile("s_waitcnt lgkmcnt(" #n ")" ::: "memory")
#define PG8_BAR __builtin_amdgcn_s_barrier()
#define PG8_SCHED __builtin_amdgcn_sched_barrier(0)
    Unit cur, nxt; int ui = 0;
    if (!S.next(0, cur)) return;
    f32x4 acc[2][2][4][2];
#pragma unroll
    for (int a = 0; a < 2; ++a)
#pragma unroll
        for (int b = 0; b < 2; ++b)
#pragma unroll
            for (int m = 0; m < 4; ++m)
#pragma unroll
                for (int n = 0; n < 2; ++n) acc[a][b][m][n] = (f32x4){0.f, 0.f, 0.f, 0.f};
    bf16x8 At[4][2], B0[2][2], B1[2][2];
    const char* cA = cur.a; const char* cB = cur.bt;
    PG8_STAGE(PG8_SB(0, 0), cB, voffB); PG8_STAGE(PG8_SA(0, 0), cA, voffA); PG8_STAGE(PG8_SB(0, 1), cB + hstepB, voffB); PG8_STAGE(PG8_SA(0, 1), cA + hstepA, voffA);
    if (wr == 1) PG8_BAR;
    PG8_WAIT_V(4); PG8_BAR;
    PG8_STAGE(PG8_SB(1, 0), cB + kstep, voffB); PG8_STAGE(PG8_SA(1, 0), cA + kstep, voffA); PG8_STAGE(PG8_SB(1, 1), cB + hstepB + kstep, voffB);
    PG8_WAIT_V(6); PG8_BAR;
    for (;;) {
        const bool has_next = S.next(ui + 1, nxt);
        const char* nA = has_next ? nxt.a : cA; const char* nB = has_next ? nxt.bt : cB;
        for (int t = 0; t < nt; t += 2) {
            const bool last = (t == nt - 2);
            const char* a1 = cA + (size_t)(t + 1) * kstep;
            const char* a2 = last ? nA : cA + (size_t)(t + 2) * kstep; const char* b2 = last ? nB : cB + (size_t)(t + 2) * kstep;
            const char* a3 = a2 + kstep; const char* b3 = b2 + kstep;
            PG8_LDB(B0, 0, 0); PG8_SCHED; PG8_LDA(At, 0, 0); PG8_STAGE(PG8_SA(1, 1), a1 + hstepA, voffA);
            PG8_WAIT_L(8); PG8_BAR; PG8_WAIT_L(0); PG8_MMA(0, 0, At, B0); PG8_BAR; PG8_SCHED;
            PG8_LDB(B1, 0, 1); PG8_STAGE(PG8_SB(0, 0), b2, voffB);
            PG8_BAR; PG8_WAIT_L(0); PG8_MMA(0, 1, At, B1); PG8_BAR;
            PG8_LDA(At, 0, 1); PG8_STAGE(PG8_SA(0, 0), a2, voffA);
            PG8_BAR; PG8_WAIT_L(0); PG8_MMA(1, 0, At, B0); PG8_BAR; PG8_SCHED;
            PG8_STAGE(PG8_SB(0, 1), b2 + hstepB, voffB);
            PG8_WAIT_V(6); PG8_BAR; PG8_MMA(1, 1, At, B1); PG8_BAR;
            PG8_LDB(B0, 1, 0); PG8_SCHED; PG8_LDA(At, 1, 0); PG8_STAGE(PG8_SA(0, 1), a2 + hstepA, voffA);
            PG8_WAIT_L(8); PG8_BAR; PG8_WAIT_L(0); PG8_MMA(0, 0, At, B0); PG8_BAR; PG8_SCHED;
            PG8_LDB(B1, 1, 1); PG8_STAGE(PG8_SB(1, 0), b3, voffB);
            PG8_BAR; PG8_WAIT_L(0); PG8_MMA(0, 1, At, B1); PG8_BAR;
            PG8_LDA(At, 1, 1); PG8_STAGE(PG8_SA(1, 0), a3, voffA);
            PG8_BAR; PG8_WAIT_L(0); PG8_MMA(1, 0, At, B0); PG8_BAR; PG8_SCHED;
            PG8_STAGE(PG8_SB(1, 1), b3 + hstepB, voffB);
            PG8_WAIT_V(6); PG8_BAR; PG8_MMA(1, 1, At, B1); PG8_BAR;
        }
        { int t2 = threadIdx.x; asm volatile("" : "+v"(t2)); const int w2 = __builtin_amdgcn_readfirstlane(t2 >> 6), l2 = t2 & 63;
          E(acc, cur, w2 >> 2, w2 & 3, l2 & 15, l2 >> 4); }
        if (!has_next) break;
#pragma unroll
        for (int a = 0; a < 2; ++a)
#pragma unroll
            for (int b = 0; b < 2; ++b)
#pragma unroll
                for (int m = 0; m < 4; ++m)
#pragma unroll
                    for (int n = 0; n < 2; ++n) acc[a][b][m][n] = (f32x4){0.f, 0.f, 0.f, 0.f};
        cur = nxt; cA = nA; cB = nB; ++ui;
    }
    PG8_WAIT_V(0);
    if (wr == 0) PG8_BAR;
    PG8_BAR;
#undef PG8_SA
#undef PG8_SB
#undef PG8_STAGE
#undef PG8_LDA
#undef PG8_LDB
#undef PG8_MMA
#undef PG8_WAIT_V
#undef PG8_WAIT_L
#undef PG8_BAR
#undef PG8_SCHED
}

__device__ __forceinline__ Sched mk_sched(const void* A, const void* Bt, int M, int N, int lda, int ldb, int rot) {
    Sched s; s.A = (const char*)A; s.Bt = (const char*)Bt; s.a_tile = 256 * lda * 2; s.b_tile = 256 * ldb * 2; s.a_batch = 0; s.b_batch = 0; s.seqB = 0;
    s.nM = M / 256; s.nN = N / 256; s.nB = 1; s.G = gridDim.x; s.c = (int)((blockIdx.x + (unsigned)rot) % gridDim.x); s.mode = 0; s.r = 1; return s;
}


struct GemmJob { int K, lda, ldb; Sched s; EpiAny e; };
__device__ __forceinline__ int rotc(int rot) { return (int)((blockIdx.x + gridDim.x - ((unsigned)rot % gridDim.x)) % gridDim.x); }
__device__ __forceinline__ bool get_job(const Params& p, int op, int arg, int j, GemmJob& J) {
    unsigned char* ws = p.ws; bf16_t* WB = (bf16_t*)ws; bf16_t* XB = (bf16_t*)(ws + OFF_XB); unsigned char* st = ws + OFF_STAGE;
    EpiAny e; e.kind = 0; e.o_off = 0; e.ldc = DM; e.bstride = 0; e.scale = 1.0f; e.h = 0; e.r = 1;
    J.K = DM; J.lda = DM; J.ldb = DM;
    if (op == 1) {
        if (j == 0) { J.s = mk_sched(st + ST_MEMN, WB + E_CKV, 768, 2048, DM, DM, 0); e.o_off = OFF_STAGE + ST_KV; e.ldc = 2048; }
        else if (j == 1) { J.s = mk_sched(XB, WB + E_FFN1_IN, T, 2 * DFF, DM, DM, 0); J.s.c = rotc(24); e.kind = 1; e.o_off = OFF_STAGE + ST_HID; }
        else return false;
    } else if (op == 2) {
        if (j == 0) { J.s = mk_sched(st + ST_HID, WB + E_FFN1_OUT, T, DM, DFF, DFF, 0); J.K = DFF; J.lda = DFF; J.ldb = DFF; e.kind = 2; e.scale = 0.5f; }
        else if (j <= 3) { const int sq = j - 1;
            J.s = mk_sched((const char*)(st + ST_KV) + (size_t)sq * 256 * 2048 * 2, WB + E_CQ, 256, 1024, 2048, DM, 0); J.s.nB = 4; J.s.a_batch = 512; J.s.b_batch = 512; J.s.c = rotc(sq * 16);
            J.K = 256; J.lda = 2048; J.ldb = DM; e.o_off = (E_GT + (size_t)sq * DM * DM) * 2; e.ldc = DM; e.bstride = 256 * DM; }
        else if (j <= 6) { const int sq = j - 4;
            J.s = mk_sched(WB + E_CO, (const char*)(st + ST_KV) + (size_t)sq * 256 * 2048 * 2 + 1024 * 2, 1024, 256, DM, 2048, 0); J.s.nB = 4; J.s.a_batch = 512; J.s.b_batch = 512; J.s.c = rotc(48 + sq * 16);
            J.K = 256; J.lda = DM; J.ldb = 2048; e.o_off = (E_HM + (size_t)sq * DM * DM) * 2; e.ldc = DM; e.bstride = 256; }
        else return false;
    } else if (op == 3) { if (j) return false; J.s = mk_sched(st + ST_ABUF, WB + E_MIX_OUT, T, DM, DM, DM, 0); e.kind = 2; }
    else if (op == 4) { if (j) return false; J.s = mk_sched(XB, WB + E_GT, T, DM, DM, DM, 0); J.s.mode = 1; J.s.seqB = DM * DM * 2; e.kind = 6; e.o_off = OFF_STAGE + ST_ABUF; }
    else if (op == 5) { if (j) return false; J.s = mk_sched(st + ST_ABUF, WB + E_HM, T, DM, DM, DM, 0); J.s.mode = 1; J.s.seqB = DM * DM * 2; e.kind = 2; }
    else if (op == 6) { if (j) return false; J.s = mk_sched(XB, WB + E_FFN2_IN, T, 2 * DFF, DM, DM, 0); e.kind = 1; e.o_off = OFF_STAGE + ST_HID; }
    else if (op == 7) { if (j) return false; J.s = mk_sched(st + ST_HID, WB + E_FFN2_OUT, T, DM, DFF, DFF, 0); J.K = DFF; J.lda = DFF; J.ldb = DFF; e.kind = 2; e.scale = 0.5f; }
    else if (op == 10) { if (j) return false; J.s = mk_sched(XB, WB + E_MIX_IN + (size_t)arg * 1024 * DM, T, 1024, DM, DM, 0); e.kind = 3; e.h = arg; }
    else if (op == 20) { if (j >= 6) return false; const int g = j >> 1, r = g == 0 ? 1 : (g == 1 ? 4 : 16); e.r = r;
        if ((j & 1) == 0) { J.s = mk_sched(XB, WB + E_MIX_IN + (size_t)(arg * 2304 + g * 512) * DM, T, 512, r * DM, DM, 0); J.s.mode = 2; J.s.r = r; J.s.c = rotc(g * 384);
            J.lda = r * DM; e.kind = 4; e.o_off = OFF_STAGE + ST_QKG + (size_t)g * T * 512 * 2; }
        else { J.s = mk_sched(WB + E_MIX_IN + (size_t)(arg * 2304 + 1536 + g * 256) * DM, XB, 256, T, DM, r * DM, 0); J.s.mode = 3; J.s.r = r; J.s.c = rotc(g * 384 + 256);
            J.ldb = r * DM; e.kind = 5; e.o_off = OFF_STAGE + ST_VTG + (size_t)g * 256 * T * 2; } }
    else return false;
    J.e = e; return true;
}

__device__ __forceinline__ void conv_tile(const float* src, int ld_src, int k0, int n0, bf16_t* dst, int ld_dst, int dr0, const float* gain, float scale, LAS float* tile) {
    int tid = threadIdx.x; asm volatile("" : "+v"(tid)); const int tx = tid & 63, ty = tid >> 6;
    for (int i = ty; i < 64; i += 8) { float v = src[(size_t)(k0 + i) * ld_src + n0 + tx] * scale; if (gain) v *= gain[k0 + i]; tile[i * 65 + tx] = v; }
    __syncthreads();
    const int i2 = tid & 31;
    for (int j = tid >> 5; j < 64; j += 16) { const float a = tile[(2 * i2) * 65 + j], b = tile[(2 * i2 + 1) * 65 + j];
        *(unsigned*)(dst + (size_t)(dr0 + j) * ld_dst + k0 + 2 * i2) = cvt_pk_bf16(a, b); }
    __syncthreads();
}
__device__ __forceinline__ int map_row(int kind, int n0, float& scale) {
    scale = 1.0f;
    if (EN(23) && kind == 1) { if (n0 < DFF) return (n0 / 128) * 256 + (n0 % 128); const int j = n0 - DFF; return (j / 128) * 256 + 128 + (j % 128); }
    if (EN(24) && kind == 2) {
        if (n0 < 512) { scale = 0.08838834764831845f; return (n0 / 128) * 1024 + (n0 % 128); }
        if (n0 < 1024) { const int j = n0 - 512; return (j / 128) * 1024 + 128 + (j % 128); }
        if (n0 < 2048) { const int j = n0 - 1024; return (j / 256) * 1024 + 512 + (j % 256); }
        const int j = n0 - 2048; return (j / 256) * 1024 + 768 + (j % 256);
    }
    if (EN(25) && kind == 3) { const int tg = n0 / 1024, h = (n0 % 1024) / 64, t = tg / 3, g = tg % 3, hc = h >> 2, hl = h & 3;
        if (t == 0) scale = 0.125f;
        if (t < 2) return hc * 2304 + g * 512 + t * 256 + hl * 64;
        return hc * 2304 + 1536 + g * 256 + hl * 64; }
    return n0;
}
__device__ void conv_weight(const float* src, int K, int N, int ld_src, bf16_t* dst, const float* gain, int kind, LAS float* tile, int& rot) {
    const int nk = K / 64, nn = N / 64, tot = nk * nn;
    for (int t = (int)((blockIdx.x + gridDim.x - (rot % gridDim.x)) % gridDim.x); t < tot; t += gridDim.x) {
        const int kt = t % nk, ntile = t / nk; float sc; const int dr0 = map_row(kind, ntile * 64, sc);
        conv_tile(src, ld_src, kt * 64, ntile * 64, dst, K, dr0, gain, sc, tile);
    }
    rot += tot;
}
__device__ __forceinline__ const float* x_in_row(const Params& p, int t) { return t < 16384 ? p.in[0] + (size_t)t * DM : p.in[1] + (size_t)(t - 16384) * DM; }

__device__ void phase_prologue(const Params& p, int layer, LAS unsigned char* lds) {
    unsigned char* ws = p.ws; bf16_t* WB = (bf16_t*)ws; LAS float* tile = (LAS float*)lds;
    int tid = threadIdx.x; asm volatile("" : "+v"(tid)); const int lane = tid & 63, wid = tid >> 6, nwv = gridDim.x * 8, gw = blockIdx.x * 8 + wid;
    int rot = 0;
    conv_weight(p.in[6] + (size_t)layer * DM * 2 * DFF, DM, 2 * DFF, 2 * DFF, WB + E_FFN1_IN, p.in[5] + layer * DM, 1, tile, rot);
    conv_weight(p.in[7] + (size_t)layer * DFF * DM, DFF, DM, DM, WB + E_FFN1_OUT, nullptr, 0, tile, rot);
    conv_weight(p.in[24] + (size_t)layer * DM * 2 * DFF, DM, 2 * DFF, 2 * DFF, WB + E_FFN2_IN, p.in[23] + layer * DM, 1, tile, rot);
    conv_weight(p.in[25] + (size_t)layer * DFF * DM, DFF, DM, DM, WB + E_FFN2_OUT, nullptr, 0, tile, rot);
    conv_weight(p.in[21] + (size_t)layer * DM * 2048, DM, 2048, 2048, WB + E_CKV, nullptr, 0, tile, rot);
    conv_weight(p.in[22] + (size_t)layer * DM * DM, DM, DM, DM, WB + E_CO, nullptr, 0, tile, rot);
    if (layer == 0) {
        conv_weight(p.in[9], DM, 3072, 3104, WB + E_MIX_IN, p.in[8], 2, tile, rot);
        conv_weight(p.in[15], DM, DM, DM, WB + E_MIX_OUT, nullptr, 0, tile, rot);
        for (size_t idx = (size_t)blockIdx.x * 512 + tid; idx < (size_t)2 * 512 * 1024; idx += (size_t)gridDim.x * 512) {
            const int c = (int)(idx & 1023), n = (int)((idx >> 10) & 511), dir = (int)(idx >> 19);
            const float* wi = p.in[9] + (size_t)c * 3104 + 3072 + dir * 16; const float* wg = (dir ? p.in[12] : p.in[10]) + n;
            float s = 0.f;
#pragma unroll
            for (int r = 0; r < 16; ++r) s += wi[r] * wg[r * 512];
            s *= p.in[8][c];
            WB[E_MIX_IN + (size_t)((n >> 7) * 1024 + 256 + dir * 128 + (n & 127)) * DM + c] = f2bf(s);
        }
    } else {
        conv_weight(p.in[16], DM, 9216, 9216, WB + E_MIX_IN, p.in[8] + DM, 3, tile, rot);
        conv_weight(p.in[17], DM, DM, DM, WB + E_MIX_OUT, nullptr, 0, tile, rot);
    }
    { const float* src = p.in[20] + (size_t)layer * DM * DM; const float* g = p.in[18] + layer * DM;
      for (size_t idx = ((size_t)blockIdx.x * 512 + tid) * 4; idx < (size_t)DM * DM; idx += (size_t)gridDim.x * 512 * 4) {
          const f32x4 v = *(const f32x4*)(src + idx); const float s = g[idx >> 10] * 0.0625f;
          u32x2 w; w.x = cvt_pk_bf16(v[0] * s, v[1] * s); w.y = cvt_pk_bf16(v[2] * s, v[3] * s);
          *(u32x2*)(WB + E_CQ + idx) = w; } }
    { bf16_t* MEMN = (bf16_t*)(ws + OFF_STAGE + ST_MEMN); const float* g = p.in[19] + layer * DM;
      for (int row = gw; row < 768; row += nwv) {
          const float* src = row < 512 ? p.in[2] + (size_t)row * DM : p.in[3] + (size_t)(row - 512) * DM;
          f32x4 v[4]; float ss = 0.f;
#pragma unroll
          for (int i = 0; i < 4; ++i) { v[i] = *(const f32x4*)(src + i * 256 + lane * 4); ss += (v[i][0] * v[i][0] + v[i][1] * v[i][1]) + (v[i][2] * v[i][2] + v[i][3] * v[i][3]); }
#pragma unroll
          for (int o = 1; o < 64; o <<= 1) ss += __shfl_xor(ss, o);
          const float rs = rsqrtf(ss * (1.0f / 1024.0f) + EPS);
#pragma unroll
          for (int i = 0; i < 4; ++i) { const f32x4 gg = *(const f32x4*)(g + i * 256 + lane * 4);
              u32x2 w; w.x = cvt_pk_bf16(v[i][0] * rs * gg[0], v[i][1] * rs * gg[1]); w.y = cvt_pk_bf16(v[i][2] * rs * gg[2], v[i][3] * rs * gg[3]);
              *(u32x2*)(MEMN + (size_t)row * DM + i * 256 + lane * 4) = w; } } }
    if (layer == 0) {
        bf16_t* XB = (bf16_t*)(ws + OFF_XB); float* part = (float*)(ws + OFF_PART);
        for (int row = gw; row < T; row += nwv) {
            const float* src = x_in_row(p, row); f32x4 v[4]; float ss = 0.f;
#pragma unroll
            for (int i = 0; i < 4; ++i) { v[i] = *(const f32x4*)(src + i * 256 + lane * 4); ss += (v[i][0] * v[i][0] + v[i][1] * v[i][1]) + (v[i][2] * v[i][2] + v[i][3] * v[i][3]); }
#pragma unroll
            for (int o = 1; o < 64; o <<= 1) ss += __shfl_xor(ss, o);
#pragma unroll
            for (int i = 0; i < 4; ++i) { *(f32x4*)(p.X + (size_t)row * DM + i * 256 + lane * 4) = v[i];
                u32x2 w; w.x = cvt_pk_bf16(v[i][0], v[i][1]); w.y = cvt_pk_bf16(v[i][2], v[i][3]);
                *(u32x2*)(XB + (size_t)row * DM + i * 256 + lane * 4) = w; }
            if (lane == 0) *(f32x4*)(part + (size_t)row * 4) = (f32x4){ss, 0.f, 0.f, 0.f};
        }
        float* bt = (float*)(ws + OFF_BTAB);
        for (int idx = blockIdx.x * 512 + tid; idx < 3 * 16 * 129; idx += gridDim.x * 512) {
            const int rel = idx % 129 - 64, h = (idx / 129) % 16, g = idx / (129 * 16); const int r = g == 0 ? 1 : (g == 1 ? 4 : 16);
            const int rr = rel * r, n = rr < 0 ? -rr : rr; int bk;
            if (n < 8) bk = n; else bk = 8 + (n >= 15) + (n >= 27) + (n >= 50) + (n >= 91) + (n >= 166) + (n >= 305) + (n >= 559);
            if (rr > 0) bk += 16;
            bt[idx] = p.in[4][bk * 48 + g * 16 + h];
        }
    }
}

__device__ void phase_final(const Params& p) {
    const float* part = (const float*)(p.ws + OFF_PART); const float* g = p.in[26];
    int tid = threadIdx.x; asm volatile("" : "+v"(tid)); const int lane = tid & 63, wid = tid >> 6, nwv = gridDim.x * 8, gw = blockIdx.x * 8 + wid;
    for (int row = gw; row < T; row += nwv) { const float rs = rstd_of(part, row);
#pragma unroll
        for (int i = 0; i < 4; ++i) { float* xp = p.X + (size_t)row * DM + i * 256 + lane * 4; const f32x4 v = ld_sys16f(xp); const f32x4 gg = *(const f32x4*)(g + i * 256 + lane * 4);
            *(f32x4*)xp = (f32x4){v[0] * rs * gg[0], v[1] * rs * gg[1], v[2] * rs * gg[2], v[3] * rs * gg[3]}; } }
}

__device__ void gla_combine(const Params& p, int h) {
    unsigned char* st = p.ws + OFF_STAGE; const float* OF = (const float*)(st + ST_OF); const float* OB = (const float*)(st + ST_OB); bf16_t* AB = (bf16_t*)(st + ST_ABUF);
    const float* gn = p.in[14] + h * 256;
    int tid = threadIdx.x; asm volatile("" : "+v"(tid)); const int lane = tid & 63, wid = tid >> 6, nwv = gridDim.x * 8, gw = blockIdx.x * 8 + wid;
    const f32x4 gg = *(const f32x4*)(gn + lane * 4);
    for (int row = gw; row < T; row += nwv) {
        const f32x4 a = ld_sys16f(OF + (size_t)row * 256 + lane * 4), b = ld_sys16f(OB + (size_t)row * 256 + lane * 4);
        const f32x4 o = a + b; float ss = (o[0] * o[0] + o[1] * o[1]) + (o[2] * o[2] + o[3] * o[3]);
#pragma unroll
        for (int s = 1; s < 64; s <<= 1) ss += __shfl_xor(ss, s);
        const float rs = rsqrtf(ss * (1.0f / 256.0f) + EPS);
        bf16_t* ap = AB + (size_t)row * DM + h * 256 + lane * 4; const u32x2 rr = ld_sys8(ap);
        const float r0 = __uint_as_float(rr.x << 16), r1 = __uint_as_float(rr.x & 0xffff0000u), r2 = __uint_as_float(rr.y << 16), r3 = __uint_as_float(rr.y & 0xffff0000u);
        u32x2 w; w.x = cvt_pk_bf16(o[0] * rs * gg[0] * r0, o[1] * rs * gg[1] * r1); w.y = cvt_pk_bf16(o[2] * rs * gg[2] * r2, o[3] * rs * gg[3] * r3);
        *(u32x2*)ap = w;
    }
}

constexpr int SC_QP = 0, SC_KP = 17408, SC_KT = 34816, SC_VT = 53248, SC_ATT = 62464, SC_SS = 71680, SC_QS = 89088, SC_BL = 91136;

template <bool OUT>
__device__ void gla_scan(const Params& p, LAS unsigned char* lds) {
    unsigned char* st = p.ws + OFF_STAGE;
    const bf16_t* QK = (const bf16_t*)(st + ST_QK); const float* GG = (const float*)(st + ST_GG); const bf16_t* VV = (const bf16_t*)(st + ST_VV);
    float* SLOC = (float*)(st + ST_SLOC); float* DVEC = (float*)(st + ST_DVEC);
    int tid = threadIdx.x; asm volatile("" : "+v"(tid)); const int lane = tid & 63, w = tid >> 6, l15 = lane & 15, quad = lane >> 4;
    LAS bf16_t* QP = (LAS bf16_t*)(lds + SC_QP); LAS bf16_t* KP = (LAS bf16_t*)(lds + SC_KP); LAS bf16_t* KT = (LAS bf16_t*)(lds + SC_KT);
    LAS bf16_t* VT = (LAS bf16_t*)(lds + SC_VT); LAS bf16_t* ATT = (LAS bf16_t*)(lds + SC_ATT); LAS bf16_t* SS = (LAS bf16_t*)(lds + SC_SS);
    LAS float* QS = (LAS float*)(lds + SC_QS); LAS float* BL = (LAS float*)(lds + SC_BL);
    for (int unit = blockIdx.x; unit < 256; unit += gridDim.x) {
        const int slice = unit & 3, dir = (unit >> 2) & 1, seg = unit >> 3;
        const int sfirst = seg < 8 ? 0 : (seg < 16 ? 8 : 16), nseg = seg < 16 ? 8 : 16;
        const int sigma = dir == 0 ? seg - sfirst : sfirst + nseg - 1 - seg;
        float* oout = (float*)(st + (dir == 0 ? ST_OF : ST_OB));
        f32x4 S[4];
#pragma unroll
        for (int d = 0; d < 4; ++d) S[d] = (f32x4){0.f, 0.f, 0.f, 0.f};
        if (OUT) {
            for (int sp = 0; sp < sigma; ++sp) {
                const int sg = dir == 0 ? sfirst + sp : sfirst + nseg - 1 - sp;
                const float* sl = SLOC + (size_t)(sg * 2 + dir) * 128 * 256; const float* dv = DVEC + (size_t)(sg * 2 + dir) * 128;
#pragma unroll
                for (int r = 0; r < 4; ++r) { const int dk = 16 * w + 4 * quad + r; const float dd = ldsys_f(dv + dk);
#pragma unroll
                    for (int d = 0; d < 4; ++d) S[d][r] = S[d][r] * dd + ldsys_f(sl + (size_t)dk * 256 + slice * 64 + d * 16 + l15); }
            }
        }
        float dsum = 0.f;
        const int dkc = tid & 127, qr = tid >> 7;
        const int dvc = tid & 63, jr = tid >> 6;
        for (int ch = 0; ch < 16; ++ch) {
            const int tb = seg * 1024 + (dir == 0 ? ch * 64 : (15 - ch) * 64);
            float g[16]; float q[16], k[16];
#pragma unroll
            for (int ii = 0; ii < 16; ++ii) { const int ip = qr * 16 + ii; const int tok = tb + (dir == 0 ? ip : 63 - ip);
                g[ii] = ldsys_f(GG + (size_t)tok * 256 + dir * 128 + dkc);
                if (OUT) q[ii] = bf2f(ldsys_h(QK + (size_t)tok * 256 + dkc));
                k[ii] = bf2f(ldsys_h(QK + (size_t)tok * 256 + 128 + dkc)); }
            unsigned vpk[4];
            { float v[8];
#pragma unroll
              for (int jj = 0; jj < 8; ++jj) { const int jp = jr * 8 + jj; const int tok = tb + (dir == 0 ? jp : 63 - jp); v[jj] = bf2f(ldsys_h(VV + (size_t)tok * 256 + slice * 64 + dvc)); }
#pragma unroll
              for (int jj = 0; jj < 4; ++jj) vpk[jj] = cvt_pk_bf16(v[2 * jj], v[2 * jj + 1]); }
#pragma unroll
            for (int ii = 1; ii < 16; ++ii) g[ii] += g[ii - 1];
            QS[qr * 128 + dkc] = g[15];
            *(LAS u32x4*)(VT + dvc * 72 + jr * 8) = (u32x4){vpk[0], vpk[1], vpk[2], vpk[3]};
            __syncthreads();
            float off = 0.f, tot = 0.f;
#pragma unroll
            for (int qq = 0; qq < 4; ++qq) { const float s = QS[qq * 128 + dkc]; tot += s; if (qq < qr) off += s; }
            if (qr == 0) { BL[dkc] = __expf(tot); dsum += tot; }
            unsigned kt[8];
#pragma unroll
            for (int ii = 0; ii < 16; ii += 2) {
                const float b0 = off + g[ii], b1 = off + g[ii + 1];
                if (OUT) { const int ip = qr * 16 + ii;
                    QP[ip * 136 + dkc] = f2bf(q[ii] * __expf(b0)); QP[(ip + 1) * 136 + dkc] = f2bf(q[ii + 1] * __expf(b1));
                    KP[ip * 136 + dkc] = f2bf(k[ii] * __expf(-b0)); KP[(ip + 1) * 136 + dkc] = f2bf(k[ii + 1] * __expf(-b1)); }
                kt[ii >> 1] = cvt_pk_bf16(k[ii] * __expf(tot - b0), k[ii + 1] * __expf(tot - b1));
            }
            *(LAS u32x4*)(KT + dkc * 72 + qr * 16) = (u32x4){kt[0], kt[1], kt[2], kt[3]};
            *(LAS u32x4*)(KT + dkc * 72 + qr * 16 + 8) = (u32x4){kt[4], kt[5], kt[6], kt[7]};
            if (OUT) {
#pragma unroll
                for (int d = 0; d < 4; ++d) { u32x2 sw; sw.x = cvt_pk_bf16(S[d][0], S[d][1]); sw.y = cvt_pk_bf16(S[d][2], S[d][3]);
                    *(LAS u32x2*)(SS + (d * 16 + l15) * 136 + 16 * w + 4 * quad) = sw; }
            }
            __syncthreads();
            f32x4 O[2];
            if (OUT) {
                const int it = w >> 1, c0 = (w & 1) * 2;
                f32x4 at[2] = {(f32x4){0.f, 0.f, 0.f, 0.f}, (f32x4){0.f, 0.f, 0.f, 0.f}};
                O[0] = (f32x4){0.f, 0.f, 0.f, 0.f}; O[1] = (f32x4){0.f, 0.f, 0.f, 0.f};
#pragma unroll
                for (int kk = 0; kk < 4; ++kk) {
                    const bf16x8 af = *(const LAS bf16x8*)(QP + (it * 16 + l15) * 136 + kk * 32 + quad * 8);
#pragma unroll
                    for (int x = 0; x < 2; ++x) {
                        const bf16x8 kf = *(const LAS bf16x8*)(KP + ((c0 + x) * 16 + l15) * 136 + kk * 32 + quad * 8);
                        at[x] = __builtin_amdgcn_mfma_f32_16x16x32_bf16(af, kf, at[x], 0, 0, 0);
                        const bf16x8 sf = *(const LAS bf16x8*)(SS + ((c0 + x) * 16 + l15) * 136 + kk * 32 + quad * 8);
                        O[x] = __builtin_amdgcn_mfma_f32_16x16x32_bf16(af, sf, O[x], 0, 0, 0);
                    }
                }
#pragma unroll
                for (int x = 0; x < 2; ++x)
#pragma unroll
                    for (int r = 0; r < 4; ++r) { const int i = it * 16 + quad * 4 + r, j = (c0 + x) * 16 + l15;
                        ATT[i * 72 + j] = f2bf(j <= i ? at[x][r] : 0.f); }
            }
            {
#pragma unroll
                for (int r = 0; r < 4; ++r) { const float dd = BL[16 * w + 4 * quad + r];
#pragma unroll
                    for (int d = 0; d < 4; ++d) S[d][r] *= dd; }
#pragma unroll
                for (int kk = 0; kk < 2; ++kk) {
                    const bf16x8 af = *(const LAS bf16x8*)(KT + (16 * w + l15) * 72 + kk * 32 + quad * 8);
#pragma unroll
                    for (int d = 0; d < 4; ++d) { const bf16x8 vf = *(const LAS bf16x8*)(VT + (d * 16 + l15) * 72 + kk * 32 + quad * 8);
                        S[d] = __builtin_amdgcn_mfma_f32_16x16x32_bf16(af, vf, S[d], 0, 0, 0); }
                }
            }
            if (OUT) {
                __syncthreads();
                const int it = w >> 1, c0 = (w & 1) * 2;
#pragma unroll
                for (int kk = 0; kk < 2; ++kk) {
                    const bf16x8 af = *(const LAS bf16x8*)(ATT + (it * 16 + l15) * 72 + kk * 32 + quad * 8);
#pragma unroll
                    for (int x = 0; x < 2; ++x) { const bf16x8 vf = *(const LAS bf16x8*)(VT + ((c0 + x) * 16 + l15) * 72 + kk * 32 + quad * 8);
                        O[x] = __builtin_amdgcn_mfma_f32_16x16x32_bf16(af, vf, O[x], 0, 0, 0); }
                }
#pragma unroll
                for (int x = 0; x < 2; ++x)
#pragma unroll
                    for (int r = 0; r < 4; ++r) { const int ip = it * 16 + quad * 4 + r; const int tok = tb + (dir == 0 ? ip : 63 - ip);
                        oout[(size_t)tok * 256 + slice * 64 + (c0 + x) * 16 + l15] = O[x][r]; }
            }
            __syncthreads();
        }
        if (!OUT) {
            float* sl = SLOC + (size_t)(seg * 2 + dir) * 128 * 256;
#pragma unroll
            for (int r = 0; r < 4; ++r) { const int dk = 16 * w + 4 * quad + r;
#pragma unroll
                for (int d = 0; d < 4; ++d) sl[(size_t)dk * 256 + slice * 64 + d * 16 + l15] = S[d][r]; }
            if (slice == 0 && tid < 128) DVEC[(size_t)(seg * 2 + dir) * 128 + tid] = __expf(dsum);
        }
    }
}

__device__ void dil_attn(const Params& p, int hc, LAS unsigned char* lds) {
    unsigned char* st = p.ws + OFF_STAGE; bf16_t* AB = (bf16_t*)(st + ST_ABUF); const float* btab = (const float*)(p.ws + OFF_BTAB);
    LAS float* OST = (LAS float*)lds; LAS float* MST = (LAS float*)(lds + 69632); LAS float* LST = (LAS float*)(lds + 70656);
    int tid = threadIdx.x; asm volatile("" : "+v"(tid)); const int lane = tid & 63, w = tid >> 6, l15 = lane & 15, quad = lane >> 4;
    for (int unit = blockIdx.x; unit < 512; unit += gridDim.x) {
        const int hl = unit & 3, tbk = unit >> 2, t0 = tbk * 256;
        const int sb = t0 < 8192 ? 0 : (t0 < 16384 ? 8192 : 16384), Sq = t0 < 16384 ? 8192 : 16384;
        const int h = hc * 4 + hl;
#pragma unroll 1
        for (int g = 0; g < 3; ++g) {
            const int r = g == 0 ? 1 : (g == 1 ? 4 : 16), L = Sq / r;
            const bf16_t* QKg = (const bf16_t*)(st + ST_QKG) + (size_t)g * T * 512; const bf16_t* VTg = (const bf16_t*)(st + ST_VTG) + (size_t)g * 256 * T;
            const float* bt = btab + (g * 16 + h) * 129;
#pragma unroll 1
            for (int itx = 0; itx < 2; ++itx) {
                const int item = 2 * w + itx;
                int c, l0;
                if (g == 0) { c = 0; l0 = (t0 - sb) + 16 * item; } else if (g == 1) { c = item & 3; l0 = (t0 - sb) / 4 + 16 * (item >> 2); } else { c = item; l0 = (t0 - sb) / 16; }
                const int nq0 = sb + c * L + l0;
                const int tokl = (l0 + l15) * r + c - (t0 - sb);
                bf16x8 qf[2];
#pragma unroll
                for (int kk = 0; kk < 2; ++kk) qf[kk] = ld_sys16(QKg + (unsigned)((nq0 + l15) * 512 + hl * 64 + kk * 32 + quad * 8));
                const int kap = ((l15 >> 2) << 3) + (l15 & 3);
                const int nbase = sb + c * L + l0 - 64;
                f32x4 sT[10];
#pragma unroll
                for (int hb = 0; hb < 3; ++hb) {
                    bf16x8 kfr[4][2];
#pragma unroll
                    for (int kq = 0; kq < (hb == 2 ? 2 : 4); ++kq) { const int kt = hb * 4 + kq, kp = kt >> 1, ab = kt & 1;
                        const int lkh = l0 - 64 + 32 * kp + 16 * (l15 >> 3); const bool inr = (lkh >= 0) && (lkh < L);
                        const int nrow = inr ? nbase + 32 * kp + kap + 4 * ab : nq0 + l15;
#pragma unroll
                        for (int kk = 0; kk < 2; ++kk) kfr[kq][kk] = ld_sys16(QKg + (unsigned)(nrow * 512 + 256 + hl * 64 + kk * 32 + quad * 8));
                    }
#pragma unroll
                    for (int kq = 0; kq < (hb == 2 ? 2 : 4); ++kq) {
                        f32x4 a = (f32x4){0.f, 0.f, 0.f, 0.f};
#pragma unroll
                        for (int kk = 0; kk < 2; ++kk) a = __builtin_amdgcn_mfma_f32_16x16x32_bf16(kfr[kq][kk], qf[kk], a, 0, 0, 0);
                        sT[hb * 4 + kq] = a;
                    }
                    asm volatile("" ::: "memory");
                }
                bf16x8 vfa[3][4];
#pragma unroll
                for (int kp = 0; kp < 3; ++kp) {
                    const int lkh = l0 - 64 + 32 * kp + 16 * (quad >> 1); const bool inr = (lkh >= 0) && (lkh < L);
                    const int ncol = inr ? nbase + 32 * kp + quad * 8 : nq0;
#pragma unroll
                    for (int d = 0; d < 4; ++d) vfa[kp][d] = ld_sys16(VTg + (unsigned)((hl * 64 + d * 16 + l15) * T + ncol));
                }
#pragma unroll
                for (int kt = 0; kt < 10; ++kt) { const int kp = kt >> 1, ab = kt & 1;
                    const int lkh = l0 - 64 + 32 * kp + 16 * (quad >> 1); const bool inr = (lkh >= 0) && (lkh < L);
#pragma unroll
                    for (int rr = 0; rr < 4; ++rr) { const int rel = -64 + 32 * kp + quad * 8 + 4 * ab + rr - l15; const bool ok = inr && rel >= -64 && rel <= 64;
                        const int ri = rel < -64 ? 0 : (rel > 64 ? 128 : rel + 64);
                        sT[kt][rr] = ok ? sT[kt][rr] + bt[ri] : -1.0e30f; }
                }
                float mo = -1.0e30f, lo = 0.f;
                f32x4 O[4];
#pragma unroll
                for (int d = 0; d < 4; ++d) O[d] = (f32x4){0.f, 0.f, 0.f, 0.f};
                if (g > 0) { mo = MST[tokl]; lo = LST[tokl];
#pragma unroll
                    for (int d = 0; d < 4; ++d) O[d] = *(const LAS f32x4*)(OST + tokl * 68 + d * 16 + quad * 4); }
                float mx = mo;
#pragma unroll
                for (int kt = 0; kt < 10; ++kt)
#pragma unroll
                    for (int rr = 0; rr < 4; ++rr) mx = fmaxf(mx, sT[kt][rr]);
                mx = fmaxf(mx, __shfl_xor(mx, 16)); mx = fmaxf(mx, __shfl_xor(mx, 32));
                const float alpha = __expf(mo - mx);
                float ls = 0.f;
#pragma unroll
                for (int kt = 0; kt < 10; ++kt)
#pragma unroll
                    for (int rr = 0; rr < 4; ++rr) { const float e = __expf(sT[kt][rr] - mx); sT[kt][rr] = e; ls += e; }
                ls += __shfl_xor(ls, 16); ls += __shfl_xor(ls, 32);
                const float ln = lo * alpha + ls;
#pragma unroll
                for (int d = 0; d < 4; ++d) O[d] *= alpha;
#pragma unroll
                for (int hb = 0; hb < 2; ++hb) {
                    bf16x8 vfb[2][4];
                    if (hb == 1) {
#pragma unroll
                        for (int kp = 3; kp < 5; ++kp) {
                            const int lkh = l0 - 64 + 32 * kp + 16 * (quad >> 1); const bool inr = (lkh >= 0) && (lkh < L);
                            const int ncol = inr ? nbase + 32 * kp + quad * 8 : nq0;
#pragma unroll
                            for (int d = 0; d < 4; ++d) vfb[kp - 3][d] = ld_sys16(VTg + (unsigned)((hl * 64 + d * 16 + l15) * T + ncol));
                        }
                    }
#pragma unroll
                    for (int kq = 0; kq < (hb == 0 ? 3 : 2); ++kq) { const int kp = hb * 3 + kq;
                        bf16x8 pf; { const unsigned p0 = cvt_pk_bf16(sT[2 * kp][0], sT[2 * kp][1]), p1 = cvt_pk_bf16(sT[2 * kp][2], sT[2 * kp][3]),
                                                    p2 = cvt_pk_bf16(sT[2 * kp + 1][0], sT[2 * kp + 1][1]), p3 = cvt_pk_bf16(sT[2 * kp + 1][2], sT[2 * kp + 1][3]);
                                     u32x4 pw = (u32x4){p0, p1, p2, p3}; pf = __builtin_bit_cast(bf16x8, pw); }
#pragma unroll
                        for (int d = 0; d < 4; ++d) { const bf16x8 vf = hb == 0 ? vfa[kq < 3 ? kq : 0][d] : vfb[kq < 2 ? kq : 0][d];
                            O[d] = __builtin_amdgcn_mfma_f32_16x16x32_bf16(vf, pf, O[d], 0, 0, 0); }
                    }
                }
                if (g < 2) {
                    if (quad == 0) { MST[tokl] = mx; LST[tokl] = ln; }
#pragma unroll
                    for (int d = 0; d < 4; ++d) *(LAS f32x4*)(OST + tokl * 68 + d * 16 + quad * 4) = O[d];
                } else {
                    const float inv = 1.0f / ln;
#pragma unroll
                    for (int d = 0; d < 4; ++d) { u32x2 ow; ow.x = cvt_pk_bf16(O[d][0] * inv, O[d][1] * inv); ow.y = cvt_pk_bf16(O[d][2] * inv, O[d][3] * inv);
                        *(u32x2*)(AB + (size_t)(t0 + tokl) * DM + h * 64 + d * 16 + quad * 4) = ow; }
                }
            }
            __syncthreads();
        }
    }
}

#define XB_TMO      128
#define XB_XCNT(j)  (256  + 64 * (j))
#define XB_XSUB(j)  (1280 + 64 * (j))
#define XB_XGEN(j)  (2304 + 64 * (j))
#define XB_TOP      3328
#define XB_TOPGEN   3392
#define XCD_BAR_WORDS 3456
#define XB_SPIN_CAP (1u << 22)
__device__ __forceinline__ unsigned xb_ld(unsigned* p)              { return __hip_atomic_load(p, __ATOMIC_RELAXED, __HIP_MEMORY_SCOPE_AGENT); }
__device__ __forceinline__ unsigned xb_add(unsigned* p, unsigned v) { return __hip_atomic_fetch_add(p, v, __ATOMIC_RELAXED, __HIP_MEMORY_SCOPE_AGENT); }
__device__ __forceinline__ unsigned xb_xcc_id() { return (unsigned)__builtin_amdgcn_s_getreg((3 << 11) | 20) & 0xFu; }
#define XB_SPIN(cond, bar) do { unsigned _sp = 0; while (cond) { __builtin_amdgcn_s_sleep(1); \
    if ((++_sp & 255u) == 0u) { if (xb_ld(&(bar)[XB_TMO])) break; if (_sp > XB_SPIN_CAP) { atomicAdd(&(bar)[XB_TMO], 1u); break; } } } } while (0)
struct XcdBarrier { unsigned* bar; unsigned x; volatile LAS unsigned* st; };
__device__ __forceinline__ XcdBarrier xcd_barrier_post(unsigned* bar, volatile LAS unsigned* st) {
    XcdBarrier b; b.bar = bar; b.x = xb_xcc_id(); b.st = st;
    if (threadIdx.x == 0) (void)xb_add(&bar[XB_XCNT(b.x)], 1u);
    return b;
}
__device__ __forceinline__ void xcd_barrier_complete(unsigned* bar, unsigned x, unsigned& nloc, unsigned& nx) {
    const unsigned G = gridDim.x * gridDim.y * gridDim.z;
    unsigned sum, cnt, mine, sp = 0u;
    for (;;) {
        sum = 0u; cnt = 0u; mine = 0u;
#pragma unroll
        for (unsigned j = 0; j < 16; ++j) { const unsigned c = xb_ld(&bar[XB_XCNT(j)]); sum += c; cnt += (c > 0u) ? 1u : 0u; mine = (j == x) ? c : mine; }
        if (sum == G) break;
        __builtin_amdgcn_s_sleep(1);
        if ((++sp & 255u) == 0u) { if (xb_ld(&bar[XB_TMO])) break; if (sp > XB_SPIN_CAP) { atomicAdd(&bar[XB_TMO], 1u); break; } }
    }
    nloc = mine > 0u ? mine : 1u; nx = cnt > 0u ? cnt : 1u;
}
__device__ __forceinline__ void xcd_barrier(const XcdBarrier& b) {
    asm volatile("s_waitcnt vmcnt(0)" ::: "memory");
    __syncthreads();
    if (threadIdx.x == 0) {
        unsigned* bar = b.bar;
        __builtin_amdgcn_s_waitcnt(0);
        unsigned nloc = b.st[0], nx = b.st[1];
        if (nloc == 0u) { xcd_barrier_complete(bar, b.x, nloc, nx); b.st[0] = nloc; b.st[1] = nx; }
        const unsigned old = xb_add(&bar[XB_XSUB(b.x)], 1u);
        const unsigned gen = old / nloc;
        if (old + 1u == (gen + 1u) * nloc) {
            __builtin_amdgcn_fence(__ATOMIC_RELEASE, "agent");
            asm volatile("s_waitcnt vmcnt(0)" ::: "memory");
            const unsigned og = xb_add(&bar[XB_TOP], 1u);
            const unsigned tg = og / nx;
            if (og + 1u == (tg + 1u) * nx) xb_add(&bar[XB_TOPGEN], 1u);
            else XB_SPIN(xb_ld(&bar[XB_TOPGEN]) == tg, bar);
            __builtin_amdgcn_fence(__ATOMIC_ACQUIRE, "agent");
            xb_add(&bar[XB_XGEN(b.x)], 1u);
            asm volatile("s_waitcnt vmcnt(0)" ::: "memory");
        } else {
            XB_SPIN(xb_ld(&bar[XB_XGEN(b.x)]) == gen, bar);
            __builtin_amdgcn_fence(__ATOMIC_ACQUIRE, "agent");
            asm volatile("s_waitcnt vmcnt(0)" ::: "memory");
        }
    }
    __syncthreads();
}

__global__ void __launch_bounds__(512, 2) fwd_megakernel(Params p) {
    extern __shared__ __attribute__((aligned(16))) unsigned char smem[];
    LAS unsigned char* lds = (LAS unsigned char*)smem;
    cg::grid_group grid = cg::this_grid();
    if (threadIdx.x < 2) ((volatile LAS unsigned*)(lds + LDS_CTL))[threadIdx.x] = 0u;
    __syncthreads();
    const XcdBarrier bar = xcd_barrier_post((unsigned*)(p.ws + OFF_CTL), (volatile LAS unsigned*)(lds + LDS_CTL));
    grid.sync();
    unsigned char* ws = p.ws; bf16_t* WB = (bf16_t*)ws; bf16_t* XB = (bf16_t*)(ws + OFF_XB); float* part = (float*)(ws + OFF_PART);
    unsigned char* st = ws + OFF_STAGE;
    for (int ph = p.ph_lo; ph < p.ph_hi; ++ph) {
        if (ph > p.ph_lo) { for (int xs = 0; xs <= PROBE_SYNC; ++xs) xcd_barrier(bar); }
        if (ph == 37) { phase_final(p); continue; }
        const int layer = ph >= 21 ? 1 : 0, q = ph - layer * 21;
        int op = -1, arg = 0;
        if (q == 0) op = 0; else if (q == 1) op = 1; else if (q == 2) op = 2;
        else if (layer == 0) {
            if (q <= 14) { const int hh = (q - 3) / 3, s = (q - 3) % 3; arg = hh; op = 10 + s; }
            else if (q == 15) { op = 13; arg = 3; } else op = q - 16 + 3;
        } else {
            if (q <= 10) { arg = (q - 3) >> 1; op = 20 + ((q - 3) & 1); } else op = q - 11 + 3;
        }
        if (op == 10 && arg > 0) gla_combine(p, arg - 1);
        for (int rep = 0; rep < (((PROBE_REP >> op) & 1u) ? 2 : 1); ++rep) {
        if (op == 0) { if (EN(0)) phase_prologue(p, layer, lds); }
        else if (op == 11) { if (EN(11)) gla_scan<false>(p, lds); }
        else if (op == 12) { if (EN(12)) gla_scan<true>(p, lds); }
        else if (op == 13) { if (EN(13)) gla_combine(p, arg); }
        else if (op == 21) { if (EN(21)) dil_attn(p, arg, lds); }
        else if (EN(1)) {
            GemmJob J;
            for (int j = 0; j < 8; ++j) { if (!get_job(p, op, arg, j, J)) break;
                const float* part = (const float*)(ws + OFF_PART); const int kind = J.e.kind;
                if (EN(22) && kind == 0) { EpiPlain e{(bf16_t*)(ws + J.e.o_off), J.e.ldc, J.e.bstride}; gemm_phase(lds, J.K, J.lda, J.ldb, J.s, e); }
                else if (EN(23) && kind == 1) { EpiSwiGLU e{(bf16_t*)(ws + J.e.o_off), part}; gemm_phase(lds, DM, DM, DM, J.s, e); }
                else if (EN(24) && kind == 2) { EpiResid e{p.X, XB, (float*)(ws + OFF_PART), J.e.scale, (LAS float*)(lds + LDS_X)}; gemm_phase(lds, J.K, J.K, J.K, J.s, e); }
                else if (EN(25) && kind == 3) { EpiGlaProj e{(bf16_t*)(st + ST_QK), (float*)(st + ST_GG), (bf16_t*)(st + ST_VV), (bf16_t*)(st + ST_ABUF), part, p.in[11], p.in[13], J.e.h}; gemm_phase(lds, DM, DM, DM, J.s, e); }
                else if (EN(26) && kind == 4) { EpiDilQK e{(bf16_t*)(ws + J.e.o_off), part, J.e.r}; gemm_phase(lds, DM, J.lda, DM, J.s, e); }
                else if (EN(27) && kind == 5) { EpiDilVT e{(bf16_t*)(ws + J.e.o_off), part, J.e.r}; gemm_phase(lds, DM, DM, J.ldb, J.s, e); }
                else if (EN(28) && kind == 6) { EpiScores e{(bf16_t*)(ws + J.e.o_off), part, (LAS f32x2*)(lds + LDS_X)}; gemm_phase(lds, DM, DM, DM, J.s, e); }
            }
        }
        __syncthreads();
        }
    }
}

extern "C" void kernel_launch(void* const* d_in, const int* in_sizes, int n_in, void* d_out, int out_size, void* d_ws, size_t ws_size, hipStream_t stream) {
    static int grid_blocks = 0;
    if (!grid_blocks) {
        int dev = 0, cus = 0, per_cu = 0;
        hipGetDevice(&dev);
        hipDeviceGetAttribute(&cus, hipDeviceAttributeMultiprocessorCount, dev);
        hipFuncSetAttribute((const void*)fwd_megakernel, hipFuncAttributeMaxDynamicSharedMemorySize, LDS_BYTES);
        hipOccupancyMaxActiveBlocksPerMultiprocessor(&per_cu, fwd_megakernel, 512, LDS_BYTES);
        if (per_cu < 1) per_cu = 1;
        if (per_cu > 1) per_cu = 1;
        grid_blocks = cus * per_cu;
    }
    if (n_in != 27 || ws_size < WS_NEED) { fprintf(stderr, "kernel_launch: unexpected n_in %d / ws_size %zu (need %zu)\n", n_in, ws_size, (size_t)WS_NEED); return; }
    hipMemsetAsync((char*)d_ws + OFF_CTL, 0, CTL_BYTES, stream);
    Params p{};
    for (int i = 0; i < 27; ++i) p.in[i] = (const float*)d_in[i];
    p.X = (float*)d_out; p.ws = (unsigned char*)d_ws; p.ph_lo = 0; p.ph_hi = 38;
    void* args[] = {&p};
    hipError_t e = hipLaunchCooperativeKernel((const void*)fwd_megakernel, dim3(grid_blocks), dim3(512), args, LDS_BYTES, stream);
    if (e != hipSuccess) fprintf(stderr, "cooperative launch failed: %s (grid %d)\n", hipGetErrorString(e), grid_blocks);
}
```

```cpp
#include <hip/hip_runtime.h>
#include <hip/hip_cooperative_groups.h>
#include <cstdio>
#include <cstdint>
namespace cg = cooperative_groups;

#define LAS __attribute__((address_space(3)))
typedef unsigned short bf16_t;
typedef short bf16x8 __attribute__((ext_vector_type(8)));
typedef short bf16x4 __attribute__((ext_vector_type(4)));
typedef float f32x4 __attribute__((ext_vector_type(4)));
typedef float f32x2 __attribute__((ext_vector_type(2)));
typedef unsigned u32x4 __attribute__((ext_vector_type(4)));
typedef unsigned u32x2 __attribute__((ext_vector_type(2)));

#ifndef OPMASK
#define OPMASK 0xFFFFFFFFu
#endif
#define EN(o) ((OPMASK >> (o)) & 1u)
#ifndef PROBE_REP
#define PROBE_REP 0u
#endif
#ifndef PROBE_SYNC
#define PROBE_SYNC 0
#endif
constexpr int T = 32768, DM = 1024, DFF = 2816;
constexpr float EPS = 1e-6f;
constexpr int BM = 256, BK = 64, HALF = 128, HTB = HALF * BK * 2, STAGE_BYTES = 8 * HTB, NXCD = 8, WGM = 8;
constexpr int LDS_X = STAGE_BYTES;
constexpr int LDS_BYTES = 160 * 1024;
constexpr int LDS_CTL = LDS_BYTES - 64;

constexpr size_t E_FFN1_IN = 0, E_FFN1_OUT = 5767168, E_FFN2_IN = 8650752, E_FFN2_OUT = 14417920, E_CQ = 17301504, E_CKV = 18350080,
                 E_CO = 20447232, E_MIX_IN = 21495808, E_MIX_OUT = 30932992, E_GT = 31981568, E_HM = 35127296, E_WEND = 38273024;
constexpr size_t OFF_XB = E_WEND * 2, OFF_PART = OFF_XB + (size_t)T * DM * 2, OFF_BTAB = OFF_PART + (size_t)T * 16, OFF_STAGE = OFF_BTAB + 32768;
constexpr size_t ST_HID = 0, ST_MEMN = 184549376, ST_KV = 186122240;
constexpr size_t ST_ABUF = 0, ST_QK = 67108864, ST_GG = 83886080, ST_VV = 117440512, ST_OF = 134217728, ST_OB = 167772160, ST_SLOC = 201326592, ST_DVEC = 209715200;
constexpr size_t ST_QKG = 67108864, ST_VTG = 167772160;
constexpr size_t OFF_CTL = OFF_STAGE + 218103808;
constexpr size_t CTL_BYTES = 16384;
constexpr size_t WS_NEED = OFF_CTL + CTL_BYTES;

struct Params {
    const float* in[27];
    float* X;
    unsigned char* ws;
    int ph_lo, ph_hi;
};

__device__ __forceinline__ unsigned cvt_pk_bf16(float lo, float hi) { unsigned r; asm volatile("v_cvt_pk_bf16_f32 %0, %1, %2" : "=v"(r) : "v"(lo), "v"(hi)); return r; }
__device__ __forceinline__ float bf2f(bf16_t b) { return __uint_as_float(((unsigned)b) << 16); }
__device__ __forceinline__ bf16_t f2bf(float f) { return (bf16_t)(cvt_pk_bf16(f, 0.f) & 0xffffu); }

__host__ __device__ __forceinline__ int lds_byte(int r, int c) { const int st = (r >> 4) * 2 + (c >> 5), rr = r & 15, cc = c & 31, ob = rr * 64 + cc * 2; return st * 1024 + (ob ^ (((ob >> 9) & 1) << 5)); }
__host__ __device__ __forceinline__ void stage_rc(int b, int& R, int& C) { const int st = b / 1024, sb = b % 1024, swz = sb ^ (((sb >> 9) & 1) << 5); R = (st >> 1) * 16 + swz / 64; C = (st & 1) * 32 + (swz % 64) / 2; }
__host__ __device__ __forceinline__ int perm32(int rho) { const int n = rho >> 4, i = rho & 15; return 8 * (i >> 2) + 4 * n + (i & 3); }

struct Unit { int pm, pn, b; const char* a; const char* bt; };

__device__ __forceinline__ int dil_token0(int n0, int r) {
    const int sb = n0 < 8192 ? 0 : (n0 < 16384 ? 8192 : 16384), S = n0 < 16384 ? 8192 : 16384, L = S / r;
    const int c = (n0 - sb) / L, l0 = (n0 - sb) % L;
    return sb + l0 * r + c;
}

struct Sched {
    const char* A; const char* Bt;
    int a_tile, b_tile, a_batch, b_batch, seqB;
    int nM, nN, nB, G, c, mode, r;
    __device__ __forceinline__ bool next(int i, Unit& u) const {
        const int per = nM * nN; const long tot = (long)per * nB;
        const long L = (long)i * G + c; if (L >= tot) return false;
        int b = (int)(L / per); int wgid = (int)(L % per);
        { const int q = per / NXCD, rr = per % NXCD, xcd = wgid % NXCD, off = wgid / NXCD; wgid = (xcd < rr ? xcd * (q + 1) : rr * (q + 1) + (xcd - rr) * q) + off; }
        const int nig = WGM * nN, gid = wgid / nig, fm = gid * WGM, gsz = (nM - fm) < WGM ? (nM - fm) : WGM;
        u.pm = fm + ((wgid % nig) % gsz); u.pn = (wgid % nig) / gsz; u.b = b;
        const char* a = A + (long)b * a_batch; const char* bt = Bt + (long)b * b_batch;
        if (mode == 2) a += (long)dil_token0(u.pm * 256, r) * (DM * 2); else a += (long)u.pm * a_tile;
        if (mode == 3) bt += (long)dil_token0(u.pn * 256, r) * (DM * 2); else bt += (long)u.pn * b_tile;
        if (mode == 1) { const int s = u.pm < 32 ? 0 : (u.pm < 64 ? 1 : 2); bt += (long)s * seqB; }
        u.a = a; u.bt = bt; return true;
    }
};


typedef unsigned long long u64_t;
__device__ __forceinline__ float ldsys_f(const float* p) { return __hip_atomic_load(p, __ATOMIC_RELAXED, __HIP_MEMORY_SCOPE_SYSTEM); }
__device__ __forceinline__ bf16_t ldsys_h(const bf16_t* p) { return __hip_atomic_load(p, __ATOMIC_RELAXED, __HIP_MEMORY_SCOPE_SYSTEM); }
__device__ __forceinline__ u32x2 ld_sys8(const void* p) {
    const u64_t a = __hip_atomic_load((const u64_t*)p, __ATOMIC_RELAXED, __HIP_MEMORY_SCOPE_SYSTEM); return (u32x2){(unsigned)a, (unsigned)(a >> 32)};
}
__device__ __forceinline__ u32x4 ld_sys16u(const void* p) {
    const u64_t* q = (const u64_t*)p;
    const u64_t a = __hip_atomic_load(q, __ATOMIC_RELAXED, __HIP_MEMORY_SCOPE_SYSTEM), b = __hip_atomic_load(q + 1, __ATOMIC_RELAXED, __HIP_MEMORY_SCOPE_SYSTEM);
    return (u32x4){(unsigned)a, (unsigned)(a >> 32), (unsigned)b, (unsigned)(b >> 32)};
}
__device__ __forceinline__ bf16x8 ld_sys16(const void* p) { return __builtin_bit_cast(bf16x8, ld_sys16u(p)); }
__device__ __forceinline__ f32x4 ld_sys16f(const void* p) { return __builtin_bit_cast(f32x4, ld_sys16u(p)); }

__device__ __forceinline__ float rstd_of(const float* part, int row) {
    const f32x4 p = ld_sys16f(part + (size_t)row * 4);
    return rsqrtf(((p[0] + p[1]) + (p[2] + p[3])) * (1.0f / 1024.0f) + EPS);
}


__device__ __forceinline__ void rstd8(const float* part, int row0, float (&rs)[8]) {
    f32x4 pp[8];
#pragma unroll
    for (int i = 0; i < 8; ++i) pp[i] = ld_sys16f(part + (size_t)(row0 + (i >> 2) * 128 + (i & 3) * 16) * 4);
#pragma unroll
    for (int i = 0; i < 8; ++i) rs[i] = rsqrtf(((pp[i][0] + pp[i][1]) + (pp[i][2] + pp[i][3])) * (1.0f / 1024.0f) + EPS);
}

#define LBAR() do { asm volatile("s_waitcnt lgkmcnt(0)" ::: "memory"); __builtin_amdgcn_s_barrier(); asm volatile("" ::: "memory"); } while (0)

struct EpiPlain {
    bf16_t* O; int ldc; int bstride;
    __device__ __forceinline__ void operator()(const f32x4 (&acc)[2][2][4][2], const Unit& u, int wr, int wc, int fr, int fq) const {
        bf16_t* base = O + (long)u.b * bstride;
#pragma unroll
        for (int ai = 0; ai < 2; ++ai)
#pragma unroll
            for (int m = 0; m < 4; ++m) { const int row = u.pm * 256 + ai * 128 + wr * 64 + m * 16 + fr;
#pragma unroll
                for (int bj = 0; bj < 2; ++bj) { const int col = u.pn * 256 + bj * 128 + wc * 32 + 8 * fq;
                    const f32x4 v0 = acc[ai][bj][m][0], v1 = acc[ai][bj][m][1];
                    u32x4 w; w.x = cvt_pk_bf16(v0[0], v0[1]); w.y = cvt_pk_bf16(v0[2], v0[3]); w.z = cvt_pk_bf16(v1[0], v1[1]); w.w = cvt_pk_bf16(v1[2], v1[3]);
                    *(u32x4*)(base + (long)row * ldc + col) = w; } }
    }
};
struct EpiSwiGLU {
    bf16_t* H; const float* part;
    __device__ __forceinline__ void operator()(const f32x4 (&acc)[2][2][4][2], const Unit& u, int wr, int wc, int fr, int fq) const {
        float rs8[8]; rstd8(part, u.pm * 256 + wr * 64 + fr, rs8);
#pragma unroll
        for (int ai = 0; ai < 2; ++ai)
#pragma unroll
            for (int m = 0; m < 4; ++m) { const int row = u.pm * 256 + ai * 128 + wr * 64 + m * 16 + fr; const float rs = rs8[ai * 4 + m];
                float h[8];
#pragma unroll
                for (int n = 0; n < 2; ++n)
#pragma unroll
                    for (int j = 0; j < 4; ++j) { const float a = acc[ai][0][m][n][j] * rs, b = acc[ai][1][m][n][j] * rs; h[n * 4 + j] = a * b / (1.0f + __expf(-a)); }
                u32x4 w; w.x = cvt_pk_bf16(h[0], h[1]); w.y = cvt_pk_bf16(h[2], h[3]); w.z = cvt_pk_bf16(h[4], h[5]); w.w = cvt_pk_bf16(h[6], h[7]);
                *(u32x4*)(H + (long)row * DFF + u.pn * 128 + wc * 32 + 8 * fq) = w; }
    }
};
struct EpiResid {
    float* X; bf16_t* XB; float* part; float scale; LAS float* xt;
    __device__ __forceinline__ void operator()(const f32x4 (&acc)[2][2][4][2], const Unit& u, int wr, int wc, int fr, int fq) const {
#pragma unroll
        for (int ai = 0; ai < 2; ++ai)
#pragma unroll
            for (int m = 0; m < 4; ++m) { const int rl = ai * 128 + wr * 64 + m * 16 + fr; const long row = (long)u.pm * 256 + rl; float ss = 0.f;
#pragma unroll
                for (int bj = 0; bj < 2; ++bj) { const int col = u.pn * 256 + bj * 128 + wc * 32 + 8 * fq;
                    float* xp = X + row * DM + col;
                    f32x4 x0 = *(const f32x4*)xp, x1 = *(const f32x4*)(xp + 4);
                    x0 += acc[ai][bj][m][0] * scale; x1 += acc[ai][bj][m][1] * scale;
                    *(f32x4*)xp = x0; *(f32x4*)(xp + 4) = x1;
                    u32x4 w; w.x = cvt_pk_bf16(x0[0], x0[1]); w.y = cvt_pk_bf16(x0[2], x0[3]); w.z = cvt_pk_bf16(x1[0], x1[1]); w.w = cvt_pk_bf16(x1[2], x1[3]);
                    *(u32x4*)(XB + row * DM + col) = w;
                    ss += (x0[0] * x0[0] + x0[1] * x0[1]) + (x0[2] * x0[2] + x0[3] * x0[3]) + (x1[0] * x1[0] + x1[1] * x1[1]) + (x1[2] * x1[2] + x1[3] * x1[3]); }
                ss += __shfl_xor(ss, 16); ss += __shfl_xor(ss, 32);
                if (fq == 0) xt[rl * 4 + wc] = ss;
                asm volatile("" ::: "memory"); }
        LBAR();
        const int lane = fq * 16 + fr;
        if (lane < 32) { const int q = wc * 32 + lane, rl = (q >> 6) * 128 + wr * 64 + (q & 63);
            const f32x4 s = *(const LAS f32x4*)(xt + rl * 4);
            part[((size_t)u.pm * 256 + rl) * 4 + u.pn] = (s[0] + s[1]) + (s[2] + s[3]); }
    }
};
struct EpiGlaProj {
    bf16_t* QK; float* GG; bf16_t* VV; bf16_t* AB; const float* part; const float* bgf; const float* bgb; int h;
    __device__ __forceinline__ void operator()(const f32x4 (&acc)[2][2][4][2], const Unit& u, int wr, int wc, int fr, int fq) const {
        float rs8[8]; rstd8(part, u.pm * 256 + wr * 64 + fr, rs8);
#pragma unroll
        for (int ai = 0; ai < 2; ++ai)
#pragma unroll
            for (int m = 0; m < 4; ++m) { const long row = (long)u.pm * 256 + ai * 128 + wr * 64 + m * 16 + fr; const float rs = rs8[ai * 4 + m];
#pragma unroll
                for (int bj = 0; bj < 2; ++bj) { const int col = bj * 128 + wc * 32 + 8 * fq;
                    f32x4 v0 = acc[ai][bj][m][0] * rs, v1 = acc[ai][bj][m][1] * rs;
                    if (u.pn == 1) {
                        const float* bp = (bj == 0 ? bgf : bgb) + h * 128 + wc * 32 + 8 * fq;
                        const f32x4 b0 = *(const f32x4*)bp, b1 = *(const f32x4*)(bp + 4);
#pragma unroll
                        for (int j = 0; j < 4; ++j) { float z = v0[j] + b0[j]; v0[j] = (fminf(z, 0.f) - log1pf(__expf(-fabsf(z)))) * (1.0f / 16.0f);
                                                      z = v1[j] + b1[j]; v1[j] = (fminf(z, 0.f) - log1pf(__expf(-fabsf(z)))) * (1.0f / 16.0f); }
                        float* gp = GG + row * 256 + col; *(f32x4*)gp = v0; *(f32x4*)(gp + 4) = v1;
                    } else {
                        if (u.pn == 3) {
#pragma unroll
                            for (int j = 0; j < 4; ++j) { v0[j] = v0[j] / (1.0f + __expf(-v0[j])); v1[j] = v1[j] / (1.0f + __expf(-v1[j])); } }
                        u32x4 w; w.x = cvt_pk_bf16(v0[0], v0[1]); w.y = cvt_pk_bf16(v0[2], v0[3]); w.z = cvt_pk_bf16(v1[0], v1[1]); w.w = cvt_pk_bf16(v1[2], v1[3]);
                        bf16_t* dst = u.pn == 0 ? QK + row * 256 + col : (u.pn == 2 ? VV + row * 256 + col : AB + row * DM + h * 256 + col);
                        *(u32x4*)dst = w; } } }
    }
};
struct EpiDilQK {
    bf16_t* O; const float* part; int r;
    __device__ __forceinline__ void operator()(const f32x4 (&acc)[2][2][4][2], const Unit& u, int wr, int wc, int fr, int fq) const {
        const int tok0 = dil_token0(u.pm * 256, r);
        float rs8[8];
        { f32x4 pp[8];
#pragma unroll
          for (int i = 0; i < 8; ++i) pp[i] = ld_sys16f(part + (size_t)(tok0 + ((i >> 2) * 128 + wr * 64 + (i & 3) * 16 + fr) * r) * 4);
#pragma unroll
          for (int i = 0; i < 8; ++i) rs8[i] = rsqrtf(((pp[i][0] + pp[i][1]) + (pp[i][2] + pp[i][3])) * (1.0f / 1024.0f) + EPS); }
#pragma unroll
        for (int ai = 0; ai < 2; ++ai)
#pragma unroll
            for (int m = 0; m < 4; ++m) { const int rl = ai * 128 + wr * 64 + m * 16 + fr; const long row = (long)u.pm * 256 + rl; const float rs = rs8[ai * 4 + m];
#pragma unroll
                for (int bj = 0; bj < 2; ++bj) { const int col = u.pn * 256 + bj * 128 + wc * 32 + 8 * fq;
                    const f32x4 v0 = acc[ai][bj][m][0] * rs, v1 = acc[ai][bj][m][1] * rs;
                    u32x4 w; w.x = cvt_pk_bf16(v0[0], v0[1]); w.y = cvt_pk_bf16(v0[2], v0[3]); w.z = cvt_pk_bf16(v1[0], v1[1]); w.w = cvt_pk_bf16(v1[2], v1[3]);
                    *(u32x4*)(O + row * 512 + col) = w; }
                asm volatile("" ::: "memory"); }
    }
};
struct EpiDilVT {
    bf16_t* O; const float* part; int r;
    __device__ __forceinline__ void operator()(const f32x4 (&acc)[2][2][4][2], const Unit& u, int wr, int wc, int fr, int fq) const {
        const int tok0 = dil_token0(u.pn * 256, r);
#pragma unroll
        for (int bj = 0; bj < 2; ++bj) { const int cl = bj * 128 + wc * 32 + 8 * fq; float rs[8];
#pragma unroll
            for (int j = 0; j < 8; ++j) rs[j] = rstd_of(part, tok0 + (cl + j) * r);
#pragma unroll
            for (int ai = 0; ai < 2; ++ai)
#pragma unroll
                for (int m = 0; m < 4; ++m) { const int row = ai * 128 + wr * 64 + m * 16 + fr;
                    const f32x4 v0 = acc[ai][bj][m][0], v1 = acc[ai][bj][m][1];
                    u32x4 w; w.x = cvt_pk_bf16(v0[0] * rs[0], v0[1] * rs[1]); w.y = cvt_pk_bf16(v0[2] * rs[2], v0[3] * rs[3]);
                    w.z = cvt_pk_bf16(v1[0] * rs[4], v1[1] * rs[5]); w.w = cvt_pk_bf16(v1[2] * rs[6], v1[3] * rs[7]);
                    *(u32x4*)(O + (long)row * T + u.pn * 256 + cl) = w;
                    asm volatile("" ::: "memory"); } }
    }
};
struct EpiScores {
    bf16_t* P; const float* part; LAS f32x2* xt;
    __device__ __forceinline__ void operator()(const f32x4 (&acc)[2][2][4][2], const Unit& u, int wr, int wc, int fr, int fq) const {
        float rs8[8]; rstd8(part, u.pm * 256 + wr * 64 + fr, rs8);
#pragma unroll
        for (int ai = 0; ai < 2; ++ai)
#pragma unroll
            for (int m = 0; m < 4; ++m) { const int rl = ai * 128 + wr * 64 + m * 16 + fr; const float r_ = rs8[ai * 4 + m];
                float mx = -3.0e38f;
#pragma unroll
                for (int bj = 0; bj < 2; ++bj)
#pragma unroll
                    for (int n = 0; n < 2; ++n)
#pragma unroll
                        for (int j = 0; j < 4; ++j) mx = fmaxf(mx, acc[ai][bj][m][n][j] * r_);
                mx = fmaxf(mx, __shfl_xor(mx, 16)); mx = fmaxf(mx, __shfl_xor(mx, 32));
                float l = 0.f;
#pragma unroll
                for (int bj = 0; bj < 2; ++bj)
#pragma unroll
                    for (int n = 0; n < 2; ++n)
#pragma unroll
                        for (int j = 0; j < 4; ++j) l += __expf(acc[ai][bj][m][n][j] * r_ - mx);
                l += __shfl_xor(l, 16); l += __shfl_xor(l, 32);
                if (fq == 0) xt[rl * 4 + wc] = (f32x2){mx, l};
                asm volatile("" ::: "memory"); }
        LBAR();
#pragma unroll
        for (int ai = 0; ai < 2; ++ai)
#pragma unroll
            for (int m = 0; m < 4; ++m) { const int rl = ai * 128 + wr * 64 + m * 16 + fr; const long row = (long)u.pm * 256 + rl; const float r_ = rs8[ai * 4 + m];
                const f32x2 a = xt[rl * 4 + 0], b = xt[rl * 4 + 1], c = xt[rl * 4 + 2], d = xt[rl * 4 + 3];
                const float M = fmaxf(fmaxf(a.x, b.x), fmaxf(c.x, d.x));
                const float Ls = a.y * __expf(a.x - M) + b.y * __expf(b.x - M) + c.y * __expf(c.x - M) + d.y * __expf(d.x - M);
                const float inv = 1.0f / Ls;
#pragma unroll
                for (int bj = 0; bj < 2; ++bj) { const int col = u.pn * 256 + bj * 128 + wc * 32 + 8 * fq; float p[8];
#pragma unroll
                    for (int n = 0; n < 2; ++n)
#pragma unroll
                        for (int j = 0; j < 4; ++j) p[n * 4 + j] = __expf(acc[ai][bj][m][n][j] * r_ - M) * inv;
                    u32x4 w; w.x = cvt_pk_bf16(p[0], p[1]); w.y = cvt_pk_bf16(p[2], p[3]); w.z = cvt_pk_bf16(p[4], p[5]); w.w = cvt_pk_bf16(p[6], p[7]);
                    *(u32x4*)(P + row * DM + col) = w; }
                asm volatile("" ::: "memory"); }
    }
};


struct EpiAny {
    int kind;
    long o_off;
    int ldc, bstride; float scale; int h, r;
    __device__ __forceinline__ void operator()(const f32x4 (&acc)[2][2][4][2], const Unit& u, int wr, int wc, int fr, int fq, const Params& p, LAS unsigned char* lds) const {
        unsigned char* ws = p.ws; unsigned char* st = ws + OFF_STAGE; const float* part = (const float*)(ws + OFF_PART);
        if (EN(22) && kind == 0) { EpiPlain e{(bf16_t*)(ws + o_off), ldc, bstride}; e(acc, u, wr, wc, fr, fq); }
        else if (EN(23) && kind == 1) { EpiSwiGLU e{(bf16_t*)(ws + o_off), part}; e(acc, u, wr, wc, fr, fq); }
        else if (EN(24) && kind == 2) { EpiResid e{p.X, (bf16_t*)(ws + OFF_XB), (float*)(ws + OFF_PART), scale, (LAS float*)(lds + LDS_X)}; e(acc, u, wr, wc, fr, fq); }
        else if (EN(25) && kind == 3) { EpiGlaProj e{(bf16_t*)(st + ST_QK), (float*)(st + ST_GG), (bf16_t*)(st + ST_VV), (bf16_t*)(st + ST_ABUF), part, p.in[11], p.in[13], h}; e(acc, u, wr, wc, fr, fq); }
        else if (EN(26) && kind == 4) { EpiDilQK e{(bf16_t*)(ws + o_off), part, r}; e(acc, u, wr, wc, fr, fq); }
        else if (EN(27) && kind == 5) { EpiDilVT e{(bf16_t*)(ws + o_off), part, r}; e(acc, u, wr, wc, fr, fq); }
        else if (EN(28)) { EpiScores e{(bf16_t*)(ws + o_off), part, (LAS f32x2*)(lds + LDS_X)}; e(acc, u, wr, wc, fr, fq); }
    }
};

template <class Epi>
__device__ __forceinline__ void gemm_phase(LAS unsigned char* lds, const int K, const int lda, const int ldb, const Sched& S, const Epi& E) {
    int tid = threadIdx.x; asm volatile("" : "+v"(tid));
    const int wid = __builtin_amdgcn_readfirstlane(tid >> 6), lane = tid & 63, wr = wid >> 2, wc = wid & 3, fr = lane & 15, fq = lane >> 4;
    const int nt = K / BK;
    unsigned voffA[2], voffB[2];
#pragma unroll
    for (int i = 0; i < 2; ++i) { int R, C; stage_rc(tid * 16 + i * 8192, R, C); const int Rb = (R & ~31) + perm32(R & 31);
        voffA[i] = (unsigned)(R * lda + C) * 2u; voffB[i] = (unsigned)(Rb * ldb + C) * 2u; }
    const size_t kstep = (size_t)(BK * 2);
    const size_t hstepA = (size_t)HALF * lda * 2, hstepB = (size_t)HALF * ldb * 2;
    const unsigned ldsw = (unsigned)wid * 1024u;
    const int aoff = lds_byte(wr * 64 + fr, fq * 8), boff = lds_byte(wc * 32 + fr, fq * 8);
#define PG8_SA(b, h) (((b) * 2 + (h)) * HTB)
#define PG8_SB(b, h) ((4 + (b) * 2 + (h)) * HTB)
#define PG8_STAGE(bufoff, gbase, voff) do { _Pragma("unroll") for (int _i = 0; _i < 2; ++_i) \
        __builtin_amdgcn_global_load_lds((const unsigned*)((const char*)(gbase) + (voff)[_i]), (LAS unsigned*)(lds + (bufoff) + ldsw + _i * 8192), 16, 0, 0); } while (0)
#define PG8_LDA(dst, b, h) do { _Pragma("unroll") for (int m = 0; m < 4; ++m) _Pragma("unroll") for (int k = 0; k < 2; ++k) dst[m][k] = *(const LAS bf16x8*)(lds + PG8_SA(b, h) + aoff + m * 2048 + k * 1024); } while (0)
#define PG8_LDB(dst, b, h) do { _Pragma("unroll") for (int n = 0; n < 2; ++n) _Pragma("unroll") for (int k = 0; k < 2; ++k) dst[n][k] = *(const LAS bf16x8*)(lds + PG8_SB(b, h) + boff + n * 2048 + k * 1024); } while (0)
#define PG8_MMA(ai, bj, At, Bt) do { __builtin_amdgcn_s_setprio(1); _Pragma("unroll") for (int m = 0; m < 4; ++m) _Pragma("unroll") for (int n = 0; n < 2; ++n) _Pragma("unroll") for (int k = 0; k < 2; ++k) \
        acc[ai][bj][m][n] = __builtin_amdgcn_mfma_f32_16x16x32_bf16(Bt[n][k], At[m][k], acc[ai][bj][m][n], 0, 0, 0); __builtin_amdgcn_s_setprio(0); } while (0)
#define PG8_WAIT_V(n) asm volatile("s_waitcnt vmcnt(" #n ")" ::: "memory")
#define PG8_WAIT_L(n) asm volatile("s_waitcnt lgkmcnt(" #n ")" ::: "memory")
#define PG8_BAR __builtin_amdgcn_s_barrier()
#define PG8_SCHED __builtin_amdgcn_sched_barrier(0)
    Unit cur, nxt; int ui = 0;
    if (!S.next(0, cur)) return;
    f32x4 acc[2][2][4][2];
#pragma unroll
    for (int a = 0; a < 2; ++a)
#pragma unroll
        for (int b = 0; b < 2; ++b)
#pragma unroll
            for (int m = 0; m < 4; ++m)
#pragma unroll
                for (int n = 0; n < 2; ++n) acc[a][b][m][n] = (f32x4){0.f, 0.f, 0.f, 0.f};
    bf16x8 At[4][2], B0[2][2], B1[2][2];
    const char* cA = cur.a; const char* cB = cur.bt;
    PG8_STAGE(PG8_SB(0, 0), cB, voffB); PG8_STAGE(PG8_SA(0, 0), cA, voffA); PG8_STAGE(PG8_SB(0, 1), cB + hstepB, voffB); PG8_STAGE(PG8_SA(0, 1), cA + hstepA, voffA);
    if (wr == 1) PG8_BAR;
    PG8_WAIT_V(4); PG8_BAR;
    PG8_STAGE(PG8_SB(1, 0), cB + kstep, voffB); PG8_STAGE(PG8_SA(1, 0), cA + kstep, voffA); PG8_STAGE(PG8_SB(1, 1), cB + hstepB + kstep, voffB);
    PG8_WAIT_V(6); PG8_BAR;
    for (;;) {
        const bool has_next = S.next(ui + 1, nxt);
        const char* nA = has_next ? nxt.a : cA; const char* nB = has_next ? nxt.bt : cB;
        for (int t = 0; t < nt; t += 2) {
            const bool last = (t == nt - 2);
            const char* a1 = cA + (size_t)(t + 1) * kstep;
            const char* a2 = last ? nA : cA + (size_t)(t + 2) * kstep; const char* b2 = last ? nB : cB + (size_t)(t + 2) * kstep;
            const char* a3 = a2 + kstep; const char* b3 = b2 + kstep;
            PG8_LDB(B0, 0, 0); PG8_SCHED; PG8_LDA(At, 0, 0); PG8_STAGE(PG8_SA(1, 1), a1 + hstepA, voffA);
            PG8_WAIT_L(8); PG8_BAR; PG8_WAIT_L(0); PG8_MMA(0, 0, At, B0); PG8_BAR; PG8_SCHED;
            PG8_LDB(B1, 0, 1); PG8_STAGE(PG8_SB(0, 0), b2, voffB);
            PG8_BAR; PG8_WAIT_L(0); PG8_MMA(0, 1, At, B1); PG8_BAR;
            PG8_LDA(At, 0, 1); PG8_STAGE(PG8_SA(0, 0), a2, voffA);
            PG8_BAR; PG8_WAIT_L(0); PG8_MMA(1, 0, At, B0); PG8_BAR; PG8_SCHED;
            PG8_STAGE(PG8_SB(0, 1), b2 + hstepB, voffB);
            PG8_WAIT_V(6); PG8_BAR; PG8_MMA(1, 1, At, B1); PG8_BAR;
            PG8_LDB(B0, 1, 0); PG8_SCHED; PG8_LDA(At, 1, 0); PG8_STAGE(PG8_SA(0, 1), a2 + hstepA, voffA);
            PG8_WAIT_L(8); PG8_BAR; PG8_WAIT_L(0); PG8_MMA(0, 0, At, B0); PG8_BAR; PG8_SCHED;
            PG8_LDB(B1, 1, 1); PG8_STAGE(PG8_SB(1, 0), b3, voffB);
            PG8_BAR; PG8_WAIT_L(0); PG8_MMA(0, 1, At, B1); PG8_BAR;
            PG8_LDA(At, 1, 1); PG8_STAGE(PG8_SA(1, 0), a3, voffA);
            PG8_BAR; PG8_WAIT_L(0); PG8_MMA(1, 0, At, B0); PG8_BAR; PG8_SCHED;
            PG8_STAGE(PG8_SB(1, 1), b3 + hstepB, voffB);
            PG8_WAIT_V(6); PG8_BAR; PG8_MMA(1, 1, At, B1); PG8_BAR;
        }
        { int t2 = threadIdx.x; asm volatile("" : "+v"(t2)); const int w2 = __builtin_amdgcn_readfirstlane(t2 >> 6), l2 = t2 & 63;
          E(acc, cur, w2 >> 2, w2 & 3, l2 & 15, l2 >> 4); }
        if (!has_next) break;
#pragma unroll
        for (int a = 0; a < 2; ++a)
#pragma unroll
            for (int b = 0; b < 2; ++b)
#pragma unroll
                for (int m = 0; m < 4; ++m)
#pragma unroll
                    for (int n = 0; n < 2; ++n) acc[a][b][m][n] = (f32x4){0.f, 0.f, 0.f, 0.f};
        cur = nxt; cA = nA; cB = nB; ++ui;
    }
    PG8_WAIT_V(0);
    if (wr == 0) PG8_BAR;
    PG8_BAR;
#undef PG8_SA
#undef PG8_SB
#undef PG8_STAGE
#undef PG8_LDA
#undef PG8_LDB
#undef PG8_MMA
#undef PG8_WAIT_V
#undef PG8_WAIT_L
#undef PG8_BAR
#undef PG8_SCHED
}

__device__ __forceinline__ Sched mk_sched(const void* A, const void* Bt, int M, int N, int lda, int ldb, int rot) {
    Sched s; s.A = (const char*)A; s.Bt = (const char*)Bt; s.a_tile = 256 * lda * 2; s.b_tile = 256 * ldb * 2; s.a_batch = 0; s.b_batch = 0; s.seqB = 0;
    s.nM = M / 256; s.nN = N / 256; s.nB = 1; s.G = gridDim.x; s.c = (int)((blockIdx.x + (unsigned)rot) % gridDim.x); s.mode = 0; s.r = 1; return s;
}


struct GemmJob { int K, lda, ldb; Sched s; EpiAny e; };
__device__ __forceinline__ int rotc(int rot) { return (int)((blockIdx.x + gridDim.x - ((unsigned)rot % gridDim.x)) % gridDim.x); }
__device__ __forceinline__ bool get_job(const Params& p, int op, int arg, int j, GemmJob& J) {
    unsigned char* ws = p.ws; bf16_t* WB = (bf16_t*)ws; bf16_t* XB = (bf16_t*)(ws + OFF_XB); unsigned char* st = ws + OFF_STAGE;
    EpiAny e; e.kind = 0; e.o_off = 0; e.ldc = DM; e.bstride = 0; e.scale = 1.0f; e.h = 0; e.r = 1;
    J.K = DM; J.lda = DM; J.ldb = DM;
    if (op == 1) {
        if (j == 0) { J.s = mk_sched(st + ST_MEMN, WB + E_CKV, 768, 2048, DM, DM, 0); e.o_off = OFF_STAGE + ST_KV; e.ldc = 2048; }
        else if (j == 1) { J.s = mk_sched(XB, WB + E_FFN1_IN, T, 2 * DFF, DM, DM, 0); J.s.c = rotc(24); e.kind = 1; e.o_off = OFF_STAGE + ST_HID; }
        else return false;
    } else if (op == 2) {
        if (j == 0) { J.s = mk_sched(st + ST_HID, WB + E_FFN1_OUT, T, DM, DFF, DFF, 0); J.K = DFF; J.lda = DFF; J.ldb = DFF; e.kind = 2; e.scale = 0.5f; }
        else if (j <= 3) { const int sq = j - 1;
            J.s = mk_sched((const char*)(st + ST_KV) + (size_t)sq * 256 * 2048 * 2, WB + E_CQ, 256, 1024, 2048, DM, 0); J.s.nB = 4; J.s.a_batch = 512; J.s.b_batch = 512; J.s.c = rotc(sq * 16);
            J.K = 256; J.lda = 2048; J.ldb = DM; e.o_off = (E_GT + (size_t)sq * DM * DM) * 2; e.ldc = DM; e.bstride = 256 * DM; }
        else if (j <= 6) { const int sq = j - 4;
            J.s = mk_sched(WB + E_CO, (const char*)(st + ST_KV) + (size_t)sq * 256 * 2048 * 2 + 1024 * 2, 1024, 256, DM, 2048, 0); J.s.nB = 4; J.s.a_batch = 512; J.s.b_batch = 512; J.s.c = rotc(48 + sq * 16);
            J.K = 256; J.lda = DM; J.ldb = 2048; e.o_off = (E_HM + (size_t)sq * DM * DM) * 2; e.ldc = DM; e.bstride = 256; }
        else return false;
    } else if (op == 3) { if (j) return false; J.s = mk_sched(st + ST_ABUF, WB + E_MIX_OUT, T, DM, DM, DM, 0); e.kind = 2; }
    else if (op == 4) { if (j) return false; J.s = mk_sched(XB, WB + E_GT, T, DM, DM, DM, 0); J.s.mode = 1; J.s.seqB = DM * DM * 2; e.kind = 6; e.o_off = OFF_STAGE + ST_ABUF; }
    else if (op == 5) { if (j) return false; J.s = mk_sched(st + ST_ABUF, WB + E_HM, T, DM, DM, DM, 0); J.s.mode = 1; J.s.seqB = DM * DM * 2; e.kind = 2; }
    else if (op == 6) { if (j) return false; J.s = mk_sched(XB, WB + E_FFN2_IN, T, 2 * DFF, DM, DM, 0); e.kind = 1; e.o_off = OFF_STAGE + ST_HID; }
    else if (op == 7) { if (j) return false; J.s = mk_sched(st + ST_HID, WB + E_FFN2_OUT, T, DM, DFF, DFF, 0); J.K = DFF; J.lda = DFF; J.ldb = DFF; e.kind = 2; e.scale = 0.5f; }
    else if (op == 10) { if (j) return false; J.s = mk_sched(XB, WB + E_MIX_IN + (size_t)arg * 1024 * DM, T, 1024, DM, DM, 0); e.kind = 3; e.h = arg; }
    else if (op == 20) { if (j >= 6) return false; const int g = j >> 1, r = g == 0 ? 1 : (g == 1 ? 4 : 16); e.r = r;
        if ((j & 1) == 0) { J.s = mk_sched(XB, WB + E_MIX_IN + (size_t)(arg * 2304 + g * 512) * DM, T, 512, r * DM, DM, 0); J.s.mode = 2; J.s.r = r; J.s.c = rotc(g * 384);
            J.lda = r * DM; e.kind = 4; e.o_off = OFF_STAGE + ST_QKG + (size_t)g * T * 512 * 2; }
        else { J.s = mk_sched(WB + E_MIX_IN + (size_t)(arg * 2304 + 1536 + g * 256) * DM, XB, 256, T, DM, r * DM, 0); J.s.mode = 3; J.s.r = r; J.s.c = rotc(g * 384 + 256);
            J.ldb = r * DM; e.kind = 5; e.o_off = OFF_STAGE + ST_VTG + (size_t)g * 256 * T * 2; } }
    else return false;
    J.e = e; return true;
}

template <int NT>
__device__ __forceinline__ void conv_tiles(const float* src, int ld_src, const int (&k0)[NT], const int (&n0)[NT], bf16_t* dst, int ld_dst, const int (&dr0)[NT], const float* gain,
                                           const float (&scale)[NT], int nvalid, LAS float* tile) {
    int tid = threadIdx.x; asm volatile("" : "+v"(tid)); const int tx = tid & 63, ty = tid >> 6;
    float v[NT][8];
#pragma unroll
    for (int t = 0; t < NT; ++t) if (t < nvalid) {
#pragma unroll
        for (int i = 0; i < 8; ++i) v[t][i] = src[(size_t)(k0[t] + ty + 8 * i) * ld_src + n0[t] + tx];
    }
#pragma unroll
    for (int t = 0; t < NT; ++t) if (t < nvalid) {
#pragma unroll
        for (int i = 0; i < 8; ++i) { float x = v[t][i] * scale[t]; if (gain) x *= gain[k0[t] + ty + 8 * i]; tile[t * 4160 + (ty + 8 * i) * 65 + tx] = x; }
    }
    __syncthreads();
    const int i2 = tid & 31;
#pragma unroll
    for (int t = 0; t < NT; ++t) if (t < nvalid) {
#pragma unroll
        for (int jj = 0; jj < 4; ++jj) { const int j = (tid >> 5) + 16 * jj; const float a = tile[t * 4160 + (2 * i2) * 65 + j], b = tile[t * 4160 + (2 * i2 + 1) * 65 + j];
            *(unsigned*)(dst + (size_t)(dr0[t] + j) * ld_dst + k0[t] + 2 * i2) = cvt_pk_bf16(a, b); }
    }
    __syncthreads();
}
__device__ __forceinline__ int map_row(int kind, int n0, float& scale) {
    scale = 1.0f;
    if (EN(23) && kind == 1) { if (n0 < DFF) return (n0 / 128) * 256 + (n0 % 128); const int j = n0 - DFF; return (j / 128) * 256 + 128 + (j % 128); }
    if (EN(24) && kind == 2) {
        if (n0 < 512) { scale = 0.08838834764831845f; return (n0 / 128) * 1024 + (n0 % 128); }
        if (n0 < 1024) { const int j = n0 - 512; return (j / 128) * 1024 + 128 + (j % 128); }
        if (n0 < 2048) { const int j = n0 - 1024; return (j / 256) * 1024 + 512 + (j % 256); }
        const int j = n0 - 2048; return (j / 256) * 1024 + 768 + (j % 256);
    }
    if (EN(25) && kind == 3) { const int tg = n0 / 1024, h = (n0 % 1024) / 64, t = tg / 3, g = tg % 3, hc = h >> 2, hl = h & 3;
        if (t == 0) scale = 0.125f;
        if (t < 2) return hc * 2304 + g * 512 + t * 256 + hl * 64;
        return hc * 2304 + 1536 + g * 256 + hl * 64; }
    return n0;
}
__device__ __forceinline__ void conv_weight(const float* src, int K, int N, int ld_src, bf16_t* dst, const float* gain, int kind, LAS float* tile, int& rot) {
    constexpr int NT = 4;
    const int nk = K / 64, nn = N / 64, tot = nk * nn, G = gridDim.x;
    for (int t0 = (int)((blockIdx.x + G - (rot % G)) % G); t0 < tot; t0 += G * NT) {
        int k0[NT], n0[NT], dr0[NT]; float sc[NT]; int nvalid = 0;
#pragma unroll
        for (int j = 0; j < NT; ++j) { const int t = t0 + j * G; const bool ok = t < tot; const int tt = ok ? t : t0; const int kt = tt % nk, ntile = tt / nk;
            k0[j] = kt * 64; n0[j] = ntile * 64; dr0[j] = map_row(kind, ntile * 64, sc[j]); nvalid += ok ? 1 : 0; }
        conv_tiles<NT>(src, ld_src, k0, n0, dst, K, dr0, gain, sc, nvalid, tile);
    }
    rot += tot;
}
__device__ __forceinline__ const float* x_in_row(const Params& p, int t) { return t < 16384 ? p.in[0] + (size_t)t * DM : p.in[1] + (size_t)(t - 16384) * DM; }

__device__ __forceinline__ void phase_prologue(const Params& p, int layer, LAS unsigned char* lds) {
    unsigned char* ws = p.ws; bf16_t* WB = (bf16_t*)ws; LAS float* tile = (LAS float*)lds;
    int tid = threadIdx.x; asm volatile("" : "+v"(tid)); const int lane = tid & 63, wid = tid >> 6, nwv = gridDim.x * 8, gw = blockIdx.x * 8 + wid;
    int rot = 0;
    conv_weight(p.in[6] + (size_t)layer * DM * 2 * DFF, DM, 2 * DFF, 2 * DFF, WB + E_FFN1_IN, p.in[5] + layer * DM, 1, tile, rot);
    conv_weight(p.in[7] + (size_t)layer * DFF * DM, DFF, DM, DM, WB + E_FFN1_OUT, nullptr, 0, tile, rot);
    conv_weight(p.in[24] + (size_t)layer * DM * 2 * DFF, DM, 2 * DFF, 2 * DFF, WB + E_FFN2_IN, p.in[23] + layer * DM, 1, tile, rot);
    conv_weight(p.in[25] + (size_t)layer * DFF * DM, DFF, DM, DM, WB + E_FFN2_OUT, nullptr, 0, tile, rot);
    conv_weight(p.in[21] + (size_t)layer * DM * 2048, DM, 2048, 2048, WB + E_CKV, nullptr, 0, tile, rot);
    conv_weight(p.in[22] + (size_t)layer * DM * DM, DM, DM, DM, WB + E_CO, nullptr, 0, tile, rot);
    if (layer == 0) {
        conv_weight(p.in[9], DM, 3072, 3104, WB + E_MIX_IN, p.in[8], 2, tile, rot);
        conv_weight(p.in[15], DM, DM, DM, WB + E_MIX_OUT, nullptr, 0, tile, rot);
        for (size_t idx = (size_t)blockIdx.x * 512 + tid; idx < (size_t)2 * 512 * 1024; idx += (size_t)gridDim.x * 512) {
            const int c = (int)(idx & 1023), n = (int)((idx >> 10) & 511), dir = (int)(idx >> 19);
            const float* wi = p.in[9] + (size_t)c * 3104 + 3072 + dir * 16; const float* wg = (dir ? p.in[12] : p.in[10]) + n;
            float s = 0.f;
#pragma unroll
            for (int r = 0; r < 16; ++r) s += wi[r] * wg[r * 512];
            s *= p.in[8][c];
            WB[E_MIX_IN + (size_t)((n >> 7) * 1024 + 256 + dir * 128 + (n & 127)) * DM + c] = f2bf(s);
        }
    } else {
        conv_weight(p.in[16], DM, 9216, 9216, WB + E_MIX_IN, p.in[8] + DM, 3, tile, rot);
        conv_weight(p.in[17], DM, DM, DM, WB + E_MIX_OUT, nullptr, 0, tile, rot);
    }
    { const float* src = p.in[20] + (size_t)layer * DM * DM; const float* g = p.in[18] + layer * DM;
      for (size_t idx = ((size_t)blockIdx.x * 512 + tid) * 4; idx < (size_t)DM * DM; idx += (size_t)gridDim.x * 512 * 4) {
          const f32x4 v = *(const f32x4*)(src + idx); const float s = g[idx >> 10] * 0.0625f;
          u32x2 w; w.x = cvt_pk_bf16(v[0] * s, v[1] * s); w.y = cvt_pk_bf16(v[2] * s, v[3] * s);
          *(u32x2*)(WB + E_CQ + idx) = w; } }
    { bf16_t* MEMN = (bf16_t*)(ws + OFF_STAGE + ST_MEMN); const float* g = p.in[19] + layer * DM;
      for (int row = gw; row < 768; row += nwv) {
          const float* src = row < 512 ? p.in[2] + (size_t)row * DM : p.in[3] + (size_t)(row - 512) * DM;
          f32x4 v[4]; float ss = 0.f;
#pragma unroll
          for (int i = 0; i < 4; ++i) { v[i] = *(const f32x4*)(src + i * 256 + lane * 4); ss += (v[i][0] * v[i][0] + v[i][1] * v[i][1]) + (v[i][2] * v[i][2] + v[i][3] * v[i][3]); }
#pragma unroll
          for (int o = 1; o < 64; o <<= 1) ss += __shfl_xor(ss, o);
          const float rs = rsqrtf(ss * (1.0f / 1024.0f) + EPS);
#pragma unroll
          for (int i = 0; i < 4; ++i) { const f32x4 gg = *(const f32x4*)(g + i * 256 + lane * 4);
              u32x2 w; w.x = cvt_pk_bf16(v[i][0] * rs * gg[0], v[i][1] * rs * gg[1]); w.y = cvt_pk_bf16(v[i][2] * rs * gg[2], v[i][3] * rs * gg[3]);
              *(u32x2*)(MEMN + (size_t)row * DM + i * 256 + lane * 4) = w; } } }
    if (layer == 0) {
        bf16_t* XB = (bf16_t*)(ws + OFF_XB); float* part = (float*)(ws + OFF_PART);
        for (int row = gw; row < T; row += nwv) {
            const float* src = x_in_row(p, row); f32x4 v[4]; float ss = 0.f;
#pragma unroll
            for (int i = 0; i < 4; ++i) { v[i] = *(const f32x4*)(src + i * 256 + lane * 4); ss += (v[i][0] * v[i][0] + v[i][1] * v[i][1]) + (v[i][2] * v[i][2] + v[i][3] * v[i][3]); }
#pragma unroll
            for (int o = 1; o < 64; o <<= 1) ss += __shfl_xor(ss, o);
#pragma unroll
            for (int i = 0; i < 4; ++i) { *(f32x4*)(p.X + (size_t)row * DM + i * 256 + lane * 4) = v[i];
                u32x2 w; w.x = cvt_pk_bf16(v[i][0], v[i][1]); w.y = cvt_pk_bf16(v[i][2], v[i][3]);
                *(u32x2*)(XB + (size_t)row * DM + i * 256 + lane * 4) = w; }
            if (lane == 0) *(f32x4*)(part + (size_t)row * 4) = (f32x4){ss, 0.f, 0.f, 0.f};
        }
        float* bt = (float*)(ws + OFF_BTAB);
        for (int idx = blockIdx.x * 512 + tid; idx < 3 * 16 * 129; idx += gridDim.x * 512) {
            const int rel = idx % 129 - 64, h = (idx / 129) % 16, g = idx / (129 * 16); const int r = g == 0 ? 1 : (g == 1 ? 4 : 16);
            const int rr = rel * r, n = rr < 0 ? -rr : rr; int bk;
            if (n < 8) bk = n; else bk = 8 + (n >= 15) + (n >= 27) + (n >= 50) + (n >= 91) + (n >= 166) + (n >= 305) + (n >= 559);
            if (rr > 0) bk += 16;
            bt[idx] = p.in[4][bk * 48 + g * 16 + h];
        }
    }
}

__device__ __forceinline__ void phase_final(const Params& p) {
    const float* part = (const float*)(p.ws + OFF_PART); const float* g = p.in[26];
    int tid = threadIdx.x; asm volatile("" : "+v"(tid)); const int lane = tid & 63, wid = tid >> 6, nwv = gridDim.x * 8, gw = blockIdx.x * 8 + wid;
    for (int row = gw; row < T; row += nwv) { const float rs = rstd_of(part, row);
#pragma unroll
        for (int i = 0; i < 4; ++i) { float* xp = p.X + (size_t)row * DM + i * 256 + lane * 4; const f32x4 v = ld_sys16f(xp); const f32x4 gg = *(const f32x4*)(g + i * 256 + lane * 4);
            *(f32x4*)xp = (f32x4){v[0] * rs * gg[0], v[1] * rs * gg[1], v[2] * rs * gg[2], v[3] * rs * gg[3]}; } }
}

__device__ __forceinline__ void gla_combine(const Params& p, int h) {
    unsigned char* st = p.ws + OFF_STAGE; const float* OF = (const float*)(st + ST_OF); const float* OB = (const float*)(st + ST_OB); bf16_t* AB = (bf16_t*)(st + ST_ABUF);
    const float* gn = p.in[14] + h * 256;
    int tid = threadIdx.x; asm volatile("" : "+v"(tid)); const int lane = tid & 63, wid = tid >> 6, nwv = gridDim.x * 8, gw = blockIdx.x * 8 + wid;
    const f32x4 gg = *(const f32x4*)(gn + lane * 4);
    for (int row = gw; row < T; row += nwv) {
        const f32x4 a = ld_sys16f(OF + (size_t)row * 256 + lane * 4), b = ld_sys16f(OB + (size_t)row * 256 + lane * 4);
        const f32x4 o = a + b; float ss = (o[0] * o[0] + o[1] * o[1]) + (o[2] * o[2] + o[3] * o[3]);
#pragma unroll
        for (int s = 1; s < 64; s <<= 1) ss += __shfl_xor(ss, s);
        const float rs = rsqrtf(ss * (1.0f / 256.0f) + EPS);
        bf16_t* ap = AB + (size_t)row * DM + h * 256 + lane * 4; const u32x2 rr = ld_sys8(ap);
        const float r0 = __uint_as_float(rr.x << 16), r1 = __uint_as_float(rr.x & 0xffff0000u), r2 = __uint_as_float(rr.y << 16), r3 = __uint_as_float(rr.y & 0xffff0000u);
        u32x2 w; w.x = cvt_pk_bf16(o[0] * rs * gg[0] * r0, o[1] * rs * gg[1] * r1); w.y = cvt_pk_bf16(o[2] * rs * gg[2] * r2, o[3] * rs * gg[3] * r3);
        *(u32x2*)ap = w;
    }
}

constexpr int SC_QP = 0, SC_KP = 17408, SC_KT = 34816, SC_VT = 53248, SC_ATT = 62464, SC_SS = 71680, SC_QS = 89088, SC_BL = 91136;

template <bool OUT>
__device__ __forceinline__ void gla_scan(const Params& p, LAS unsigned char* lds) {
    unsigned char* st = p.ws + OFF_STAGE;
    const bf16_t* QK = (const bf16_t*)(st + ST_QK); const float* GG = (const float*)(st + ST_GG); const bf16_t* VV = (const bf16_t*)(st + ST_VV);
    float* SLOC = (float*)(st + ST_SLOC); float* DVEC = (float*)(st + ST_DVEC);
    int tid = threadIdx.x; asm volatile("" : "+v"(tid)); const int lane = tid & 63, w = tid >> 6, l15 = lane & 15, quad = lane >> 4;
    LAS bf16_t* QP = (LAS bf16_t*)(lds + SC_QP); LAS bf16_t* KP = (LAS bf16_t*)(lds + SC_KP); LAS bf16_t* KT = (LAS bf16_t*)(lds + SC_KT);
    LAS bf16_t* VT = (LAS bf16_t*)(lds + SC_VT); LAS bf16_t* ATT = (LAS bf16_t*)(lds + SC_ATT); LAS bf16_t* SS = (LAS bf16_t*)(lds + SC_SS);
    LAS float* QS = (LAS float*)(lds + SC_QS); LAS float* BL = (LAS float*)(lds + SC_BL);
    for (int unit = blockIdx.x; unit < 256; unit += gridDim.x) {
        const int slice = unit & 3, dir = (unit >> 2) & 1, seg = unit >> 3;
        const int sfirst = seg < 8 ? 0 : (seg < 16 ? 8 : 16), nseg = seg < 16 ? 8 : 16;
        const int sigma = dir == 0 ? seg - sfirst : sfirst + nseg - 1 - seg;
        float* oout = (float*)(st + (dir == 0 ? ST_OF : ST_OB));
        f32x4 S[4];
#pragma unroll
        for (int d = 0; d < 4; ++d) S[d] = (f32x4){0.f, 0.f, 0.f, 0.f};
        if (OUT) {
            for (int sp = 0; sp < sigma; ++sp) {
                const int sg = dir == 0 ? sfirst + sp : sfirst + nseg - 1 - sp;
                const float* sl = SLOC + (size_t)(sg * 2 + dir) * 128 * 256; const float* dv = DVEC + (size_t)(sg * 2 + dir) * 128;
#pragma unroll
                for (int r = 0; r < 4; ++r) { const int dk = 16 * w + 4 * quad + r; const float dd = ldsys_f(dv + dk);
#pragma unroll
                    for (int d = 0; d < 4; ++d) S[d][r] = S[d][r] * dd + ldsys_f(sl + (size_t)dk * 256 + slice * 64 + d * 16 + l15); }
            }
        }
        float dsum = 0.f;
        const int dkc = tid & 127, qr = tid >> 7;
        const int dvc = tid & 63, jr = tid >> 6;
        for (int ch = 0; ch < 16; ++ch) {
            const int tb = seg * 1024 + (dir == 0 ? ch * 64 : (15 - ch) * 64);
            float g[16]; float q[16], k[16];
#pragma unroll
            for (int ii = 0; ii < 16; ++ii) { const int ip = qr * 16 + ii; const int tok = tb + (dir == 0 ? ip : 63 - ip);
                g[ii] = ldsys_f(GG + (size_t)tok * 256 + dir * 128 + dkc);
                if (OUT) q[ii] = bf2f(ldsys_h(QK + (size_t)tok * 256 + dkc));
                k[ii] = bf2f(ldsys_h(QK + (size_t)tok * 256 + 128 + dkc)); }
            unsigned vpk[4];
            { float v[8];
#pragma unroll
              for (int jj = 0; jj < 8; ++jj) { const int jp = jr * 8 + jj; const int tok = tb + (dir == 0 ? jp : 63 - jp); v[jj] = bf2f(ldsys_h(VV + (size_t)tok * 256 + slice * 64 + dvc)); }
#pragma unroll
              for (int jj = 0; jj < 4; ++jj) vpk[jj] = cvt_pk_bf16(v[2 * jj], v[2 * jj + 1]); }
#pragma unroll
            for (int ii = 1; ii < 16; ++ii) g[ii] += g[ii - 1];
            QS[qr * 128 + dkc] = g[15];
            *(LAS u32x4*)(VT + dvc * 72 + jr * 8) = (u32x4){vpk[0], vpk[1], vpk[2], vpk[3]};
            __syncthreads();
            float off = 0.f, tot = 0.f;
#pragma unroll
            for (int qq = 0; qq < 4; ++qq) { const float s = QS[qq * 128 + dkc]; tot += s; if (qq < qr) off += s; }
            if (qr == 0) { BL[dkc] = __expf(tot); dsum += tot; }
            unsigned kt[8];
#pragma unroll
            for (int ii = 0; ii < 16; ii += 2) {
                const float b0 = off + g[ii], b1 = off + g[ii + 1];
                if (OUT) { const int ip = qr * 16 + ii;
                    QP[ip * 136 + dkc] = f2bf(q[ii] * __expf(b0)); QP[(ip + 1) * 136 + dkc] = f2bf(q[ii + 1] * __expf(b1));
                    KP[ip * 136 + dkc] = f2bf(k[ii] * __expf(-b0)); KP[(ip + 1) * 136 + dkc] = f2bf(k[ii + 1] * __expf(-b1)); }
                kt[ii >> 1] = cvt_pk_bf16(k[ii] * __expf(tot - b0), k[ii + 1] * __expf(tot - b1));
            }
            *(LAS u32x4*)(KT + dkc * 72 + qr * 16) = (u32x4){kt[0], kt[1], kt[2], kt[3]};
            *(LAS u32x4*)(KT + dkc * 72 + qr * 16 + 8) = (u32x4){kt[4], kt[5], kt[6], kt[7]};
            if (OUT) {
#pragma unroll
                for (int d = 0; d < 4; ++d) { u32x2 sw; sw.x = cvt_pk_bf16(S[d][0], S[d][1]); sw.y = cvt_pk_bf16(S[d][2], S[d][3]);
                    *(LAS u32x2*)(SS + (d * 16 + l15) * 136 + 16 * w + 4 * quad) = sw; }
            }
            __syncthreads();
            f32x4 O[2];
            if (OUT) {
                const int it = w >> 1, c0 = (w & 1) * 2;
                f32x4 at[2] = {(f32x4){0.f, 0.f, 0.f, 0.f}, (f32x4){0.f, 0.f, 0.f, 0.f}};
                O[0] = (f32x4){0.f, 0.f, 0.f, 0.f}; O[1] = (f32x4){0.f, 0.f, 0.f, 0.f};
#pragma unroll
                for (int kk = 0; kk < 4; ++kk) {
                    const bf16x8 af = *(const LAS bf16x8*)(QP + (it * 16 + l15) * 136 + kk * 32 + quad * 8);
#pragma unroll
                    for (int x = 0; x < 2; ++x) {
                        const bf16x8 kf = *(const LAS bf16x8*)(KP + ((c0 + x) * 16 + l15) * 136 + kk * 32 + quad * 8);
                        at[x] = __builtin_amdgcn_mfma_f32_16x16x32_bf16(af, kf, at[x], 0, 0, 0);
                        const bf16x8 sf = *(const LAS bf16x8*)(SS + ((c0 + x) * 16 + l15) * 136 + kk * 32 + quad * 8);
                        O[x] = __builtin_amdgcn_mfma_f32_16x16x32_bf16(af, sf, O[x], 0, 0, 0);
                    }
                }
#pragma unroll
                for (int x = 0; x < 2; ++x)
#pragma unroll
                    for (int r = 0; r < 4; ++r) { const int i = it * 16 + quad * 4 + r, j = (c0 + x) * 16 + l15;
                        ATT[i * 72 + j] = f2bf(j <= i ? at[x][r] : 0.f); }
            }
            {
#pragma unroll
                for (int r = 0; r < 4; ++r) { const float dd = BL[16 * w + 4 * quad + r];
#pragma unroll
                    for (int d = 0; d < 4; ++d) S[d][r] *= dd; }
#pragma unroll
                for (int kk = 0; kk < 2; ++kk) {
                    const bf16x8 af = *(const LAS bf16x8*)(KT + (16 * w + l15) * 72 + kk * 32 + quad * 8);
#pragma unroll
                    for (int d = 0; d < 4; ++d) { const bf16x8 vf = *(const LAS bf16x8*)(VT + (d * 16 + l15) * 72 + kk * 32 + quad * 8);
                        S[d] = __builtin_amdgcn_mfma_f32_16x16x32_bf16(af, vf, S[d], 0, 0, 0); }
                }
            }
            if (OUT) {
                __syncthreads();
                const int it = w >> 1, c0 = (w & 1) * 2;
#pragma unroll
                for (int kk = 0; kk < 2; ++kk) {
                    const bf16x8 af = *(const LAS bf16x8*)(ATT + (it * 16 + l15) * 72 + kk * 32 + quad * 8);
#pragma unroll
                    for (int x = 0; x < 2; ++x) { const bf16x8 vf = *(const LAS bf16x8*)(VT + ((c0 + x) * 16 + l15) * 72 + kk * 32 + quad * 8);
                        O[x] = __builtin_amdgcn_mfma_f32_16x16x32_bf16(af, vf, O[x], 0, 0, 0); }
                }
#pragma unroll
                for (int x = 0; x < 2; ++x)
#pragma unroll
                    for (int r = 0; r < 4; ++r) { const int ip = it * 16 + quad * 4 + r; const int tok = tb + (dir == 0 ? ip : 63 - ip);
                        oout[(size_t)tok * 256 + slice * 64 + (c0 + x) * 16 + l15] = O[x][r]; }
            }
            __syncthreads();
        }
        if (!OUT) {
            float* sl = SLOC + (size_t)(seg * 2 + dir) * 128 * 256;
#pragma unroll
            for (int r = 0; r < 4; ++r) { const int dk = 16 * w + 4 * quad + r;
#pragma unroll
                for (int d = 0; d < 4; ++d) sl[(size_t)dk * 256 + slice * 64 + d * 16 + l15] = S[d][r]; }
            if (slice == 0 && tid < 128) DVEC[(size_t)(seg * 2 + dir) * 128 + tid] = __expf(dsum);
        }
    }
}

typedef float f32x16 __attribute__((ext_vector_type(16)));
__device__ __forceinline__ void dil_attn(const Params& p, int hc, LAS unsigned char* lds) {
    unsigned char* st = p.ws + OFF_STAGE; bf16_t* AB = (bf16_t*)(st + ST_ABUF); const float* btab = (const float*)(p.ws + OFF_BTAB);
    LAS float* OST = (LAS float*)lds; LAS float* MST = (LAS float*)(lds + 139264); LAS float* LST = (LAS float*)(lds + 141312); LAS float* BTL = (LAS float*)(lds + 143360);
    int tid = threadIdx.x; asm volatile("" : "+v"(tid)); const int lane = tid & 63, w = tid >> 6, l31 = lane & 31, hh = lane >> 5;
    const int kap = (l31 & 16) | ((l31 & 4) << 1) | ((l31 & 8) >> 1) | (l31 & 3);
    for (int unit = blockIdx.x; unit < 256; unit += gridDim.x) {
        const int hl = unit & 3, tbk = unit >> 2, t0 = tbk * 512;
        const int sb = t0 < 8192 ? 0 : (t0 < 16384 ? 8192 : 16384), Sq = t0 < 16384 ? 8192 : 16384;
        const int h = hc * 4 + hl;
#pragma unroll 1
        for (int g = 0; g < 3; ++g) {
            const int r = g == 0 ? 1 : (g == 1 ? 4 : 16), L = Sq / r;
            const bf16_t* QKg = (const bf16_t*)(st + ST_QKG) + (size_t)g * T * 512; const bf16_t* VTg = (const bf16_t*)(st + ST_VTG) + (size_t)g * 256 * T;
            const float* bt = btab + (g * 16 + h) * 129;
            if (tid < 256) { const int ri = tid - 96; BTL[tid] = (ri >= 0 && ri <= 128) ? bt[ri] : 0.f; }
            __syncthreads();
#pragma unroll 1
            for (int itx = 0; itx < 2; ++itx) {
                const int item = 2 * w + itx;
                int c, l0;
                if (g == 0) { c = 0; l0 = (t0 - sb) + 32 * item; } else if (g == 1) { c = item >> 2; l0 = (t0 - sb) / 4 + 32 * (item & 3); } else { c = item; l0 = (t0 - sb) / 16; }
                const int nq0 = sb + c * L + l0, nbase = nq0 - 64;
                const int tokl = (l0 + l31) * r + c - (t0 - sb);
                bf16x8 qf[4];
#pragma unroll
                for (int ks = 0; ks < 4; ++ks) qf[ks] = ld_sys16(QKg + (unsigned)((nq0 + l31) * 512 + hl * 64 + ks * 16 + hh * 8));
                f32x16 sT[5];
                bf16x8 kf[4];
#define DIL_LOADK(kt) do { const int lkh_ = l0 - 64 + 32 * (kt) + (l31 & 16); const bool in_ = (lkh_ >= 0) && (lkh_ < L); \
                    const int nrow_ = in_ ? nbase + 32 * (kt) + kap : nq0 + l31; \
                    _Pragma("unroll") for (int ks_ = 0; ks_ < 4; ++ks_) kf[ks_] = ld_sys16(QKg + (unsigned)(nrow_ * 512 + 256 + hl * 64 + ks_ * 16 + hh * 8)); } while (0)
#pragma unroll
                for (int kt = 0; kt < 5; ++kt) {
                    DIL_LOADK(kt);
                    f32x16 a;
#pragma unroll
                    for (int j = 0; j < 16; ++j) a[j] = 0.f;
#pragma unroll
                    for (int ks = 0; ks < 4; ++ks) a = __builtin_amdgcn_mfma_f32_32x32x16_bf16(kf[ks], qf[ks], a, 0, 0, 0);
                    sT[kt] = a;
                }
                bf16x8 vf[4];
#define DIL_LOADV(kt) do { _Pragma("unroll") for (int s_ = 0; s_ < 2; ++s_) { const int lkh_ = l0 - 64 + 32 * (kt) + 16 * s_; const bool in_ = (lkh_ >= 0) && (lkh_ < L); \
                    const int ncol_ = in_ ? nbase + 32 * (kt) + 16 * s_ + 8 * hh : nq0; \
                    _Pragma("unroll") for (int dt_ = 0; dt_ < 2; ++dt_) vf[2 * s_ + dt_] = ld_sys16(VTg + (unsigned)((hl * 64 + dt_ * 32 + l31) * T + ncol_)); } } while (0)
                DIL_LOADV(0);
#pragma unroll
                for (int kt = 0; kt < 5; ++kt)
#pragma unroll
                    for (int j = 0; j < 16; ++j) { const int lkh = l0 - 64 + 32 * kt + 16 * (j >> 3); const bool inr = (lkh >= 0) && (lkh < L);
                        const int rel = -64 + 32 * kt + 16 * (j >> 3) + 8 * hh + (j & 7) - l31; const bool ok = inr && rel >= -64 && rel <= 64;
                        sT[kt][j] = ok ? sT[kt][j] + BTL[rel + 160] : -1.0e30f; }
                float mo = -1.0e30f, lo = 0.f;
                if (g > 0) { mo = MST[tokl]; lo = LST[tokl]; }
                float mx = mo;
#pragma unroll
                for (int kt = 0; kt < 5; ++kt)
#pragma unroll
                    for (int j = 0; j < 16; ++j) mx = fmaxf(mx, sT[kt][j]);
                mx = fmaxf(mx, __shfl_xor(mx, 32));
                const float alpha = __expf(mo - mx);
                float ls = 0.f;
#pragma unroll
                for (int kt = 0; kt < 5; ++kt)
#pragma unroll
                    for (int j = 0; j < 16; ++j) { const float e = __expf(sT[kt][j] - mx); sT[kt][j] = e; ls += e; }
                ls += __shfl_xor(ls, 32);
                const float ln = lo * alpha + ls;
                f32x16 O[2];
#pragma unroll
                for (int dt = 0; dt < 2; ++dt)
#pragma unroll
                    for (int j = 0; j < 16; ++j) O[dt][j] = 0.f;
                if (g > 0) {
#pragma unroll
                    for (int dt = 0; dt < 2; ++dt)
#pragma unroll
                        for (int g4 = 0; g4 < 4; ++g4) { const f32x4 o4 = *(const LAS f32x4*)(OST + tokl * 68 + dt * 32 + g4 * 8 + hh * 4);
                            O[dt][4 * g4] = o4[0] * alpha; O[dt][4 * g4 + 1] = o4[1] * alpha; O[dt][4 * g4 + 2] = o4[2] * alpha; O[dt][4 * g4 + 3] = o4[3] * alpha; } }
#pragma unroll
                for (int kt = 0; kt < 5; ++kt) {
                    if (kt > 0) DIL_LOADV(kt);
#pragma unroll
                    for (int s2 = 0; s2 < 2; ++s2) {
                        u32x4 pw; pw.x = cvt_pk_bf16(sT[kt][8 * s2], sT[kt][8 * s2 + 1]); pw.y = cvt_pk_bf16(sT[kt][8 * s2 + 2], sT[kt][8 * s2 + 3]);
                        pw.z = cvt_pk_bf16(sT[kt][8 * s2 + 4], sT[kt][8 * s2 + 5]); pw.w = cvt_pk_bf16(sT[kt][8 * s2 + 6], sT[kt][8 * s2 + 7]);
                        const bf16x8 pf = __builtin_bit_cast(bf16x8, pw);
#pragma unroll
                        for (int dt = 0; dt < 2; ++dt) O[dt] = __builtin_amdgcn_mfma_f32_32x32x16_bf16(vf[2 * s2 + dt], pf, O[dt], 0, 0, 0);
                    }
                }
#undef DIL_LOADK
#undef DIL_LOADV
                if (g < 2) {
                    if (hh == 0) { MST[tokl] = mx; LST[tokl] = ln; }
#pragma unroll
                    for (int dt = 0; dt < 2; ++dt)
#pragma unroll
                        for (int g4 = 0; g4 < 4; ++g4) *(LAS f32x4*)(OST + tokl * 68 + dt * 32 + g4 * 8 + hh * 4) = (f32x4){O[dt][4 * g4], O[dt][4 * g4 + 1], O[dt][4 * g4 + 2], O[dt][4 * g4 + 3]};
                } else {
                    const float inv = 1.0f / ln;
#pragma unroll
                    for (int dt = 0; dt < 2; ++dt)
#pragma unroll
                        for (int g4 = 0; g4 < 4; ++g4) { u32x2 ow; ow.x = cvt_pk_bf16(O[dt][4 * g4] * inv, O[dt][4 * g4 + 1] * inv); ow.y = cvt_pk_bf16(O[dt][4 * g4 + 2] * inv, O[dt][4 * g4 + 3] * inv);
                            *(u32x2*)(AB + (size_t)(t0 + tokl) * DM + h * 64 + dt * 32 + g4 * 8 + hh * 4) = ow; }
                }
            }
            __syncthreads();
        }
    }
}

#define XB_TMO      128
#define XB_XCNT(j)  (256  + 64 * (j))
#define XB_XSUB(j)  (1280 + 64 * (j))
#define XB_XGEN(j)  (2304 + 64 * (j))
#define XB_TOP      3328
#define XB_TOPGEN   3392
#define XCD_BAR_WORDS 3456
#define XB_SPIN_CAP (1u << 22)
__device__ __forceinline__ unsigned xb_ld(unsigned* p)              { return __hip_atomic_load(p, __ATOMIC_RELAXED, __HIP_MEMORY_SCOPE_AGENT); }
__device__ __forceinline__ unsigned xb_add(unsigned* p, unsigned v) { return __hip_atomic_fetch_add(p, v, __ATOMIC_RELAXED, __HIP_MEMORY_SCOPE_AGENT); }
__device__ __forceinline__ unsigned xb_xcc_id() { return (unsigned)__builtin_amdgcn_s_getreg((3 << 11) | 20) & 0xFu; }
#define XB_SPIN(cond, bar) do { unsigned _sp = 0; while (cond) { __builtin_amdgcn_s_sleep(1); \
    if ((++_sp & 255u) == 0u) { if (xb_ld(&(bar)[XB_TMO])) break; if (_sp > XB_SPIN_CAP) { atomicAdd(&(bar)[XB_TMO], 1u); break; } } } } while (0)
struct XcdBarrier { unsigned* bar; unsigned x; volatile LAS unsigned* st; };
__device__ __forceinline__ XcdBarrier xcd_barrier_post(unsigned* bar, volatile LAS unsigned* st) {
    XcdBarrier b; b.bar = bar; b.x = xb_xcc_id(); b.st = st;
    if (threadIdx.x == 0) (void)xb_add(&bar[XB_XCNT(b.x)], 1u);
    return b;
}
__device__ __forceinline__ void xcd_barrier_complete(unsigned* bar, unsigned x, unsigned& nloc, unsigned& nx) {
    const unsigned G = gridDim.x * gridDim.y * gridDim.z;
    unsigned sum, cnt, mine, sp = 0u;
    for (;;) {
        sum = 0u; cnt = 0u; mine = 0u;
#pragma unroll
        for (unsigned j = 0; j < 16; ++j) { const unsigned c = xb_ld(&bar[XB_XCNT(j)]); sum += c; cnt += (c > 0u) ? 1u : 0u; mine = (j == x) ? c : mine; }
        if (sum == G) break;
        __builtin_amdgcn_s_sleep(1);
        if ((++sp & 255u) == 0u) { if (xb_ld(&bar[XB_TMO])) break; if (sp > XB_SPIN_CAP) { atomicAdd(&bar[XB_TMO], 1u); break; } }
    }
    nloc = mine > 0u ? mine : 1u; nx = cnt > 0u ? cnt : 1u;
}
__device__ __forceinline__ void xcd_barrier(const XcdBarrier& b) {
    asm volatile("s_waitcnt vmcnt(0)" ::: "memory");
    __syncthreads();
    if (threadIdx.x == 0) {
        unsigned* bar = b.bar;
        __builtin_amdgcn_s_waitcnt(0);
        unsigned nloc = b.st[0], nx = b.st[1];
        if (nloc == 0u) { xcd_barrier_complete(bar, b.x, nloc, nx); b.st[0] = nloc; b.st[1] = nx; }
        const unsigned old = xb_add(&bar[XB_XSUB(b.x)], 1u);
        const unsigned gen = old / nloc;
        if (old + 1u == (gen + 1u) * nloc) {
            __builtin_amdgcn_fence(__ATOMIC_RELEASE, "agent");
            asm volatile("s_waitcnt vmcnt(0)" ::: "memory");
            const unsigned og = xb_add(&bar[XB_TOP], 1u);
            const unsigned tg = og / nx;
            if (og + 1u == (tg + 1u) * nx) xb_add(&bar[XB_TOPGEN], 1u);
            else XB_SPIN(xb_ld(&bar[XB_TOPGEN]) == tg, bar);
            __builtin_amdgcn_fence(__ATOMIC_ACQUIRE, "agent");
            xb_add(&bar[XB_XGEN(b.x)], 1u);
            asm volatile("s_waitcnt vmcnt(0)" ::: "memory");
        } else {
            XB_SPIN(xb_ld(&bar[XB_XGEN(b.x)]) == gen, bar);
            __builtin_amdgcn_fence(__ATOMIC_ACQUIRE, "agent");
            asm volatile("s_waitcnt vmcnt(0)" ::: "memory");
        }
    }
    __syncthreads();
}

__global__ void __launch_bounds__(512, 2) fwd_megakernel(Params p) {
    extern __shared__ __attribute__((aligned(16))) unsigned char smem[];
    LAS unsigned char* lds = (LAS unsigned char*)smem;
    cg::grid_group grid = cg::this_grid();
    if (threadIdx.x < 2) ((volatile LAS unsigned*)(lds + LDS_CTL))[threadIdx.x] = 0u;
    __syncthreads();
    const XcdBarrier bar = xcd_barrier_post((unsigned*)(p.ws + OFF_CTL), (volatile LAS unsigned*)(lds + LDS_CTL));
    grid.sync();
    unsigned char* ws = p.ws; bf16_t* WB = (bf16_t*)ws; bf16_t* XB = (bf16_t*)(ws + OFF_XB); float* part = (float*)(ws + OFF_PART);
    unsigned char* st = ws + OFF_STAGE;
    for (int ph = p.ph_lo; ph < p.ph_hi; ++ph) {
        if (ph > p.ph_lo) { for (int xs = 0; xs <= PROBE_SYNC; ++xs) xcd_barrier(bar); }
        if (ph == 37) { phase_final(p); continue; }
        const int layer = ph >= 21 ? 1 : 0, q = ph - layer * 21;
        int op = -1, arg = 0;
        if (q == 0) op = 0; else if (q == 1) op = 1; else if (q == 2) op = 2;
        else if (layer == 0) {
            if (q <= 14) { const int hh = (q - 3) / 3, s = (q - 3) % 3; arg = hh; op = 10 + s; }
            else if (q == 15) { op = 13; arg = 3; } else op = q - 16 + 3;
        } else {
            if (q <= 10) { arg = (q - 3) >> 1; op = 20 + ((q - 3) & 1); } else op = q - 11 + 3;
        }
        if (op == 10 && arg > 0) gla_combine(p, arg - 1);
        for (int rep = 0; rep < (((PROBE_REP >> op) & 1u) ? 2 : 1); ++rep) {
        if (op == 0) { if (EN(0)) phase_prologue(p, layer, lds); }
        else if (op == 11) { if (EN(11)) gla_scan<false>(p, lds); }
        else if (op == 12) { if (EN(12)) gla_scan<true>(p, lds); }
        else if (op == 13) { if (EN(13)) gla_combine(p, arg); }
        else if (op == 21) { if (EN(21)) dil_attn(p, arg, lds); }
        else if (EN(1)) {
            GemmJob J;
            for (int j = 0; j < 8; ++j) { if (!get_job(p, op, arg, j, J)) break;
                const float* part = (const float*)(ws + OFF_PART); const int kind = J.e.kind;
                if (EN(22) && kind == 0) { EpiPlain e{(bf16_t*)(ws + J.e.o_off), J.e.ldc, J.e.bstride}; gemm_phase(lds, J.K, J.lda, J.ldb, J.s, e); }
                else if (EN(23) && kind == 1) { EpiSwiGLU e{(bf16_t*)(ws + J.e.o_off), part}; gemm_phase(lds, DM, DM, DM, J.s, e); }
                else if (EN(24) && kind == 2) { EpiResid e{p.X, XB, (float*)(ws + OFF_PART), J.e.scale, (LAS float*)(lds + LDS_X)}; gemm_phase(lds, J.K, J.K, J.K, J.s, e); }
                else if (EN(25) && kind == 3) { EpiGlaProj e{(bf16_t*)(st + ST_QK), (float*)(st + ST_GG), (bf16_t*)(st + ST_VV), (bf16_t*)(st + ST_ABUF), part, p.in[11], p.in[13], J.e.h}; gemm_phase(lds, DM, DM, DM, J.s, e); }
                else if (EN(26) && kind == 4) { EpiDilQK e{(bf16_t*)(ws + J.e.o_off), part, J.e.r}; gemm_phase(lds, DM, J.lda, DM, J.s, e); }
                else if (EN(27) && kind == 5) { EpiDilVT e{(bf16_t*)(ws + J.e.o_off), part, J.e.r}; gemm_phase(lds, DM, DM, J.ldb, J.s, e); }
                else if (EN(28) && kind == 6) { EpiScores e{(bf16_t*)(ws + J.e.o_off), part, (LAS f32x2*)(lds + LDS_X)}; gemm_phase(lds, DM, DM, DM, J.s, e); }
            }
        }
        __syncthreads();
        }
    }
}

extern "C" void kernel_launch(void* const* d_in, const int* in_sizes, int n_in, void* d_out, int out_size, void* d_ws, size_t ws_size, hipStream_t stream) {
    static int grid_blocks = 0;
    if (!grid_blocks) {
        int dev = 0, cus = 0, per_cu = 0;
        hipGetDevice(&dev);
        hipDeviceGetAttribute(&cus, hipDeviceAttributeMultiprocessorCount, dev);
        hipFuncSetAttribute((const void*)fwd_megakernel, hipFuncAttributeMaxDynamicSharedMemorySize, LDS_BYTES);
        hipOccupancyMaxActiveBlocksPerMultiprocessor(&per_cu, fwd_megakernel, 512, LDS_BYTES);
        if (per_cu < 1) per_cu = 1;
        if (per_cu > 1) per_cu = 1;
        grid_blocks = cus * per_cu;
    }
    if (n_in != 27 || ws_size < WS_NEED) { fprintf(stderr, "kernel_launch: unexpected n_in %d / ws_size %zu (need %zu)\n", n_in, ws_size, (size_t)WS_NEED); return; }
    hipMemsetAsync((char*)d_ws + OFF_CTL, 0, CTL_BYTES, stream);
    Params p{};
    for (int i = 0; i < 27; ++i) p.in[i] = (const float*)d_in[i];
    p.X = (float*)d_out; p.ws = (unsigned char*)d_ws; p.ph_lo = 0; p.ph_hi = 38;
    void* args[] = {&p};
    hipError_t e = hipLaunchCooperativeKernel((const void*)fwd_megakernel, dim3(grid_blocks), dim3(512), args, LDS_BYTES, stream);
    if (e != hipSuccess) fprintf(stderr, "cooperative launch failed: %s (grid %d)\n", hipGetErrorString(e), grid_blocks);
}
```

```cpp
#include <hip/hip_runtime.h>
#include <hip/hip_cooperative_groups.h>
#include <cstdio>
#include <cstdint>
namespace cg = cooperative_groups;

#define LAS __attribute__((address_space(3)))
typedef unsigned short bf16_t;
typedef short bf16x8 __attribute__((ext_vector_type(8)));
typedef short bf16x4 __attribute__((ext_vector_type(4)));
typedef float f32x4 __attribute__((ext_vector_type(4)));
typedef float f32x2 __attribute__((ext_vector_type(2)));
typedef unsigned u32x4 __attribute__((ext_vector_type(4)));
typedef unsigned u32x2 __attribute__((ext_vector_type(2)));

#ifndef OPMASK
#define OPMASK 0xFFFFFFFFu
#endif
#define EN(o) ((OPMASK >> (o)) & 1u)
#ifndef PROBE_REP
#define PROBE_REP 0u
#endif
#ifndef PROBE_SYNC
#define PROBE_SYNC 0
#endif
constexpr int T = 32768, DM = 1024, DFF = 2816;
constexpr float EPS = 1e-6f;
constexpr int BM = 256, BK = 64, HALF = 128, HTB = HALF * BK * 2, STAGE_BYTES = 8 * HTB, NXCD = 8, WGM = 8;
constexpr int LDS_X = STAGE_BYTES;
constexpr int LDS_BYTES = 160 * 1024;
constexpr int LDS_CTL = LDS_BYTES - 64;

constexpr size_t E_FFN1_IN = 0, E_FFN1_OUT = 5767168, E_FFN2_IN = 8650752, E_FFN2_OUT = 14417920, E_CQ = 17301504, E_CKV = 18350080,
                 E_CO = 20447232, E_MIX_IN = 21495808, E_MIX_OUT = 30932992, E_GT = 31981568, E_HM = 35127296, E_WEND = 38273024;
constexpr size_t OFF_XB = E_WEND * 2, OFF_PART = OFF_XB + (size_t)T * DM * 2, OFF_BTAB = OFF_PART + (size_t)T * 16, OFF_STAGE = OFF_BTAB + 32768;
constexpr size_t ST_HID = 0, ST_MEMN = 184549376, ST_KV = 186122240;
constexpr size_t ST_ABUF = 0, ST_QK = 67108864, ST_GG = 83886080, ST_VV = 117440512, ST_OF = 134217728, ST_OB = 167772160, ST_SLOC = 201326592, ST_DVEC = 209715200;
constexpr size_t ST_QKG = 67108864, ST_VTG = 167772160;
constexpr size_t OFF_CTL = OFF_STAGE + 218103808;
constexpr size_t CTL_BYTES = 16384;
constexpr size_t OFF_PARTV = OFF_CTL + CTL_BYTES;
constexpr size_t PARTV_BYTES = (size_t)T * 16;
constexpr size_t WS_NEED = OFF_PARTV + 9 * PARTV_BYTES;

struct Params {
    const float* in[27];
    float* X;
    unsigned char* ws;
    int ph_lo, ph_hi;
};

__device__ __forceinline__ unsigned cvt_pk_bf16(float lo, float hi) { unsigned r; asm volatile("v_cvt_pk_bf16_f32 %0, %1, %2" : "=v"(r) : "v"(lo), "v"(hi)); return r; }
__device__ __forceinline__ float bf2f(bf16_t b) { return __uint_as_float(((unsigned)b) << 16); }
__device__ __forceinline__ bf16_t f2bf(float f) { return (bf16_t)(cvt_pk_bf16(f, 0.f) & 0xffffu); }

__host__ __device__ __forceinline__ int lds_byte(int r, int c) { const int st = (r >> 4) * 2 + (c >> 5), rr = r & 15, cc = c & 31, ob = rr * 64 + cc * 2; return st * 1024 + (ob ^ (((ob >> 9) & 1) << 5)); }
__host__ __device__ __forceinline__ void stage_rc(int b, int& R, int& C) { const int st = b / 1024, sb = b % 1024, swz = sb ^ (((sb >> 9) & 1) << 5); R = (st >> 1) * 16 + swz / 64; C = (st & 1) * 32 + (swz % 64) / 2; }
__host__ __device__ __forceinline__ int perm32(int rho) { const int n = rho >> 4, i = rho & 15; return 8 * (i >> 2) + 4 * n + (i & 3); }

struct Unit { int pm, pn, b; const char* a; const char* bt; };

__device__ __forceinline__ int dil_token0(int n0, int r) {
    const int sb = n0 < 8192 ? 0 : (n0 < 16384 ? 8192 : 16384), S = n0 < 16384 ? 8192 : 16384, L = S / r;
    const int c = (n0 - sb) / L, l0 = (n0 - sb) % L;
    return sb + l0 * r + c;
}

struct Sched {
    const char* A; const char* Bt;
    int a_tile, b_tile, a_batch, b_batch, seqB;
    int nM, nN, nB, G, c, mode, r;
    __device__ __forceinline__ bool next(int i, Unit& u) const {
        const int per = nM * nN; const long tot = (long)per * nB;
        const long L = (long)i * G + c; if (L >= tot) return false;
        int b = (int)(L / per); int wgid = (int)(L % per);
        { const int q = per / NXCD, rr = per % NXCD, xcd = wgid % NXCD, off = wgid / NXCD; wgid = (xcd < rr ? xcd * (q + 1) : rr * (q + 1) + (xcd - rr) * q) + off; }
        const int nig = WGM * nN, gid = wgid / nig, fm = gid * WGM, gsz = (nM - fm) < WGM ? (nM - fm) : WGM;
        u.pm = fm + ((wgid % nig) % gsz); u.pn = (wgid % nig) / gsz; u.b = b;
        const char* a = A + (long)b * a_batch; const char* bt = Bt + (long)b * b_batch;
        if (mode == 2) a += (long)dil_token0(u.pm * 256, r) * (DM * 2); else a += (long)u.pm * a_tile;
        if (mode == 3) bt += (long)dil_token0(u.pn * 256, r) * (DM * 2); else bt += (long)u.pn * b_tile;
        if (mode == 1) { const int s = u.pm < 32 ? 0 : (u.pm < 64 ? 1 : 2); bt += (long)s * seqB; }
        u.a = a; u.bt = bt; return true;
    }
};


typedef unsigned long long u64_t;
__device__ __forceinline__ float ldsys_f(const float* p) { return __hip_atomic_load(p, __ATOMIC_RELAXED, __HIP_MEMORY_SCOPE_SYSTEM); }
__device__ __forceinline__ bf16_t ldsys_h(const bf16_t* p) { return __hip_atomic_load(p, __ATOMIC_RELAXED, __HIP_MEMORY_SCOPE_SYSTEM); }
__device__ __forceinline__ u32x2 ld_sys8(const void* p) {
    const u64_t a = __hip_atomic_load((const u64_t*)p, __ATOMIC_RELAXED, __HIP_MEMORY_SCOPE_SYSTEM); return (u32x2){(unsigned)a, (unsigned)(a >> 32)};
}
__device__ __forceinline__ u32x4 ld_sys16u(const void* p) {
    const u64_t* q = (const u64_t*)p;
    const u64_t a = __hip_atomic_load(q, __ATOMIC_RELAXED, __HIP_MEMORY_SCOPE_SYSTEM), b = __hip_atomic_load(q + 1, __ATOMIC_RELAXED, __HIP_MEMORY_SCOPE_SYSTEM);
    return (u32x4){(unsigned)a, (unsigned)(a >> 32), (unsigned)b, (unsigned)(b >> 32)};
}
__device__ __forceinline__ bf16x8 ld_sys16(const void* p) { return __builtin_bit_cast(bf16x8, ld_sys16u(p)); }
__device__ __forceinline__ f32x4 ld_sys16f(const void* p) { return __builtin_bit_cast(f32x4, ld_sys16u(p)); }

__device__ __forceinline__ float rstd_of(const float* part, int row) {
    const f32x4 p = *(const f32x4*)(part + (size_t)row * 4);
    return rsqrtf(((p[0] + p[1]) + (p[2] + p[3])) * (1.0f / 1024.0f) + EPS);
}


__device__ __forceinline__ void rstd8(const float* part, int row0, float (&rs)[8]) {
    f32x4 pp[8];
#pragma unroll
    for (int i = 0; i < 8; ++i) pp[i] = *(const f32x4*)(part + (size_t)(row0 + (i >> 2) * 128 + (i & 3) * 16) * 4);
#pragma unroll
    for (int i = 0; i < 8; ++i) rs[i] = rsqrtf(((pp[i][0] + pp[i][1]) + (pp[i][2] + pp[i][3])) * (1.0f / 1024.0f) + EPS);
}

#define LBAR() do { asm volatile("s_waitcnt lgkmcnt(0)" ::: "memory"); __builtin_amdgcn_s_barrier(); asm volatile("" ::: "memory"); } while (0)

struct EpiPlain {
    bf16_t* O; int ldc; int bstride;
    __device__ __forceinline__ void operator()(const f32x4 (&acc)[2][2][4][2], const Unit& u, int wr, int wc, int fr, int fq) const {
        bf16_t* base = O + (long)u.b * bstride;
#pragma unroll
        for (int ai = 0; ai < 2; ++ai)
#pragma unroll
            for (int m = 0; m < 4; ++m) { const int row = u.pm * 256 + ai * 128 + wr * 64 + m * 16 + fr;
#pragma unroll
                for (int bj = 0; bj < 2; ++bj) { const int col = u.pn * 256 + bj * 128 + wc * 32 + 8 * fq;
                    const f32x4 v0 = acc[ai][bj][m][0], v1 = acc[ai][bj][m][1];
                    u32x4 w; w.x = cvt_pk_bf16(v0[0], v0[1]); w.y = cvt_pk_bf16(v0[2], v0[3]); w.z = cvt_pk_bf16(v1[0], v1[1]); w.w = cvt_pk_bf16(v1[2], v1[3]);
                    *(u32x4*)(base + (long)row * ldc + col) = w; } }
    }
};
struct EpiSwiGLU {
    bf16_t* H; const float* part;
    __device__ __forceinline__ void operator()(const f32x4 (&acc)[2][2][4][2], const Unit& u, int wr, int wc, int fr, int fq) const {
        float rs8[8]; rstd8(part, u.pm * 256 + wr * 64 + fr, rs8);
#pragma unroll
        for (int ai = 0; ai < 2; ++ai)
#pragma unroll
            for (int m = 0; m < 4; ++m) { const int row = u.pm * 256 + ai * 128 + wr * 64 + m * 16 + fr; const float rs = rs8[ai * 4 + m];
                float h[8];
#pragma unroll
                for (int n = 0; n < 2; ++n)
#pragma unroll
                    for (int j = 0; j < 4; ++j) { const float a = acc[ai][0][m][n][j] * rs, b = acc[ai][1][m][n][j] * rs; h[n * 4 + j] = a * b / (1.0f + __expf(-a)); }
                u32x4 w; w.x = cvt_pk_bf16(h[0], h[1]); w.y = cvt_pk_bf16(h[2], h[3]); w.z = cvt_pk_bf16(h[4], h[5]); w.w = cvt_pk_bf16(h[6], h[7]);
                *(u32x4*)(H + (long)row * DFF + u.pn * 128 + wc * 32 + 8 * fq) = w; }
    }
};
struct EpiResid {
    float* X; bf16_t* XB; float* part; float scale; LAS float* xt;
    __device__ __forceinline__ void operator()(const f32x4 (&acc)[2][2][4][2], const Unit& u, int wr, int wc, int fr, int fq) const {
#pragma unroll
        for (int ai = 0; ai < 2; ++ai) {
            f32x4 xv[4][2][2];
#pragma unroll
            for (int m = 0; m < 4; ++m)
#pragma unroll
                for (int bj = 0; bj < 2; ++bj) { const float* xp = X + ((long)u.pm * 256 + ai * 128 + wr * 64 + m * 16 + fr) * DM + u.pn * 256 + bj * 128 + wc * 32 + 8 * fq;
                    xv[m][bj][0] = *(const f32x4*)xp; xv[m][bj][1] = *(const f32x4*)(xp + 4); }
#pragma unroll
            for (int m = 0; m < 4; ++m) { const int rl = ai * 128 + wr * 64 + m * 16 + fr; const long row = (long)u.pm * 256 + rl; float ss = 0.f;
#pragma unroll
                for (int bj = 0; bj < 2; ++bj) { const int col = u.pn * 256 + bj * 128 + wc * 32 + 8 * fq;
                    float* xp = X + row * DM + col;
                    const f32x4 x0 = xv[m][bj][0] + acc[ai][bj][m][0] * scale, x1 = xv[m][bj][1] + acc[ai][bj][m][1] * scale;
                    *(f32x4*)xp = x0; *(f32x4*)(xp + 4) = x1;
                    u32x4 w; w.x = cvt_pk_bf16(x0[0], x0[1]); w.y = cvt_pk_bf16(x0[2], x0[3]); w.z = cvt_pk_bf16(x1[0], x1[1]); w.w = cvt_pk_bf16(x1[2], x1[3]);
                    *(u32x4*)(XB + row * DM + col) = w;
                    ss += (x0[0] * x0[0] + x0[1] * x0[1]) + (x0[2] * x0[2] + x0[3] * x0[3]) + (x1[0] * x1[0] + x1[1] * x1[1]) + (x1[2] * x1[2] + x1[3] * x1[3]); }
                ss += __shfl_xor(ss, 16); ss += __shfl_xor(ss, 32);
                if (fq == 0) xt[rl * 4 + wc] = ss; }
            asm volatile("" ::: "memory");
        }
        LBAR();
        const int lane = fq * 16 + fr;
        if (lane < 32) { const int q = wc * 32 + lane, rl = (q >> 6) * 128 + wr * 64 + (q & 63);
            const f32x4 s = *(const LAS f32x4*)(xt + rl * 4);
            part[((size_t)u.pm * 256 + rl) * 4 + u.pn] = (s[0] + s[1]) + (s[2] + s[3]); }
    }
};
struct EpiGlaProj {
    bf16_t* QK; float* GG; bf16_t* VV; bf16_t* AB; const float* part; const float* bgf; const float* bgb; int h;
    __device__ __forceinline__ void operator()(const f32x4 (&acc)[2][2][4][2], const Unit& u, int wr, int wc, int fr, int fq) const {
        float rs8[8]; rstd8(part, u.pm * 256 + wr * 64 + fr, rs8);
#pragma unroll
        for (int ai = 0; ai < 2; ++ai)
#pragma unroll
            for (int m = 0; m < 4; ++m) { const long row = (long)u.pm * 256 + ai * 128 + wr * 64 + m * 16 + fr; const float rs = rs8[ai * 4 + m];
#pragma unroll
                for (int bj = 0; bj < 2; ++bj) { const int col = bj * 128 + wc * 32 + 8 * fq;
                    f32x4 v0 = acc[ai][bj][m][0] * rs, v1 = acc[ai][bj][m][1] * rs;
                    if (u.pn == 1) {
                        const float* bp = (bj == 0 ? bgf : bgb) + h * 128 + wc * 32 + 8 * fq;
                        const f32x4 b0 = *(const f32x4*)bp, b1 = *(const f32x4*)(bp + 4);
#pragma unroll
                        for (int j = 0; j < 4; ++j) { float z = v0[j] + b0[j]; v0[j] = (fminf(z, 0.f) - log1pf(__expf(-fabsf(z)))) * (1.0f / 16.0f);
                                                      z = v1[j] + b1[j]; v1[j] = (fminf(z, 0.f) - log1pf(__expf(-fabsf(z)))) * (1.0f / 16.0f); }
                        float* gp = GG + row * 256 + col; *(f32x4*)gp = v0; *(f32x4*)(gp + 4) = v1;
                    } else {
                        if (u.pn == 3) {
#pragma unroll
                            for (int j = 0; j < 4; ++j) { v0[j] = v0[j] / (1.0f + __expf(-v0[j])); v1[j] = v1[j] / (1.0f + __expf(-v1[j])); } }
                        u32x4 w; w.x = cvt_pk_bf16(v0[0], v0[1]); w.y = cvt_pk_bf16(v0[2], v0[3]); w.z = cvt_pk_bf16(v1[0], v1[1]); w.w = cvt_pk_bf16(v1[2], v1[3]);
                        bf16_t* dst = u.pn == 0 ? QK + row * 256 + col : (u.pn == 2 ? VV + row * 256 + col : AB + row * DM + h * 256 + col);
                        *(u32x4*)dst = w; } } }
    }
};
struct EpiDilQK {
    bf16_t* O; const float* part; int r;
    __device__ __forceinline__ void operator()(const f32x4 (&acc)[2][2][4][2], const Unit& u, int wr, int wc, int fr, int fq) const {
        const int tok0 = dil_token0(u.pm * 256, r);
        float rs8[8];
        { f32x4 pp[8];
#pragma unroll
          for (int i = 0; i < 8; ++i) pp[i] = *(const f32x4*)(part + (size_t)(tok0 + ((i >> 2) * 128 + wr * 64 + (i & 3) * 16 + fr) * r) * 4);
#pragma unroll
          for (int i = 0; i < 8; ++i) rs8[i] = rsqrtf(((pp[i][0] + pp[i][1]) + (pp[i][2] + pp[i][3])) * (1.0f / 1024.0f) + EPS); }
#pragma unroll
        for (int ai = 0; ai < 2; ++ai)
#pragma unroll
            for (int m = 0; m < 4; ++m) { const int rl = ai * 128 + wr * 64 + m * 16 + fr; const long row = (long)u.pm * 256 + rl; const float rs = rs8[ai * 4 + m];
#pragma unroll
                for (int bj = 0; bj < 2; ++bj) { const int col = u.pn * 256 + bj * 128 + wc * 32 + 8 * fq;
                    const f32x4 v0 = acc[ai][bj][m][0] * rs, v1 = acc[ai][bj][m][1] * rs;
                    u32x4 w; w.x = cvt_pk_bf16(v0[0], v0[1]); w.y = cvt_pk_bf16(v0[2], v0[3]); w.z = cvt_pk_bf16(v1[0], v1[1]); w.w = cvt_pk_bf16(v1[2], v1[3]);
                    *(u32x4*)(O + row * 512 + col) = w; }
                asm volatile("" ::: "memory"); }
    }
};
struct EpiDilVT {
    bf16_t* O; const float* part; int r;
    __device__ __forceinline__ void operator()(const f32x4 (&acc)[2][2][4][2], const Unit& u, int wr, int wc, int fr, int fq) const {
        const int tok0 = dil_token0(u.pn * 256, r);
#pragma unroll
        for (int bj = 0; bj < 2; ++bj) { const int cl = bj * 128 + wc * 32 + 8 * fq; float rs[8];
#pragma unroll
            for (int j = 0; j < 8; ++j) rs[j] = rstd_of(part, tok0 + (cl + j) * r);
#pragma unroll
            for (int ai = 0; ai < 2; ++ai)
#pragma unroll
                for (int m = 0; m < 4; ++m) { const int row = ai * 128 + wr * 64 + m * 16 + fr;
                    const f32x4 v0 = acc[ai][bj][m][0], v1 = acc[ai][bj][m][1];
                    u32x4 w; w.x = cvt_pk_bf16(v0[0] * rs[0], v0[1] * rs[1]); w.y = cvt_pk_bf16(v0[2] * rs[2], v0[3] * rs[3]);
                    w.z = cvt_pk_bf16(v1[0] * rs[4], v1[1] * rs[5]); w.w = cvt_pk_bf16(v1[2] * rs[6], v1[3] * rs[7]);
                    *(u32x4*)(O + (long)row * T + u.pn * 256 + cl) = w;
                    asm volatile("" ::: "memory"); } }
    }
};
struct EpiScores {
    bf16_t* P; const float* part; LAS f32x2* xt;
    __device__ __forceinline__ void operator()(const f32x4 (&acc)[2][2][4][2], const Unit& u, int wr, int wc, int fr, int fq) const {
        float rs8[8]; rstd8(part, u.pm * 256 + wr * 64 + fr, rs8);
#pragma unroll
        for (int ai = 0; ai < 2; ++ai)
#pragma unroll
            for (int m = 0; m < 4; ++m) { const int rl = ai * 128 + wr * 64 + m * 16 + fr; const float r_ = rs8[ai * 4 + m];
                float mx = -3.0e38f;
#pragma unroll
                for (int bj = 0; bj < 2; ++bj)
#pragma unroll
                    for (int n = 0; n < 2; ++n)
#pragma unroll
                        for (int j = 0; j < 4; ++j) mx = fmaxf(mx, acc[ai][bj][m][n][j] * r_);
                mx = fmaxf(mx, __shfl_xor(mx, 16)); mx = fmaxf(mx, __shfl_xor(mx, 32));
                float l = 0.f;
#pragma unroll
                for (int bj = 0; bj < 2; ++bj)
#pragma unroll
                    for (int n = 0; n < 2; ++n)
#pragma unroll
                        for (int j = 0; j < 4; ++j) l += __expf(acc[ai][bj][m][n][j] * r_ - mx);
                l += __shfl_xor(l, 16); l += __shfl_xor(l, 32);
                if (fq == 0) xt[rl * 4 + wc] = (f32x2){mx, l};
                asm volatile("" ::: "memory"); }
        LBAR();
#pragma unroll
        for (int ai = 0; ai < 2; ++ai)
#pragma unroll
            for (int m = 0; m < 4; ++m) { const int rl = ai * 128 + wr * 64 + m * 16 + fr; const long row = (long)u.pm * 256 + rl; const float r_ = rs8[ai * 4 + m];
                const f32x2 a = xt[rl * 4 + 0], b = xt[rl * 4 + 1], c = xt[rl * 4 + 2], d = xt[rl * 4 + 3];
                const float M = fmaxf(fmaxf(a.x, b.x), fmaxf(c.x, d.x));
                const float Ls = a.y * __expf(a.x - M) + b.y * __expf(b.x - M) + c.y * __expf(c.x - M) + d.y * __expf(d.x - M);
                const float inv = 1.0f / Ls;
#pragma unroll
                for (int bj = 0; bj < 2; ++bj) { const int col = u.pn * 256 + bj * 128 + wc * 32 + 8 * fq; float p[8];
#pragma unroll
                    for (int n = 0; n < 2; ++n)
#pragma unroll
                        for (int j = 0; j < 4; ++j) p[n * 4 + j] = __expf(acc[ai][bj][m][n][j] * r_ - M) * inv;
                    u32x4 w; w.x = cvt_pk_bf16(p[0], p[1]); w.y = cvt_pk_bf16(p[2], p[3]); w.z = cvt_pk_bf16(p[4], p[5]); w.w = cvt_pk_bf16(p[6], p[7]);
                    *(u32x4*)(P + row * DM + col) = w; }
                asm volatile("" ::: "memory"); }
    }
};


struct EpiAny {
    int kind;
    long o_off;
    int ldc, bstride; float scale; int h, r;
    __device__ __forceinline__ void operator()(const f32x4 (&acc)[2][2][4][2], const Unit& u, int wr, int wc, int fr, int fq, const Params& p, LAS unsigned char* lds) const {
        unsigned char* ws = p.ws; unsigned char* st = ws + OFF_STAGE; const float* part = (const float*)(ws + OFF_PART);
        if (EN(22) && kind == 0) { EpiPlain e{(bf16_t*)(ws + o_off), ldc, bstride}; e(acc, u, wr, wc, fr, fq); }
        else if (EN(23) && kind == 1) { EpiSwiGLU e{(bf16_t*)(ws + o_off), part}; e(acc, u, wr, wc, fr, fq); }
        else if (EN(24) && kind == 2) { EpiResid e{p.X, (bf16_t*)(ws + OFF_XB), (float*)(ws + OFF_PART), scale, (LAS float*)(lds + LDS_X)}; e(acc, u, wr, wc, fr, fq); }
        else if (EN(25) && kind == 3) { EpiGlaProj e{(bf16_t*)(st + ST_QK), (float*)(st + ST_GG), (bf16_t*)(st + ST_VV), (bf16_t*)(st + ST_ABUF), part, p.in[11], p.in[13], h}; e(acc, u, wr, wc, fr, fq); }
        else if (EN(26) && kind == 4) { EpiDilQK e{(bf16_t*)(ws + o_off), part, r}; e(acc, u, wr, wc, fr, fq); }
        else if (EN(27) && kind == 5) { EpiDilVT e{(bf16_t*)(ws + o_off), part, r}; e(acc, u, wr, wc, fr, fq); }
        else if (EN(28)) { EpiScores e{(bf16_t*)(ws + o_off), part, (LAS f32x2*)(lds + LDS_X)}; e(acc, u, wr, wc, fr, fq); }
    }
};

template <class Epi>
__device__ __forceinline__ void gemm_phase(LAS unsigned char* lds, const int K, const int lda, const int ldb, const Sched& S, const Epi& E) {
    int tid = threadIdx.x; asm volatile("" : "+v"(tid));
    const int wid = __builtin_amdgcn_readfirstlane(tid >> 6), lane = tid & 63, wr = wid >> 2, wc = wid & 3, fr = lane & 15, fq = lane >> 4;
    const int nt = K / BK;
    unsigned voffA[2], voffB[2];
#pragma unroll
    for (int i = 0; i < 2; ++i) { int R, C; stage_rc(tid * 16 + i * 8192, R, C); const int Rb = (R & ~31) + perm32(R & 31);
        voffA[i] = (unsigned)(R * lda + C) * 2u; voffB[i] = (unsigned)(Rb * ldb + C) * 2u; }
    const size_t kstep = (size_t)(BK * 2);
    const size_t hstepA = (size_t)HALF * lda * 2, hstepB = (size_t)HALF * ldb * 2;
    const unsigned ldsw = (unsigned)wid * 1024u;
    const int aoff = lds_byte(wr * 64 + fr, fq * 8), boff = lds_byte(wc * 32 + fr, fq * 8);
#define PG8_SA(b, h) (((b) * 2 + (h)) * HTB)
#define PG8_SB(b, h) ((4 + (b) * 2 + (h)) * HTB)
#define PG8_STAGE(bufoff, gbase, voff) do { _Pragma("unroll") for (int _i = 0; _i < 2; ++_i) \
        __builtin_amdgcn_global_load_lds((const unsigned*)((const char*)(gbase) + (voff)[_i]), (LAS unsigned*)(lds + (bufoff) + ldsw + _i * 8192), 16, 0, 0); } while (0)
#define PG8_LDA(dst, b, h) do { _Pragma("unroll") for (int m = 0; m < 4; ++m) _Pragma("unroll") for (int k = 0; k < 2; ++k) dst[m][k] = *(const LAS bf16x8*)(lds + PG8_SA(b, h) + aoff + m * 2048 + k * 1024); } while (0)
#define PG8_LDB(dst, b, h) do { _Pragma("unroll") for (int n = 0; n < 2; ++n) _Pragma("unroll") for (int k = 0; k < 2; ++k) dst[n][k] = *(const LAS bf16x8*)(lds + PG8_SB(b, h) + boff + n * 2048 + k * 1024); } while (0)
#define PG8_MMA(ai, bj, At, Bt) do { __builtin_amdgcn_s_setprio(1); _Pragma("unroll") for (int m = 0; m < 4; ++m) _Pragma("unroll") for (int n = 0; n < 2; ++n) _Pragma("unroll") for (int k = 0; k < 2; ++k) \
        acc[ai][bj][m][n] = __builtin_amdgcn_mfma_f32_16x16x32_bf16(Bt[n][k], At[m][k], acc[ai][bj][m][n], 0, 0, 0); __builtin_amdgcn_s_setprio(0); } while (0)
#define PG8_WAIT_V(n) asm volatile("s_waitcnt vmcnt(" #n ")" ::: "memory")
#define PG8_WAIT_L(n) asm volatile("s_waitcnt lgkmcnt(" #n ")" ::: "memory")
#define PG8_BAR __builtin_amdgcn_s_barrier()
#define PG8_SCHED __builtin_amdgcn_sched_barrier(0)
    Unit cur, nxt; int ui = 0;
    if (!S.next(0, cur)) return;
    f32x4 acc[2][2][4][2];
#pragma unroll
    for (int a = 0; a < 2; ++a)
#pragma unroll
        for (int b = 0; b < 2; ++b)
#pragma unroll
            for (int m = 0; m < 4; ++m)
#pragma unroll
                for (int n = 0; n < 2; ++n) acc[a][b][m][n] = (f32x4){0.f, 0.f, 0.f, 0.f};
    bf16x8 At[4][2], B0[2][2], B1[2][2];
    const char* cA = cur.a; const char* cB = cur.bt;
    PG8_STAGE(PG8_SB(0, 0), cB, voffB); PG8_STAGE(PG8_SA(0, 0), cA, voffA); PG8_STAGE(PG8_SB(0, 1), cB + hstepB, voffB); PG8_STAGE(PG8_SA(0, 1), cA + hstepA, voffA);
    if (wr == 1) PG8_BAR;
    PG8_WAIT_V(4); PG8_BAR;
    PG8_STAGE(PG8_SB(1, 0), cB + kstep, voffB); PG8_STAGE(PG8_SA(1, 0), cA + kstep, voffA); PG8_STAGE(PG8_SB(1, 1), cB + hstepB + kstep, voffB);
    PG8_WAIT_V(6); PG8_BAR;
    for (;;) {
        const bool has_next = S.next(ui + 1, nxt);
        const char* nA = has_next ? nxt.a : cA; const char* nB = has_next ? nxt.bt : cB;
        for (int t = 0; t < nt; t += 2) {
            const bool last = (t == nt - 2);
            const char* a1 = cA + (size_t)(t + 1) * kstep;
            const char* a2 = last ? nA : cA + (size_t)(t + 2) * kstep; const char* b2 = last ? nB : cB + (size_t)(t + 2) * kstep;
            const char* a3 = a2 + kstep; const char* b3 = b2 + kstep;
            PG8_LDB(B0, 0, 0); PG8_SCHED; PG8_LDA(At, 0, 0); PG8_STAGE(PG8_SA(1, 1), a1 + hstepA, voffA);
            PG8_WAIT_L(8); PG8_BAR; PG8_WAIT_L(0); PG8_MMA(0, 0, At, B0); PG8_BAR; PG8_SCHED;
            PG8_LDB(B1, 0, 1); PG8_STAGE(PG8_SB(0, 0), b2, voffB);
            PG8_BAR; PG8_WAIT_L(0); PG8_MMA(0, 1, At, B1); PG8_BAR;
            PG8_LDA(At, 0, 1); PG8_STAGE(PG8_SA(0, 0), a2, voffA);
            PG8_BAR; PG8_WAIT_L(0); PG8_MMA(1, 0, At, B0); PG8_BAR; PG8_SCHED;
            PG8_STAGE(PG8_SB(0, 1), b2 + hstepB, voffB);
            PG8_WAIT_V(6); PG8_BAR; PG8_MMA(1, 1, At, B1); PG8_BAR;
            PG8_LDB(B0, 1, 0); PG8_SCHED; PG8_LDA(At, 1, 0); PG8_STAGE(PG8_SA(0, 1), a2 + hstepA, voffA);
            PG8_WAIT_L(8); PG8_BAR; PG8_WAIT_L(0); PG8_MMA(0, 0, At, B0); PG8_BAR; PG8_SCHED;
            PG8_LDB(B1, 1, 1); PG8_STAGE(PG8_SB(1, 0), b3, voffB);
            PG8_BAR; PG8_WAIT_L(0); PG8_MMA(0, 1, At, B1); PG8_BAR;
            PG8_LDA(At, 1, 1); PG8_STAGE(PG8_SA(1, 0), a3, voffA);
            PG8_BAR; PG8_WAIT_L(0); PG8_MMA(1, 0, At, B0); PG8_BAR; PG8_SCHED;
            PG8_STAGE(PG8_SB(1, 1), b3 + hstepB, voffB);
            PG8_WAIT_V(6); PG8_BAR; PG8_MMA(1, 1, At, B1); PG8_BAR;
        }
        { int t2 = threadIdx.x; asm volatile("" : "+v"(t2)); const int w2 = __builtin_amdgcn_readfirstlane(t2 >> 6), l2 = t2 & 63;
          E(acc, cur, w2 >> 2, w2 & 3, l2 & 15, l2 >> 4); }
        if (!has_next) break;
#pragma unroll
        for (int a = 0; a < 2; ++a)
#pragma unroll
            for (int b = 0; b < 2; ++b)
#pragma unroll
                for (int m = 0; m < 4; ++m)
#pragma unroll
                    for (int n = 0; n < 2; ++n) acc[a][b][m][n] = (f32x4){0.f, 0.f, 0.f, 0.f};
        cur = nxt; cA = nA; cB = nB; ++ui;
    }
    PG8_WAIT_V(0);
    if (wr == 0) PG8_BAR;
    PG8_BAR;
#undef PG8_SA
#undef PG8_SB
#undef PG8_STAGE
#undef PG8_LDA
#undef PG8_LDB
#undef PG8_MMA
#undef PG8_WAIT_V
#undef PG8_WAIT_L
#undef PG8_BAR
#undef PG8_SCHED
}

__device__ __forceinline__ Sched mk_sched(const void* A, const void* Bt, int M, int N, int lda, int ldb, int rot) {
    Sched s; s.A = (const char*)A; s.Bt = (const char*)Bt; s.a_tile = 256 * lda * 2; s.b_tile = 256 * ldb * 2; s.a_batch = 0; s.b_batch = 0; s.seqB = 0;
    s.nM = M / 256; s.nN = N / 256; s.nB = 1; s.G = gridDim.x; s.c = (int)((blockIdx.x + (unsigned)rot) % gridDim.x); s.mode = 0; s.r = 1; return s;
}


struct GemmJob { int K, lda, ldb; Sched s; EpiAny e; };
__device__ __forceinline__ int rotc(int rot) { return (int)((blockIdx.x + gridDim.x - ((unsigned)rot % gridDim.x)) % gridDim.x); }
__device__ __forceinline__ bool get_job(const Params& p, int op, int arg, int j, GemmJob& J) {
    unsigned char* ws = p.ws; bf16_t* WB = (bf16_t*)ws; bf16_t* XB = (bf16_t*)(ws + OFF_XB); unsigned char* st = ws + OFF_STAGE;
    EpiAny e; e.kind = 0; e.o_off = 0; e.ldc = DM; e.bstride = 0; e.scale = 1.0f; e.h = 0; e.r = 1;
    J.K = DM; J.lda = DM; J.ldb = DM;
    if (op == 1) {
        if (j == 0) { J.s = mk_sched(st + ST_MEMN, WB + E_CKV, 768, 2048, DM, DM, 0); e.o_off = OFF_STAGE + ST_KV; e.ldc = 2048; }
        else if (j == 1) { J.s = mk_sched(XB, WB + E_FFN1_IN, T, 2 * DFF, DM, DM, 0); J.s.c = rotc(24); e.kind = 1; e.o_off = OFF_STAGE + ST_HID; }
        else return false;
    } else if (op == 2) {
        if (j == 0) { J.s = mk_sched(st + ST_HID, WB + E_FFN1_OUT, T, DM, DFF, DFF, 0); J.K = DFF; J.lda = DFF; J.ldb = DFF; e.kind = 2; e.scale = 0.5f; }
        else if (j <= 3) { const int sq = j - 1;
            J.s = mk_sched((const char*)(st + ST_KV) + (size_t)sq * 256 * 2048 * 2, WB + E_CQ, 256, 1024, 2048, DM, 0); J.s.nB = 4; J.s.a_batch = 512; J.s.b_batch = 512; J.s.c = rotc(sq * 16);
            J.K = 256; J.lda = 2048; J.ldb = DM; e.o_off = (E_GT + (size_t)sq * DM * DM) * 2; e.ldc = DM; e.bstride = 256 * DM; }
        else if (j <= 6) { const int sq = j - 4;
            J.s = mk_sched(WB + E_CO, (const char*)(st + ST_KV) + (size_t)sq * 256 * 2048 * 2 + 1024 * 2, 1024, 256, DM, 2048, 0); J.s.nB = 4; J.s.a_batch = 512; J.s.b_batch = 512; J.s.c = rotc(48 + sq * 16);
            J.K = 256; J.lda = DM; J.ldb = 2048; e.o_off = (E_HM + (size_t)sq * DM * DM) * 2; e.ldc = DM; e.bstride = 256; }
        else return false;
    } else if (op == 3) { if (j) return false; J.s = mk_sched(st + ST_ABUF, WB + E_MIX_OUT, T, DM, DM, DM, 0); e.kind = 2; }
    else if (op == 4) { if (j) return false; J.s = mk_sched(XB, WB + E_GT, T, DM, DM, DM, 0); J.s.mode = 1; J.s.seqB = DM * DM * 2; e.kind = 6; e.o_off = OFF_STAGE + ST_ABUF; }
    else if (op == 5) { if (j) return false; J.s = mk_sched(st + ST_ABUF, WB + E_HM, T, DM, DM, DM, 0); J.s.mode = 1; J.s.seqB = DM * DM * 2; e.kind = 2; }
    else if (op == 6) { if (j) return false; J.s = mk_sched(XB, WB + E_FFN2_IN, T, 2 * DFF, DM, DM, 0); e.kind = 1; e.o_off = OFF_STAGE + ST_HID; }
    else if (op == 7) { if (j) return false; J.s = mk_sched(st + ST_HID, WB + E_FFN2_OUT, T, DM, DFF, DFF, 0); J.K = DFF; J.lda = DFF; J.ldb = DFF; e.kind = 2; e.scale = 0.5f; }
    else if (op == 10) { if (j) return false; J.s = mk_sched(XB, WB + E_MIX_IN + (size_t)arg * 1024 * DM, T, 1024, DM, DM, 0); e.kind = 3; e.h = arg; }
    else if (op == 20) { if (j >= 6) return false; const int g = j >> 1, r = g == 0 ? 1 : (g == 1 ? 4 : 16); e.r = r;
        if ((j & 1) == 0) { J.s = mk_sched(XB, WB + E_MIX_IN + (size_t)(arg * 2304 + g * 512) * DM, T, 512, r * DM, DM, 0); J.s.mode = 2; J.s.r = r; J.s.c = rotc(g * 384);
            J.lda = r * DM; e.kind = 4; e.o_off = OFF_STAGE + ST_QKG + (size_t)g * T * 512 * 2; }
        else { J.s = mk_sched(WB + E_MIX_IN + (size_t)(arg * 2304 + 1536 + g * 256) * DM, XB, 256, T, DM, r * DM, 0); J.s.mode = 3; J.s.r = r; J.s.c = rotc(g * 384 + 256);
            J.ldb = r * DM; e.kind = 5; e.o_off = OFF_STAGE + ST_VTG + (size_t)g * 256 * T * 2; } }
    else return false;
    J.e = e; return true;
}

template <int NT>
__device__ __forceinline__ void conv_tiles(const float* src, int ld_src, const int (&k0)[NT], const int (&n0)[NT], bf16_t* dst, int ld_dst, const int (&dr0)[NT], const float* gain,
                                           const float (&scale)[NT], int nvalid, LAS float* tile) {
    int tid = threadIdx.x; asm volatile("" : "+v"(tid)); const int tx = tid & 63, ty = tid >> 6;
    float v[NT][8];
#pragma unroll
    for (int t = 0; t < NT; ++t) if (t < nvalid) {
#pragma unroll
        for (int i = 0; i < 8; ++i) v[t][i] = src[(size_t)(k0[t] + ty + 8 * i) * ld_src + n0[t] + tx];
    }
#pragma unroll
    for (int t = 0; t < NT; ++t) if (t < nvalid) {
#pragma unroll
        for (int i = 0; i < 8; ++i) { float x = v[t][i] * scale[t]; if (gain) x *= gain[k0[t] + ty + 8 * i]; tile[t * 4160 + (ty + 8 * i) * 65 + tx] = x; }
    }
    __syncthreads();
    const int i2 = tid & 31;
#pragma unroll
    for (int t = 0; t < NT; ++t) if (t < nvalid) {
#pragma unroll
        for (int jj = 0; jj < 4; ++jj) { const int j = (tid >> 5) + 16 * jj; const float a = tile[t * 4160 + (2 * i2) * 65 + j], b = tile[t * 4160 + (2 * i2 + 1) * 65 + j];
            *(unsigned*)(dst + (size_t)(dr0[t] + j) * ld_dst + k0[t] + 2 * i2) = cvt_pk_bf16(a, b); }
    }
    __syncthreads();
}
__device__ __forceinline__ int map_row(int kind, int n0, float& scale) {
    scale = 1.0f;
    if (EN(23) && kind == 1) { if (n0 < DFF) return (n0 / 128) * 256 + (n0 % 128); const int j = n0 - DFF; return (j / 128) * 256 + 128 + (j % 128); }
    if (EN(24) && kind == 2) {
        if (n0 < 512) { scale = 0.08838834764831845f; return (n0 / 128) * 1024 + (n0 % 128); }
        if (n0 < 1024) { const int j = n0 - 512; return (j / 128) * 1024 + 128 + (j % 128); }
        if (n0 < 2048) { const int j = n0 - 1024; return (j / 256) * 1024 + 512 + (j % 256); }
        const int j = n0 - 2048; return (j / 256) * 1024 + 768 + (j % 256);
    }
    if (EN(25) && kind == 3) { const int tg = n0 / 1024, h = (n0 % 1024) / 64, t = tg / 3, g = tg % 3, hc = h >> 2, hl = h & 3;
        if (t == 0) scale = 0.125f;
        if (t < 2) return hc * 2304 + g * 512 + t * 256 + hl * 64;
        return hc * 2304 + 1536 + g * 256 + hl * 64; }
    return n0;
}
__device__ __forceinline__ void conv_weight(const float* src, int K, int N, int ld_src, bf16_t* dst, const float* gain, int kind, LAS float* tile, int& rot) {
    constexpr int NT = 4;
    const int nk = K / 64, nn = N / 64, tot = nk * nn, G = gridDim.x;
    for (int t0 = (int)((blockIdx.x + G - (rot % G)) % G); t0 < tot; t0 += G * NT) {
        int k0[NT], n0[NT], dr0[NT]; float sc[NT]; int nvalid = 0;
#pragma unroll
        for (int j = 0; j < NT; ++j) { const int t = t0 + j * G; const bool ok = t < tot; const int tt = ok ? t : t0; const int kt = tt % nk, ntile = tt / nk;
            k0[j] = kt * 64; n0[j] = ntile * 64; dr0[j] = map_row(kind, ntile * 64, sc[j]); nvalid += ok ? 1 : 0; }
        conv_tiles<NT>(src, ld_src, k0, n0, dst, K, dr0, gain, sc, nvalid, tile);
    }
    rot += tot;
}
__device__ __forceinline__ const float* x_in_row(const Params& p, int t) { return t < 16384 ? p.in[0] + (size_t)t * DM : p.in[1] + (size_t)(t - 16384) * DM; }

__device__ __forceinline__ void phase_prologue(const Params& p, int layer, LAS unsigned char* lds) {
    unsigned char* ws = p.ws; bf16_t* WB = (bf16_t*)ws; LAS float* tile = (LAS float*)lds;
    int tid = threadIdx.x; asm volatile("" : "+v"(tid)); const int lane = tid & 63, wid = tid >> 6, nwv = gridDim.x * 8, gw = blockIdx.x * 8 + wid;
    int rot = 0;
    conv_weight(p.in[6] + (size_t)layer * DM * 2 * DFF, DM, 2 * DFF, 2 * DFF, WB + E_FFN1_IN, p.in[5] + layer * DM, 1, tile, rot);
    conv_weight(p.in[7] + (size_t)layer * DFF * DM, DFF, DM, DM, WB + E_FFN1_OUT, nullptr, 0, tile, rot);
    conv_weight(p.in[24] + (size_t)layer * DM * 2 * DFF, DM, 2 * DFF, 2 * DFF, WB + E_FFN2_IN, p.in[23] + layer * DM, 1, tile, rot);
    conv_weight(p.in[25] + (size_t)layer * DFF * DM, DFF, DM, DM, WB + E_FFN2_OUT, nullptr, 0, tile, rot);
    conv_weight(p.in[21] + (size_t)layer * DM * 2048, DM, 2048, 2048, WB + E_CKV, nullptr, 0, tile, rot);
    conv_weight(p.in[22] + (size_t)layer * DM * DM, DM, DM, DM, WB + E_CO, nullptr, 0, tile, rot);
    if (layer == 0) {
        conv_weight(p.in[9], DM, 3072, 3104, WB + E_MIX_IN, p.in[8], 2, tile, rot);
        conv_weight(p.in[15], DM, DM, DM, WB + E_MIX_OUT, nullptr, 0, tile, rot);
        for (size_t idx = (size_t)blockIdx.x * 512 + tid; idx < (size_t)2 * 512 * 1024; idx += (size_t)gridDim.x * 512) {
            const int c = (int)(idx & 1023), n = (int)((idx >> 10) & 511), dir = (int)(idx >> 19);
            const float* wi = p.in[9] + (size_t)c * 3104 + 3072 + dir * 16; const float* wg = (dir ? p.in[12] : p.in[10]) + n;
            float s = 0.f;
#pragma unroll
            for (int r = 0; r < 16; ++r) s += wi[r] * wg[r * 512];
            s *= p.in[8][c];
            WB[E_MIX_IN + (size_t)((n >> 7) * 1024 + 256 + dir * 128 + (n & 127)) * DM + c] = f2bf(s);
        }
    } else {
        conv_weight(p.in[16], DM, 9216, 9216, WB + E_MIX_IN, p.in[8] + DM, 3, tile, rot);
        conv_weight(p.in[17], DM, DM, DM, WB + E_MIX_OUT, nullptr, 0, tile, rot);
    }
    { const float* src = p.in[20] + (size_t)layer * DM * DM; const float* g = p.in[18] + layer * DM;
      for (size_t idx = ((size_t)blockIdx.x * 512 + tid) * 4; idx < (size_t)DM * DM; idx += (size_t)gridDim.x * 512 * 4) {
          const f32x4 v = *(const f32x4*)(src + idx); const float s = g[idx >> 10] * 0.0625f;
          u32x2 w; w.x = cvt_pk_bf16(v[0] * s, v[1] * s); w.y = cvt_pk_bf16(v[2] * s, v[3] * s);
          *(u32x2*)(WB + E_CQ + idx) = w; } }
    { bf16_t* MEMN = (bf16_t*)(ws + OFF_STAGE + ST_MEMN); const float* g = p.in[19] + layer * DM;
      for (int row = gw; row < 768; row += nwv) {
          const float* src = row < 512 ? p.in[2] + (size_t)row * DM : p.in[3] + (size_t)(row - 512) * DM;
          f32x4 v[4]; float ss = 0.f;
#pragma unroll
          for (int i = 0; i < 4; ++i) { v[i] = *(const f32x4*)(src + i * 256 + lane * 4); ss += (v[i][0] * v[i][0] + v[i][1] * v[i][1]) + (v[i][2] * v[i][2] + v[i][3] * v[i][3]); }
#pragma unroll
          for (int o = 1; o < 64; o <<= 1) ss += __shfl_xor(ss, o);
          const float rs = rsqrtf(ss * (1.0f / 1024.0f) + EPS);
#pragma unroll
          for (int i = 0; i < 4; ++i) { const f32x4 gg = *(const f32x4*)(g + i * 256 + lane * 4);
              u32x2 w; w.x = cvt_pk_bf16(v[i][0] * rs * gg[0], v[i][1] * rs * gg[1]); w.y = cvt_pk_bf16(v[i][2] * rs * gg[2], v[i][3] * rs * gg[3]);
              *(u32x2*)(MEMN + (size_t)row * DM + i * 256 + lane * 4) = w; } } }
    if (layer == 0) {
        bf16_t* XB = (bf16_t*)(ws + OFF_XB); float* part = (float*)(ws + OFF_PARTV);
        for (int row = gw; row < T; row += nwv) {
            const float* src = x_in_row(p, row); f32x4 v[4]; float ss = 0.f;
#pragma unroll
            for (int i = 0; i < 4; ++i) { v[i] = *(const f32x4*)(src + i * 256 + lane * 4); ss += (v[i][0] * v[i][0] + v[i][1] * v[i][1]) + (v[i][2] * v[i][2] + v[i][3] * v[i][3]); }
#pragma unroll
            for (int o = 1; o < 64; o <<= 1) ss += __shfl_xor(ss, o);
#pragma unroll
            for (int i = 0; i < 4; ++i) { *(f32x4*)(p.X + (size_t)row * DM + i * 256 + lane * 4) = v[i];
                u32x2 w; w.x = cvt_pk_bf16(v[i][0], v[i][1]); w.y = cvt_pk_bf16(v[i][2], v[i][3]);
                *(u32x2*)(XB + (size_t)row * DM + i * 256 + lane * 4) = w; }
            if (lane == 0) *(f32x4*)(part + (size_t)row * 4) = (f32x4){ss, 0.f, 0.f, 0.f};
        }
        float* bt = (float*)(ws + OFF_BTAB);
        for (int idx = blockIdx.x * 512 + tid; idx < 3 * 16 * 129; idx += gridDim.x * 512) {
            const int rel = idx % 129 - 64, h = (idx / 129) % 16, g = idx / (129 * 16); const int r = g == 0 ? 1 : (g == 1 ? 4 : 16);
            const int rr = rel * r, n = rr < 0 ? -rr : rr; int bk;
            if (n < 8) bk = n; else bk = 8 + (n >= 15) + (n >= 27) + (n >= 50) + (n >= 91) + (n >= 166) + (n >= 305) + (n >= 559);
            if (rr > 0) bk += 16;
            bt[idx] = p.in[4][bk * 48 + g * 16 + h];
        }
    }
}

__device__ __forceinline__ void phase_final(const Params& p) {
    const float* part = (const float*)(p.ws + OFF_PARTV + 8 * PARTV_BYTES); const float* g = p.in[26];
    int tid = threadIdx.x; asm volatile("" : "+v"(tid)); const int lane = tid & 63, wid = tid >> 6, nwv = gridDim.x * 8, gw = blockIdx.x * 8 + wid;
    for (int row = gw; row < T; row += nwv) { const float rs = rstd_of(part, row);
#pragma unroll
        for (int i = 0; i < 4; ++i) { float* xp = p.X + (size_t)row * DM + i * 256 + lane * 4; const f32x4 v = ld_sys16f(xp); const f32x4 gg = *(const f32x4*)(g + i * 256 + lane * 4);
            *(f32x4*)xp = (f32x4){v[0] * rs * gg[0], v[1] * rs * gg[1], v[2] * rs * gg[2], v[3] * rs * gg[3]}; } }
}

__device__ __forceinline__ void gla_combine(const Params& p, int h) {
    unsigned char* st = p.ws + OFF_STAGE; const float* OF = (const float*)(st + ST_OF); const float* OB = (const float*)(st + ST_OB); bf16_t* AB = (bf16_t*)(st + ST_ABUF);
    const float* gn = p.in[14] + h * 256;
    int tid = threadIdx.x; asm volatile("" : "+v"(tid)); const int lane = tid & 63, wid = tid >> 6, nwv = gridDim.x * 8, gw = blockIdx.x * 8 + wid;
    const f32x4 gg = *(const f32x4*)(gn + lane * 4);
    for (int row = gw; row < T; row += nwv) {
        const f32x4 a = ld_sys16f(OF + (size_t)row * 256 + lane * 4), b = ld_sys16f(OB + (size_t)row * 256 + lane * 4);
        const f32x4 o = a + b; float ss = (o[0] * o[0] + o[1] * o[1]) + (o[2] * o[2] + o[3] * o[3]);
#pragma unroll
        for (int s = 1; s < 64; s <<= 1) ss += __shfl_xor(ss, s);
        const float rs = rsqrtf(ss * (1.0f / 256.0f) + EPS);
        bf16_t* ap = AB + (size_t)row * DM + h * 256 + lane * 4; const u32x2 rr = ld_sys8(ap);
        const float r0 = __uint_as_float(rr.x << 16), r1 = __uint_as_float(rr.x & 0xffff0000u), r2 = __uint_as_float(rr.y << 16), r3 = __uint_as_float(rr.y & 0xffff0000u);
        u32x2 w; w.x = cvt_pk_bf16(o[0] * rs * gg[0] * r0, o[1] * rs * gg[1] * r1); w.y = cvt_pk_bf16(o[2] * rs * gg[2] * r2, o[3] * rs * gg[3] * r3);
        *(u32x2*)ap = w;
    }
}

constexpr int SC_QP = 0, SC_KP = 17408, SC_KT = 34816, SC_VT = 53248, SC_ATT = 62464, SC_SS = 71680, SC_QS = 89088, SC_BL = 91136;

template <bool OUT>
__device__ __forceinline__ void gla_scan(const Params& p, LAS unsigned char* lds) {
    unsigned char* st = p.ws + OFF_STAGE;
    const bf16_t* QK = (const bf16_t*)(st + ST_QK); const float* GG = (const float*)(st + ST_GG); const bf16_t* VV = (const bf16_t*)(st + ST_VV);
    float* SLOC = (float*)(st + ST_SLOC); float* DVEC = (float*)(st + ST_DVEC);
    int tid = threadIdx.x; asm volatile("" : "+v"(tid)); const int lane = tid & 63, w = tid >> 6, l15 = lane & 15, quad = lane >> 4;
    LAS bf16_t* QP = (LAS bf16_t*)(lds + SC_QP); LAS bf16_t* KP = (LAS bf16_t*)(lds + SC_KP); LAS bf16_t* KT = (LAS bf16_t*)(lds + SC_KT);
    LAS bf16_t* VT = (LAS bf16_t*)(lds + SC_VT); LAS bf16_t* ATT = (LAS bf16_t*)(lds + SC_ATT); LAS bf16_t* SS = (LAS bf16_t*)(lds + SC_SS);
    LAS float* QS = (LAS float*)(lds + SC_QS); LAS float* BL = (LAS float*)(lds + SC_BL);
    for (int unit = blockIdx.x; unit < 256; unit += gridDim.x) {
        const int slice = unit & 3, dir = (unit >> 2) & 1, seg = unit >> 3;
        const int sfirst = seg < 8 ? 0 : (seg < 16 ? 8 : 16), nseg = seg < 16 ? 8 : 16;
        const int sigma = dir == 0 ? seg - sfirst : sfirst + nseg - 1 - seg;
        float* oout = (float*)(st + (dir == 0 ? ST_OF : ST_OB));
        f32x4 S[4];
#pragma unroll
        for (int d = 0; d < 4; ++d) S[d] = (f32x4){0.f, 0.f, 0.f, 0.f};
        if (OUT) {
            for (int sp = 0; sp < sigma; ++sp) {
                const int sg = dir == 0 ? sfirst + sp : sfirst + nseg - 1 - sp;
                const float* sl = SLOC + (size_t)(sg * 2 + dir) * 128 * 256; const float* dv = DVEC + (size_t)(sg * 2 + dir) * 128;
#pragma unroll
                for (int r = 0; r < 4; ++r) { const int dk = 16 * w + 4 * quad + r; const float dd = ldsys_f(dv + dk);
#pragma unroll
                    for (int d = 0; d < 4; ++d) S[d][r] = S[d][r] * dd + ldsys_f(sl + (size_t)dk * 256 + slice * 64 + d * 16 + l15); }
            }
        }
        float dsum = 0.f;
        const int dkc = tid & 127, qr = tid >> 7;
        const int dvc = tid & 63, jr = tid >> 6;
        for (int ch = 0; ch < 16; ++ch) {
            const int tb = seg * 1024 + (dir == 0 ? ch * 64 : (15 - ch) * 64);
            float g[16]; float q[16], k[16];
#pragma unroll
            for (int ii = 0; ii < 16; ++ii) { const int ip = qr * 16 + ii; const int tok = tb + (dir == 0 ? ip : 63 - ip);
                g[ii] = ldsys_f(GG + (size_t)tok * 256 + dir * 128 + dkc);
                if (OUT) q[ii] = bf2f(ldsys_h(QK + (size_t)tok * 256 + dkc));
                k[ii] = bf2f(ldsys_h(QK + (size_t)tok * 256 + 128 + dkc)); }
            unsigned vpk[4];
            { float v[8];
#pragma unroll
              for (int jj = 0; jj < 8; ++jj) { const int jp = jr * 8 + jj; const int tok = tb + (dir == 0 ? jp : 63 - jp); v[jj] = bf2f(ldsys_h(VV + (size_t)tok * 256 + slice * 64 + dvc)); }
#pragma unroll
              for (int jj = 0; jj < 4; ++jj) vpk[jj] = cvt_pk_bf16(v[2 * jj], v[2 * jj + 1]); }
#pragma unroll
            for (int ii = 1; ii < 16; ++ii) g[ii] += g[ii - 1];
            QS[qr * 128 + dkc] = g[15];
            *(LAS u32x4*)(VT + dvc * 72 + jr * 8) = (u32x4){vpk[0], vpk[1], vpk[2], vpk[3]};
            __syncthreads();
            float off = 0.f, tot = 0.f;
#pragma unroll
            for (int qq = 0; qq < 4; ++qq) { const float s = QS[qq * 128 + dkc]; tot += s; if (qq < qr) off += s; }
            if (qr == 0) { BL[dkc] = __expf(tot); dsum += tot; }
            unsigned kt[8];
#pragma unroll
            for (int ii = 0; ii < 16; ii += 2) {
                const float b0 = off + g[ii], b1 = off + g[ii + 1];
                if (OUT) { const int ip = qr * 16 + ii;
                    QP[ip * 136 + dkc] = f2bf(q[ii] * __expf(b0)); QP[(ip + 1) * 136 + dkc] = f2bf(q[ii + 1] * __expf(b1));
                    KP[ip * 136 + dkc] = f2bf(k[ii] * __expf(-b0)); KP[(ip + 1) * 136 + dkc] = f2bf(k[ii + 1] * __expf(-b1)); }
                kt[ii >> 1] = cvt_pk_bf16(k[ii] * __expf(tot - b0), k[ii + 1] * __expf(tot - b1));
            }
            *(LAS u32x4*)(KT + dkc * 72 + qr * 16) = (u32x4){kt[0], kt[1], kt[2], kt[3]};
            *(LAS u32x4*)(KT + dkc * 72 + qr * 16 + 8) = (u32x4){kt[4], kt[5], kt[6], kt[7]};
            if (OUT) {
#pragma unroll
                for (int d = 0; d < 4; ++d) { u32x2 sw; sw.x = cvt_pk_bf16(S[d][0], S[d][1]); sw.y = cvt_pk_bf16(S[d][2], S[d][3]);
                    *(LAS u32x2*)(SS + (d * 16 + l15) * 136 + 16 * w + 4 * quad) = sw; }
            }
            __syncthreads();
            f32x4 O[2];
            if (OUT) {
                const int it = w >> 1, c0 = (w & 1) * 2;
                f32x4 at[2] = {(f32x4){0.f, 0.f, 0.f, 0.f}, (f32x4){0.f, 0.f, 0.f, 0.f}};
                O[0] = (f32x4){0.f, 0.f, 0.f, 0.f}; O[1] = (f32x4){0.f, 0.f, 0.f, 0.f};
#pragma unroll
                for (int kk = 0; kk < 4; ++kk) {
                    const bf16x8 af = *(const LAS bf16x8*)(QP + (it * 16 + l15) * 136 + kk * 32 + quad * 8);
#pragma unroll
                    for (int x = 0; x < 2; ++x) {
                        const bf16x8 kf = *(const LAS bf16x8*)(KP + ((c0 + x) * 16 + l15) * 136 + kk * 32 + quad * 8);
                        at[x] = __builtin_amdgcn_mfma_f32_16x16x32_bf16(af, kf, at[x], 0, 0, 0);
                        const bf16x8 sf = *(const LAS bf16x8*)(SS + ((c0 + x) * 16 + l15) * 136 + kk * 32 + quad * 8);
                        O[x] = __builtin_amdgcn_mfma_f32_16x16x32_bf16(af, sf, O[x], 0, 0, 0);
                    }
                }
#pragma unroll
                for (int x = 0; x < 2; ++x)
#pragma unroll
                    for (int r = 0; r < 4; ++r) { const int i = it * 16 + quad * 4 + r, j = (c0 + x) * 16 + l15;
                        ATT[i * 72 + j] = f2bf(j <= i ? at[x][r] : 0.f); }
            }
            {
#pragma unroll
                for (int r = 0; r < 4; ++r) { const float dd = BL[16 * w + 4 * quad + r];
#pragma unroll
                    for (int d = 0; d < 4; ++d) S[d][r] *= dd; }
#pragma unroll
                for (int kk = 0; kk < 2; ++kk) {
                    const bf16x8 af = *(const LAS bf16x8*)(KT + (16 * w + l15) * 72 + kk * 32 + quad * 8);
#pragma unroll
                    for (int d = 0; d < 4; ++d) { const bf16x8 vf = *(const LAS bf16x8*)(VT + (d * 16 + l15) * 72 + kk * 32 + quad * 8);
                        S[d] = __builtin_amdgcn_mfma_f32_16x16x32_bf16(af, vf, S[d], 0, 0, 0); }
                }
            }
            if (OUT) {
                __syncthreads();
                const int it = w >> 1, c0 = (w & 1) * 2;
#pragma unroll
                for (int kk = 0; kk < 2; ++kk) {
                    const bf16x8 af = *(const LAS bf16x8*)(ATT + (it * 16 + l15) * 72 + kk * 32 + quad * 8);
#pragma unroll
                    for (int x = 0; x < 2; ++x) { const bf16x8 vf = *(const LAS bf16x8*)(VT + ((c0 + x) * 16 + l15) * 72 + kk * 32 + quad * 8);
                        O[x] = __builtin_amdgcn_mfma_f32_16x16x32_bf16(af, vf, O[x], 0, 0, 0); }
                }
#pragma unroll
                for (int x = 0; x < 2; ++x)
#pragma unroll
                    for (int r = 0; r < 4; ++r) { const int ip = it * 16 + quad * 4 + r; const int tok = tb + (dir == 0 ? ip : 63 - ip);
                        oout[(size_t)tok * 256 + slice * 64 + (c0 + x) * 16 + l15] = O[x][r]; }
            }
            __syncthreads();
        }
        if (!OUT) {
            float* sl = SLOC + (size_t)(seg * 2 + dir) * 128 * 256;
#pragma unroll
            for (int r = 0; r < 4; ++r) { const int dk = 16 * w + 4 * quad + r;
#pragma unroll
                for (int d = 0; d < 4; ++d) sl[(size_t)dk * 256 + slice * 64 + d * 16 + l15] = S[d][r]; }
            if (slice == 0 && tid < 128) DVEC[(size_t)(seg * 2 + dir) * 128 + tid] = __expf(dsum);
        }
    }
}

typedef float f32x16 __attribute__((ext_vector_type(16)));
__device__ __forceinline__ void dil_attn(const Params& p, int hc, LAS unsigned char* lds) {
    unsigned char* st = p.ws + OFF_STAGE; bf16_t* AB = (bf16_t*)(st + ST_ABUF); const float* btab = (const float*)(p.ws + OFF_BTAB);
    LAS float* OST = (LAS float*)lds; LAS float* MST = (LAS float*)(lds + 139264); LAS float* LST = (LAS float*)(lds + 141312); LAS float* BTL = (LAS float*)(lds + 143360);
    int tid = threadIdx.x; asm volatile("" : "+v"(tid)); const int lane = tid & 63, w = tid >> 6, l31 = lane & 31, hh = lane >> 5;
    const int kap = (l31 & 16) | ((l31 & 4) << 1) | ((l31 & 8) >> 1) | (l31 & 3);
    for (int unit = blockIdx.x; unit < 256; unit += gridDim.x) {
        const int hl = unit & 3, tbk = unit >> 2, t0 = tbk * 512;
        const int sb = t0 < 8192 ? 0 : (t0 < 16384 ? 8192 : 16384), Sq = t0 < 16384 ? 8192 : 16384;
        const int h = hc * 4 + hl;
#pragma unroll 1
        for (int g = 0; g < 3; ++g) {
            const int r = g == 0 ? 1 : (g == 1 ? 4 : 16), L = Sq / r;
            const bf16_t* QKg = (const bf16_t*)(st + ST_QKG) + (size_t)g * T * 512; const bf16_t* VTg = (const bf16_t*)(st + ST_VTG) + (size_t)g * 256 * T;
            const float* bt = btab + (g * 16 + h) * 129;
            if (tid < 256) { const int ri = tid - 96; BTL[tid] = (ri >= 0 && ri <= 128) ? bt[ri] : 0.f; }
            __syncthreads();
#pragma unroll 1
            for (int itx = 0; itx < 2; ++itx) {
                const int item = 2 * w + itx;
                int c, l0;
                if (g == 0) { c = 0; l0 = (t0 - sb) + 32 * item; } else if (g == 1) { c = item >> 2; l0 = (t0 - sb) / 4 + 32 * (item & 3); } else { c = item; l0 = (t0 - sb) / 16; }
                const int nq0 = sb + c * L + l0, nbase = nq0 - 64;
                const int tokl = (l0 + l31) * r + c - (t0 - sb);
                bf16x8 qf[4];
#pragma unroll
                for (int ks = 0; ks < 4; ++ks) qf[ks] = ld_sys16(QKg + (unsigned)((nq0 + l31) * 512 + hl * 64 + ks * 16 + hh * 8));
                f32x16 sT[5];
                bf16x8 kf[4];
#define DIL_LOADK(kt) do { const int lkh_ = l0 - 64 + 32 * (kt) + (l31 & 16); const bool in_ = (lkh_ >= 0) && (lkh_ < L); \
                    const int nrow_ = in_ ? nbase + 32 * (kt) + kap : nq0 + l31; \
                    _Pragma("unroll") for (int ks_ = 0; ks_ < 4; ++ks_) kf[ks_] = ld_sys16(QKg + (unsigned)(nrow_ * 512 + 256 + hl * 64 + ks_ * 16 + hh * 8)); } while (0)
#pragma unroll
                for (int kt = 0; kt < 5; ++kt) {
                    DIL_LOADK(kt);
                    f32x16 a;
#pragma unroll
                    for (int j = 0; j < 16; ++j) a[j] = 0.f;
#pragma unroll
                    for (int ks = 0; ks < 4; ++ks) a = __builtin_amdgcn_mfma_f32_32x32x16_bf16(kf[ks], qf[ks], a, 0, 0, 0);
                    sT[kt] = a;
                }
                bf16x8 vf[4];
#define DIL_LOADV(kt) do { _Pragma("unroll") for (int s_ = 0; s_ < 2; ++s_) { const int lkh_ = l0 - 64 + 32 * (kt) + 16 * s_; const bool in_ = (lkh_ >= 0) && (lkh_ < L); \
                    const int ncol_ = in_ ? nbase + 32 * (kt) + 16 * s_ + 8 * hh : nq0; \
                    _Pragma("unroll") for (int dt_ = 0; dt_ < 2; ++dt_) vf[2 * s_ + dt_] = ld_sys16(VTg + (unsigned)((hl * 64 + dt_ * 32 + l31) * T + ncol_)); } } while (0)
                DIL_LOADV(0);
#pragma unroll
                for (int kt = 0; kt < 5; ++kt)
#pragma unroll
                    for (int j = 0; j < 16; ++j) { const int lkh = l0 - 64 + 32 * kt + 16 * (j >> 3); const bool inr = (lkh >= 0) && (lkh < L);
                        const int rel = -64 + 32 * kt + 16 * (j >> 3) + 8 * hh + (j & 7) - l31; const bool ok = inr && rel >= -64 && rel <= 64;
                        sT[kt][j] = ok ? sT[kt][j] + BTL[rel + 160] : -1.0e30f; }
                float mo = -1.0e30f, lo = 0.f;
                if (g > 0) { mo = MST[tokl]; lo = LST[tokl]; }
                float mx = mo;
#pragma unroll
                for (int kt = 0; kt < 5; ++kt)
#pragma unroll
                    for (int j = 0; j < 16; ++j) mx = fmaxf(mx, sT[kt][j]);
                mx = fmaxf(mx, __shfl_xor(mx, 32));
                const float alpha = __expf(mo - mx);
                float ls = 0.f;
#pragma unroll
                for (int kt = 0; kt < 5; ++kt)
#pragma unroll
                    for (int j = 0; j < 16; ++j) { const float e = __expf(sT[kt][j] - mx); sT[kt][j] = e; ls += e; }
                ls += __shfl_xor(ls, 32);
                const float ln = lo * alpha + ls;
                f32x16 O[2];
#pragma unroll
                for (int dt = 0; dt < 2; ++dt)
#pragma unroll
                    for (int j = 0; j < 16; ++j) O[dt][j] = 0.f;
                if (g > 0) {
#pragma unroll
                    for (int dt = 0; dt < 2; ++dt)
#pragma unroll
                        for (int g4 = 0; g4 < 4; ++g4) { const f32x4 o4 = *(const LAS f32x4*)(OST + tokl * 68 + dt * 32 + g4 * 8 + hh * 4);
                            O[dt][4 * g4] = o4[0] * alpha; O[dt][4 * g4 + 1] = o4[1] * alpha; O[dt][4 * g4 + 2] = o4[2] * alpha; O[dt][4 * g4 + 3] = o4[3] * alpha; } }
#pragma unroll
                for (int kt = 0; kt < 5; ++kt) {
                    if (kt > 0) DIL_LOADV(kt);
#pragma unroll
                    for (int s2 = 0; s2 < 2; ++s2) {
                        u32x4 pw; pw.x = cvt_pk_bf16(sT[kt][8 * s2], sT[kt][8 * s2 + 1]); pw.y = cvt_pk_bf16(sT[kt][8 * s2 + 2], sT[kt][8 * s2 + 3]);
                        pw.z = cvt_pk_bf16(sT[kt][8 * s2 + 4], sT[kt][8 * s2 + 5]); pw.w = cvt_pk_bf16(sT[kt][8 * s2 + 6], sT[kt][8 * s2 + 7]);
                        const bf16x8 pf = __builtin_bit_cast(bf16x8, pw);
#pragma unroll
                        for (int dt = 0; dt < 2; ++dt) O[dt] = __builtin_amdgcn_mfma_f32_32x32x16_bf16(vf[2 * s2 + dt], pf, O[dt], 0, 0, 0);
                    }
                }
#undef DIL_LOADK
#undef DIL_LOADV
                if (g < 2) {
                    if (hh == 0) { MST[tokl] = mx; LST[tokl] = ln; }
#pragma unroll
                    for (int dt = 0; dt < 2; ++dt)
#pragma unroll
                        for (int g4 = 0; g4 < 4; ++g4) *(LAS f32x4*)(OST + tokl * 68 + dt * 32 + g4 * 8 + hh * 4) = (f32x4){O[dt][4 * g4], O[dt][4 * g4 + 1], O[dt][4 * g4 + 2], O[dt][4 * g4 + 3]};
                } else {
                    const float inv = 1.0f / ln;
#pragma unroll
                    for (int dt = 0; dt < 2; ++dt)
#pragma unroll
                        for (int g4 = 0; g4 < 4; ++g4) { u32x2 ow; ow.x = cvt_pk_bf16(O[dt][4 * g4] * inv, O[dt][4 * g4 + 1] * inv); ow.y = cvt_pk_bf16(O[dt][4 * g4 + 2] * inv, O[dt][4 * g4 + 3] * inv);
                            *(u32x2*)(AB + (size_t)(t0 + tokl) * DM + h * 64 + dt * 32 + g4 * 8 + hh * 4) = ow; }
                }
            }
            __syncthreads();
        }
    }
}

#define XB_TMO      128
#define XB_XCNT(j)  (256  + 64 * (j))
#define XB_XSUB(j)  (1280 + 64 * (j))
#define XB_XGEN(j)  (2304 + 64 * (j))
#define XB_TOP      3328
#define XB_TOPGEN   3392
#define XCD_BAR_WORDS 3456
#define XB_SPIN_CAP (1u << 22)
__device__ __forceinline__ unsigned xb_ld(unsigned* p)              { return __hip_atomic_load(p, __ATOMIC_RELAXED, __HIP_MEMORY_SCOPE_AGENT); }
__device__ __forceinline__ unsigned xb_add(unsigned* p, unsigned v) { return __hip_atomic_fetch_add(p, v, __ATOMIC_RELAXED, __HIP_MEMORY_SCOPE_AGENT); }
__device__ __forceinline__ unsigned xb_xcc_id() { return (unsigned)__builtin_amdgcn_s_getreg((3 << 11) | 20) & 0xFu; }
#define XB_SPIN(cond, bar) do { unsigned _sp = 0; while (cond) { __builtin_amdgcn_s_sleep(1); \
    if ((++_sp & 255u) == 0u) { if (xb_ld(&(bar)[XB_TMO])) break; if (_sp > XB_SPIN_CAP) { atomicAdd(&(bar)[XB_TMO], 1u); break; } } } } while (0)
struct XcdBarrier { unsigned* bar; unsigned x; volatile LAS unsigned* st; };
__device__ __forceinline__ XcdBarrier xcd_barrier_post(unsigned* bar, volatile LAS unsigned* st) {
    XcdBarrier b; b.bar = bar; b.x = xb_xcc_id(); b.st = st;
    if (threadIdx.x == 0) (void)xb_add(&bar[XB_XCNT(b.x)], 1u);
    return b;
}
__device__ __forceinline__ void xcd_barrier_complete(unsigned* bar, unsigned x, unsigned& nloc, unsigned& nx) {
    const unsigned G = gridDim.x * gridDim.y * gridDim.z;
    unsigned sum, cnt, mine, sp = 0u;
    for (;;) {
        sum = 0u; cnt = 0u; mine = 0u;
#pragma unroll
        for (unsigned j = 0; j < 16; ++j) { const unsigned c = xb_ld(&bar[XB_XCNT(j)]); sum += c; cnt += (c > 0u) ? 1u : 0u; mine = (j == x) ? c : mine; }
        if (sum == G) break;
        __builtin_amdgcn_s_sleep(1);
        if ((++sp & 255u) == 0u) { if (xb_ld(&bar[XB_TMO])) break; if (sp > XB_SPIN_CAP) { atomicAdd(&bar[XB_TMO], 1u); break; } }
    }
    nloc = mine > 0u ? mine : 1u; nx = cnt > 0u ? cnt : 1u;
}
__device__ __forceinline__ void xcd_barrier(const XcdBarrier& b) {
    asm volatile("s_waitcnt vmcnt(0)" ::: "memory");
    __syncthreads();
    if (threadIdx.x == 0) {
        unsigned* bar = b.bar;
        __builtin_amdgcn_s_waitcnt(0);
        unsigned nloc = b.st[0], nx = b.st[1];
        if (nloc == 0u) { xcd_barrier_complete(bar, b.x, nloc, nx); b.st[0] = nloc; b.st[1] = nx; }
        const unsigned old = xb_add(&bar[XB_XSUB(b.x)], 1u);
        const unsigned gen = old / nloc;
        if (old + 1u == (gen + 1u) * nloc) {
            __builtin_amdgcn_fence(__ATOMIC_RELEASE, "agent");
            asm volatile("s_waitcnt vmcnt(0)" ::: "memory");
            const unsigned og = xb_add(&bar[XB_TOP], 1u);
            const unsigned tg = og / nx;
            if (og + 1u == (tg + 1u) * nx) xb_add(&bar[XB_TOPGEN], 1u);
            else XB_SPIN(xb_ld(&bar[XB_TOPGEN]) == tg, bar);
            __builtin_amdgcn_fence(__ATOMIC_ACQUIRE, "agent");
            xb_add(&bar[XB_XGEN(b.x)], 1u);
            asm volatile("s_waitcnt vmcnt(0)" ::: "memory");
        } else {
            XB_SPIN(xb_ld(&bar[XB_XGEN(b.x)]) == gen, bar);
            __builtin_amdgcn_fence(__ATOMIC_ACQUIRE, "agent");
            asm volatile("s_waitcnt vmcnt(0)" ::: "memory");
        }
    }
    __syncthreads();
}

__global__ void __launch_bounds__(512, 2) fwd_megakernel(Params p) {
    extern __shared__ __attribute__((aligned(16))) unsigned char smem[];
    LAS unsigned char* lds = (LAS unsigned char*)smem;
    cg::grid_group grid = cg::this_grid();
    if (threadIdx.x < 2) ((volatile LAS unsigned*)(lds + LDS_CTL))[threadIdx.x] = 0u;
    __syncthreads();
    const XcdBarrier bar = xcd_barrier_post((unsigned*)(p.ws + OFF_CTL), (volatile LAS unsigned*)(lds + LDS_CTL));
    grid.sync();
    unsigned char* ws = p.ws; bf16_t* WB = (bf16_t*)ws; bf16_t* XB = (bf16_t*)(ws + OFF_XB); float* part = (float*)(ws + OFF_PART);
    unsigned char* st = ws + OFF_STAGE;
    for (int ph = p.ph_lo; ph < p.ph_hi; ++ph) {
        if (ph > p.ph_lo) { for (int xs = 0; xs <= PROBE_SYNC; ++xs) xcd_barrier(bar); }
        if (ph == 37) { phase_final(p); continue; }
        const int layer = ph >= 21 ? 1 : 0, q = ph - layer * 21;
        int op = -1, arg = 0;
        if (q == 0) op = 0; else if (q == 1) op = 1; else if (q == 2) op = 2;
        else if (layer == 0) {
            if (q <= 14) { const int hh = (q - 3) / 3, s = (q - 3) % 3; arg = hh; op = 10 + s; }
            else if (q == 15) { op = 13; arg = 3; } else op = q - 16 + 3;
        } else {
            if (q <= 10) { arg = (q - 3) >> 1; op = 20 + ((q - 3) & 1); } else op = q - 11 + 3;
        }
        if (op == 10 && arg > 0) gla_combine(p, arg - 1);
        for (int rep = 0; rep < (((PROBE_REP >> op) & 1u) ? 2 : 1); ++rep) {
        if (op == 0) { if (EN(0)) phase_prologue(p, layer, lds); }
        else if (op == 11) { if (EN(11)) gla_scan<false>(p, lds); }
        else if (op == 12) { if (EN(12)) gla_scan<true>(p, lds); }
        else if (op == 13) { if (EN(13)) gla_combine(p, arg); }
        else if (op == 21) { if (EN(21)) dil_attn(p, arg, lds); }
        else if (EN(1)) {
            GemmJob J;
            for (int j = 0; j < 8; ++j) { if (!get_job(p, op, arg, j, J)) break;
                const int nres = layer * 4 + (op >= 7 ? 3 : (op >= 5 && op < 10 ? 2 : (op == 4 || op == 3 ? 1 : (op == 2 ? 0 : (op == 1 ? 0 : (op == 6 ? 3 : 1))))));
                const int vr = (op == 1) ? layer * 4 : ((op == 10 || op == 20) ? layer * 4 + 1 : (op == 4 ? layer * 4 + 2 : layer * 4 + 3));
                const float* part = (const float*)(ws + OFF_PARTV + (size_t)vr * PARTV_BYTES); float* partw = (float*)(ws + OFF_PARTV + (size_t)(nres + 1) * PARTV_BYTES); const int kind = J.e.kind;
                if (EN(22) && kind == 0) { EpiPlain e{(bf16_t*)(ws + J.e.o_off), J.e.ldc, J.e.bstride}; gemm_phase(lds, J.K, J.lda, J.ldb, J.s, e); }
                else if (EN(23) && kind == 1) { EpiSwiGLU e{(bf16_t*)(ws + J.e.o_off), part}; gemm_phase(lds, DM, DM, DM, J.s, e); }
                else if (EN(24) && kind == 2) { EpiResid e{p.X, XB, partw, J.e.scale, (LAS float*)(lds + LDS_X)}; gemm_phase(lds, J.K, J.K, J.K, J.s, e); }
                else if (EN(25) && kind == 3) { EpiGlaProj e{(bf16_t*)(st + ST_QK), (float*)(st + ST_GG), (bf16_t*)(st + ST_VV), (bf16_t*)(st + ST_ABUF), part, p.in[11], p.in[13], J.e.h}; gemm_phase(lds, DM, DM, DM, J.s, e); }
                else if (EN(26) && kind == 4) { EpiDilQK e{(bf16_t*)(ws + J.e.o_off), part, J.e.r}; gemm_phase(lds, DM, J.lda, DM, J.s, e); }
                else if (EN(27) && kind == 5) { EpiDilVT e{(bf16_t*)(ws + J.e.o_off), part, J.e.r}; gemm_phase(lds, DM, DM, J.ldb, J.s, e); }
                else if (EN(28) && kind == 6) { EpiScores e{(bf16_t*)(ws + J.e.o_off), part, (LAS f32x2*)(lds + LDS_X)}; gemm_phase(lds, DM, DM, DM, J.s, e); }
            }
        }
        __syncthreads();
        }
    }
}

extern "C" void kernel_launch(void* const* d_in, const int* in_sizes, int n_in, void* d_out, int out_size, void* d_ws, size_t ws_size, hipStream_t stream) {
    static int grid_blocks = 0;
    if (!grid_blocks) {
        int dev = 0, cus = 0, per_cu = 0;
        hipGetDevice(&dev);
        hipDeviceGetAttribute(&cus, hipDeviceAttributeMultiprocessorCount, dev);
        hipFuncSetAttribute((const void*)fwd_megakernel, hipFuncAttributeMaxDynamicSharedMemorySize, LDS_BYTES);
        hipOccupancyMaxActiveBlocksPerMultiprocessor(&per_cu, fwd_megakernel, 512, LDS_BYTES);
        if (per_cu < 1) per_cu = 1;
        if (per_cu > 1) per_cu = 1;
        grid_blocks = cus * per_cu;
    }
    if (n_in != 27 || ws_size < WS_NEED) { fprintf(stderr, "kernel_launch: unexpected n_in %d / ws_size %zu (need %zu)\n", n_in, ws_size, (size_t)WS_NEED); return; }
    hipMemsetAsync((char*)d_ws + OFF_CTL, 0, CTL_BYTES, stream);
    Params p{};
    for (int i = 0; i < 27; ++i) p.in[i] = (const float*)d_in[i];
    p.X = (float*)d_out; p.ws = (unsigned char*)d_ws; p.ph_lo = 0; p.ph_hi = 38;
    void* args[] = {&p};
    hipError_t e = hipLaunchCooperativeKernel((const void*)fwd_megakernel, dim3(grid_blocks), dim3(512), args, LDS_BYTES, stream);
    if (e != hipSuccess) fprintf(stderr, "cooperative launch failed: %s (grid %d)\n", hipGetErrorString(e), grid_blocks);
}
```

```cpp
#include <hip/hip_runtime.h>
#include <hip/hip_cooperative_groups.h>
#include <cstdio>
#include <cstdint>
namespace cg = cooperative_groups;

#define LAS __attribute__((address_space(3)))
typedef unsigned short bf16_t;
typedef short bf16x8 __attribute__((ext_vector_type(8)));
typedef short bf16x4 __attribute__((ext_vector_type(4)));
typedef float f32x4 __attribute__((ext_vector_type(4)));
typedef float f32x2 __attribute__((ext_vector_type(2)));
typedef unsigned u32x4 __attribute__((ext_vector_type(4)));
typedef unsigned u32x2 __attribute__((ext_vector_type(2)));

#ifndef OPMASK
#define OPMASK 0xFFFFFFFFu
#endif
#define EN(o) ((OPMASK >> (o)) & 1u)
#ifndef PROBE_REP
#define PROBE_REP 0u
#endif
#ifndef PROBE_SYNC
#define PROBE_SYNC 0
#endif
constexpr int T = 32768, DM = 1024, DFF = 2816;
constexpr float EPS = 1e-6f;
constexpr int BM = 256, BK = 64, HALF = 128, HTB = HALF * BK * 2, STAGE_BYTES = 8 * HTB, NXCD = 8, WGM = 8;
constexpr int LDS_X = STAGE_BYTES;
constexpr int LDS_BYTES = 160 * 1024;
constexpr int LDS_CTL = LDS_BYTES - 64;

constexpr size_t E_FFN1_IN = 0, E_FFN1_OUT = 5767168, E_FFN2_IN = 8650752, E_FFN2_OUT = 14417920, E_CQ = 17301504, E_CKV = 18350080,
                 E_CO = 20447232, E_MIX_IN = 21495808, E_MIX_OUT = 30932992, E_GT = 31981568, E_HM = 35127296, E_WEND = 38273024;
constexpr size_t OFF_XB = E_WEND * 2, OFF_PART = OFF_XB + (size_t)T * DM * 2, OFF_BTAB = OFF_PART + (size_t)T * 16, OFF_STAGE = OFF_BTAB + 32768;
constexpr size_t ST_HID = 0, ST_MEMN = 184549376, ST_KV = 186122240;
constexpr size_t ST_ABUF = 0, ST_QK = 67108864, ST_GG = 83886080, ST_VV = 117440512, ST_OF = 134217728, ST_OB = 167772160, ST_SLOC = 201326592, ST_DVEC = 209715200;
constexpr size_t ST_QKG = 67108864, ST_VTG = 167772160;
constexpr size_t OFF_CTL = OFF_STAGE + 218103808;
constexpr size_t CTL_BYTES = 16384;
constexpr size_t OFF_PARTV = OFF_CTL + CTL_BYTES;
constexpr size_t PARTV_BYTES = (size_t)T * 16;
constexpr size_t WS_NEED = OFF_PARTV + 9 * PARTV_BYTES;

struct Params {
    const float* in[27];
    float* X;
    unsigned char* ws;
    int ph_lo, ph_hi;
};

__device__ __forceinline__ unsigned cvt_pk_bf16(float lo, float hi) { unsigned r; asm volatile("v_cvt_pk_bf16_f32 %0, %1, %2" : "=v"(r) : "v"(lo), "v"(hi)); return r; }
__device__ __forceinline__ float bf2f(bf16_t b) { return __uint_as_float(((unsigned)b) << 16); }
__device__ __forceinline__ bf16_t f2bf(float f) { return (bf16_t)(cvt_pk_bf16(f, 0.f) & 0xffffu); }

__host__ __device__ __forceinline__ int lds_byte(int r, int c) { const int st = (r >> 4) * 2 + (c >> 5), rr = r & 15, cc = c & 31, ob = rr * 64 + cc * 2; return st * 1024 + (ob ^ (((ob >> 9) & 1) << 5)); }
__host__ __device__ __forceinline__ void stage_rc(int b, int& R, int& C) { const int st = b / 1024, sb = b % 1024, swz = sb ^ (((sb >> 9) & 1) << 5); R = (st >> 1) * 16 + swz / 64; C = (st & 1) * 32 + (swz % 64) / 2; }
__host__ __device__ __forceinline__ int perm32(int rho) { const int n = rho >> 4, i = rho & 15; return 8 * (i >> 2) + 4 * n + (i & 3); }

struct Unit { int pm, pn, b; const char* a; const char* bt; };

__device__ __forceinline__ int dil_token0(int n0, int r) {
    const int sb = n0 < 8192 ? 0 : (n0 < 16384 ? 8192 : 16384), S = n0 < 16384 ? 8192 : 16384, L = S / r;
    const int c = (n0 - sb) / L, l0 = (n0 - sb) % L;
    return sb + l0 * r + c;
}

struct Sched {
    const char* A; const char* Bt;
    int a_tile, b_tile, a_batch, b_batch, seqB;
    int nM, nN, nB, G, c, mode, r;
    __device__ __forceinline__ bool next(int i, Unit& u) const {
        const int per = nM * nN; const long tot = (long)per * nB;
        const long L = (long)i * G + c; if (L >= tot) return false;
        int b = (int)(L / per); int wgid = (int)(L % per);
        { const int q = per / NXCD, rr = per % NXCD, xcd = wgid % NXCD, off = wgid / NXCD; wgid = (xcd < rr ? xcd * (q + 1) : rr * (q + 1) + (xcd - rr) * q) + off; }
        const int nig = WGM * nN, gid = wgid / nig, fm = gid * WGM, gsz = (nM - fm) < WGM ? (nM - fm) : WGM;
        u.pm = fm + ((wgid % nig) % gsz); u.pn = (wgid % nig) / gsz; u.b = b;
        const char* a = A + (long)b * a_batch; const char* bt = Bt + (long)b * b_batch;
        if (mode == 2) a += (long)dil_token0(u.pm * 256, r) * (DM * 2); else a += (long)u.pm * a_tile;
        if (mode == 3) bt += (long)dil_token0(u.pn * 256, r) * (DM * 2); else bt += (long)u.pn * b_tile;
        if (mode == 1) { const int s = u.pm < 32 ? 0 : (u.pm < 64 ? 1 : 2); bt += (long)s * seqB; }
        u.a = a; u.bt = bt; return true;
    }
};


typedef unsigned long long u64_t;
__device__ __forceinline__ float ldsys_f(const float* p) { return __hip_atomic_load(p, __ATOMIC_RELAXED, __HIP_MEMORY_SCOPE_SYSTEM); }
__device__ __forceinline__ bf16_t ldsys_h(const bf16_t* p) { return __hip_atomic_load(p, __ATOMIC_RELAXED, __HIP_MEMORY_SCOPE_SYSTEM); }
__device__ __forceinline__ u32x2 ld_sys8(const void* p) {
    const u64_t a = __hip_atomic_load((const u64_t*)p, __ATOMIC_RELAXED, __HIP_MEMORY_SCOPE_SYSTEM); return (u32x2){(unsigned)a, (unsigned)(a >> 32)};
}
__device__ __forceinline__ u32x4 ld_sys16u(const void* p) {
    const u64_t* q = (const u64_t*)p;
    const u64_t a = __hip_atomic_load(q, __ATOMIC_RELAXED, __HIP_MEMORY_SCOPE_SYSTEM), b = __hip_atomic_load(q + 1, __ATOMIC_RELAXED, __HIP_MEMORY_SCOPE_SYSTEM);
    return (u32x4){(unsigned)a, (unsigned)(a >> 32), (unsigned)b, (unsigned)(b >> 32)};
}
__device__ __forceinline__ bf16x8 ld_sys16(const void* p) { return __builtin_bit_cast(bf16x8, ld_sys16u(p)); }
__device__ __forceinline__ f32x4 ld_sys16f(const void* p) { return __builtin_bit_cast(f32x4, ld_sys16u(p)); }

__device__ __forceinline__ float rstd_of(const float* part, int row) {
    const f32x4 p = *(const f32x4*)(part + (size_t)row * 4);
    return rsqrtf(((p[0] + p[1]) + (p[2] + p[3])) * (1.0f / 1024.0f) + EPS);
}


__device__ __forceinline__ void rstd8(const float* part, int row0, float (&rs)[8]) {
    f32x4 pp[8];
#pragma unroll
    for (int i = 0; i < 8; ++i) pp[i] = *(const f32x4*)(part + (size_t)(row0 + (i >> 2) * 128 + (i & 3) * 16) * 4);
#pragma unroll
    for (int i = 0; i < 8; ++i) rs[i] = rsqrtf(((pp[i][0] + pp[i][1]) + (pp[i][2] + pp[i][3])) * (1.0f / 1024.0f) + EPS);
}

#define LBAR() do { asm volatile("s_waitcnt lgkmcnt(0)" ::: "memory"); __builtin_amdgcn_s_barrier(); asm volatile("" ::: "memory"); } while (0)

struct EpiPlain {
    bf16_t* O; int ldc; int bstride;
    __device__ __forceinline__ void operator()(const f32x4 (&acc)[2][2][4][2], const Unit& u, int wr, int wc, int fr, int fq) const {
        bf16_t* base = O + (long)u.b * bstride;
#pragma unroll
        for (int ai = 0; ai < 2; ++ai)
#pragma unroll
            for (int m = 0; m < 4; ++m) { const int row = u.pm * 256 + ai * 128 + wr * 64 + m * 16 + fr;
#pragma unroll
                for (int bj = 0; bj < 2; ++bj) { const int col = u.pn * 256 + bj * 128 + wc * 32 + 8 * fq;
                    const f32x4 v0 = acc[ai][bj][m][0], v1 = acc[ai][bj][m][1];
                    u32x4 w; w.x = cvt_pk_bf16(v0[0], v0[1]); w.y = cvt_pk_bf16(v0[2], v0[3]); w.z = cvt_pk_bf16(v1[0], v1[1]); w.w = cvt_pk_bf16(v1[2], v1[3]);
                    *(u32x4*)(base + (long)row * ldc + col) = w; } }
    }
};
struct EpiSwiGLU {
    bf16_t* H; const float* part;
    __device__ __forceinline__ void operator()(const f32x4 (&acc)[2][2][4][2], const Unit& u, int wr, int wc, int fr, int fq) const {
        float rs8[8]; rstd8(part, u.pm * 256 + wr * 64 + fr, rs8);
#pragma unroll
        for (int ai = 0; ai < 2; ++ai)
#pragma unroll
            for (int m = 0; m < 4; ++m) { const int row = u.pm * 256 + ai * 128 + wr * 64 + m * 16 + fr; const float rs = rs8[ai * 4 + m];
                float h[8];
#pragma unroll
                for (int n = 0; n < 2; ++n)
#pragma unroll
                    for (int j = 0; j < 4; ++j) { const float a = acc[ai][0][m][n][j] * rs, b = acc[ai][1][m][n][j] * rs; h[n * 4 + j] = a * b * __builtin_amdgcn_rcpf(1.0f + __expf(-a)); }
                u32x4 w; w.x = cvt_pk_bf16(h[0], h[1]); w.y = cvt_pk_bf16(h[2], h[3]); w.z = cvt_pk_bf16(h[4], h[5]); w.w = cvt_pk_bf16(h[6], h[7]);
                *(u32x4*)(H + (long)row * DFF + u.pn * 128 + wc * 32 + 8 * fq) = w; }
    }
};
struct EpiResid {
    float* X; bf16_t* XB; float* part; float scale; LAS float* xt;
    __device__ __forceinline__ void operator()(const f32x4 (&acc)[2][2][4][2], const Unit& u, int wr, int wc, int fr, int fq) const {
#pragma unroll
        for (int ai = 0; ai < 2; ++ai) {
            f32x4 xv[4][2][2];
#pragma unroll
            for (int m = 0; m < 4; ++m)
#pragma unroll
                for (int bj = 0; bj < 2; ++bj) { const float* xp = X + ((long)u.pm * 256 + ai * 128 + wr * 64 + m * 16 + fr) * DM + u.pn * 256 + bj * 128 + wc * 32 + 8 * fq;
                    xv[m][bj][0] = *(const f32x4*)xp; xv[m][bj][1] = *(const f32x4*)(xp + 4); }
#pragma unroll
            for (int m = 0; m < 4; ++m) { const int rl = ai * 128 + wr * 64 + m * 16 + fr; const long row = (long)u.pm * 256 + rl; float ss = 0.f;
#pragma unroll
                for (int bj = 0; bj < 2; ++bj) { const int col = u.pn * 256 + bj * 128 + wc * 32 + 8 * fq;
                    float* xp = X + row * DM + col;
                    const f32x4 x0 = xv[m][bj][0] + acc[ai][bj][m][0] * scale, x1 = xv[m][bj][1] + acc[ai][bj][m][1] * scale;
                    *(f32x4*)xp = x0; *(f32x4*)(xp + 4) = x1;
                    u32x4 w; w.x = cvt_pk_bf16(x0[0], x0[1]); w.y = cvt_pk_bf16(x0[2], x0[3]); w.z = cvt_pk_bf16(x1[0], x1[1]); w.w = cvt_pk_bf16(x1[2], x1[3]);
                    *(u32x4*)(XB + row * DM + col) = w;
                    ss += (x0[0] * x0[0] + x0[1] * x0[1]) + (x0[2] * x0[2] + x0[3] * x0[3]) + (x1[0] * x1[0] + x1[1] * x1[1]) + (x1[2] * x1[2] + x1[3] * x1[3]); }
                ss += __shfl_xor(ss, 16); ss += __shfl_xor(ss, 32);
                if (fq == 0) xt[rl * 4 + wc] = ss; }
            asm volatile("" ::: "memory");
        }
        LBAR();
        const int lane = fq * 16 + fr;
        if (lane < 32) { const int q = wc * 32 + lane, rl = (q >> 6) * 128 + wr * 64 + (q & 63);
            const f32x4 s = *(const LAS f32x4*)(xt + rl * 4);
            part[((size_t)u.pm * 256 + rl) * 4 + u.pn] = (s[0] + s[1]) + (s[2] + s[3]); }
    }
};
struct EpiGlaProj {
    bf16_t* QK; float* GG; bf16_t* VV; bf16_t* AB; const float* part; const float* bgf; const float* bgb; int h;
    __device__ __forceinline__ void operator()(const f32x4 (&acc)[2][2][4][2], const Unit& u, int wr, int wc, int fr, int fq) const {
        float rs8[8]; rstd8(part, u.pm * 256 + wr * 64 + fr, rs8);
#pragma unroll
        for (int ai = 0; ai < 2; ++ai)
#pragma unroll
            for (int m = 0; m < 4; ++m) { const long row = (long)u.pm * 256 + ai * 128 + wr * 64 + m * 16 + fr; const float rs = rs8[ai * 4 + m];
#pragma unroll
                for (int bj = 0; bj < 2; ++bj) { const int col = bj * 128 + wc * 32 + 8 * fq;
                    f32x4 v0 = acc[ai][bj][m][0] * rs, v1 = acc[ai][bj][m][1] * rs;
                    if (u.pn == 1) {
                        const float* bp = (bj == 0 ? bgf : bgb) + h * 128 + wc * 32 + 8 * fq;
                        const f32x4 b0 = *(const f32x4*)bp, b1 = *(const f32x4*)(bp + 4);
#pragma unroll
                        for (int j = 0; j < 4; ++j) { float z = v0[j] + b0[j]; v0[j] = (fminf(z, 0.f) - __logf(1.0f + __expf(-fabsf(z)))) * (1.0f / 16.0f);
                                                      z = v1[j] + b1[j]; v1[j] = (fminf(z, 0.f) - __logf(1.0f + __expf(-fabsf(z)))) * (1.0f / 16.0f); }
                        float* gp = GG + row * 256 + col; *(f32x4*)gp = v0; *(f32x4*)(gp + 4) = v1;
                    } else {
                        if (u.pn == 3) {
#pragma unroll
                            for (int j = 0; j < 4; ++j) { v0[j] = v0[j] * __builtin_amdgcn_rcpf(1.0f + __expf(-v0[j])); v1[j] = v1[j] * __builtin_amdgcn_rcpf(1.0f + __expf(-v1[j])); } }
                        u32x4 w; w.x = cvt_pk_bf16(v0[0], v0[1]); w.y = cvt_pk_bf16(v0[2], v0[3]); w.z = cvt_pk_bf16(v1[0], v1[1]); w.w = cvt_pk_bf16(v1[2], v1[3]);
                        bf16_t* dst = u.pn == 0 ? QK + row * 256 + col : (u.pn == 2 ? VV + row * 256 + col : AB + row * DM + h * 256 + col);
                        *(u32x4*)dst = w; } } }
    }
};
struct EpiDilQK {
    bf16_t* O; const float* part; int r;
    __device__ __forceinline__ void operator()(const f32x4 (&acc)[2][2][4][2], const Unit& u, int wr, int wc, int fr, int fq) const {
        const int tok0 = dil_token0(u.pm * 256, r);
        float rs8[8];
        { f32x4 pp[8];
#pragma unroll
          for (int i = 0; i < 8; ++i) pp[i] = *(const f32x4*)(part + (size_t)(tok0 + ((i >> 2) * 128 + wr * 64 + (i & 3) * 16 + fr) * r) * 4);
#pragma unroll
          for (int i = 0; i < 8; ++i) rs8[i] = rsqrtf(((pp[i][0] + pp[i][1]) + (pp[i][2] + pp[i][3])) * (1.0f / 1024.0f) + EPS); }
#pragma unroll
        for (int ai = 0; ai < 2; ++ai)
#pragma unroll
            for (int m = 0; m < 4; ++m) { const int rl = ai * 128 + wr * 64 + m * 16 + fr; const long row = (long)u.pm * 256 + rl; const float rs = rs8[ai * 4 + m];
#pragma unroll
                for (int bj = 0; bj < 2; ++bj) { const int col = u.pn * 256 + bj * 128 + wc * 32 + 8 * fq;
                    const f32x4 v0 = acc[ai][bj][m][0] * rs, v1 = acc[ai][bj][m][1] * rs;
                    u32x4 w; w.x = cvt_pk_bf16(v0[0], v0[1]); w.y = cvt_pk_bf16(v0[2], v0[3]); w.z = cvt_pk_bf16(v1[0], v1[1]); w.w = cvt_pk_bf16(v1[2], v1[3]);
                    *(u32x4*)(O + row * 512 + col) = w; }
                asm volatile("" ::: "memory"); }
    }
};
struct EpiDilVT {
    bf16_t* O; const float* part; int r;
    __device__ __forceinline__ void operator()(const f32x4 (&acc)[2][2][4][2], const Unit& u, int wr, int wc, int fr, int fq) const {
        const int tok0 = dil_token0(u.pn * 256, r);
#pragma unroll
        for (int bj = 0; bj < 2; ++bj) { const int cl = bj * 128 + wc * 32 + 8 * fq; float rs[8];
#pragma unroll
            for (int j = 0; j < 8; ++j) rs[j] = rstd_of(part, tok0 + (cl + j) * r);
#pragma unroll
            for (int ai = 0; ai < 2; ++ai)
#pragma unroll
                for (int m = 0; m < 4; ++m) { const int row = ai * 128 + wr * 64 + m * 16 + fr;
                    const f32x4 v0 = acc[ai][bj][m][0], v1 = acc[ai][bj][m][1];
                    u32x4 w; w.x = cvt_pk_bf16(v0[0] * rs[0], v0[1] * rs[1]); w.y = cvt_pk_bf16(v0[2] * rs[2], v0[3] * rs[3]);
                    w.z = cvt_pk_bf16(v1[0] * rs[4], v1[1] * rs[5]); w.w = cvt_pk_bf16(v1[2] * rs[6], v1[3] * rs[7]);
                    *(u32x4*)(O + (long)row * T + u.pn * 256 + cl) = w;
                    asm volatile("" ::: "memory"); } }
    }
};
struct EpiScores {
    bf16_t* P; const float* part; LAS f32x2* xt;
    __device__ __forceinline__ void operator()(const f32x4 (&acc)[2][2][4][2], const Unit& u, int wr, int wc, int fr, int fq) const {
        float rs8[8]; rstd8(part, u.pm * 256 + wr * 64 + fr, rs8);
#pragma unroll
        for (int ai = 0; ai < 2; ++ai)
#pragma unroll
            for (int m = 0; m < 4; ++m) { const int rl = ai * 128 + wr * 64 + m * 16 + fr; const float r_ = rs8[ai * 4 + m];
                float mx = -3.0e38f;
#pragma unroll
                for (int bj = 0; bj < 2; ++bj)
#pragma unroll
                    for (int n = 0; n < 2; ++n)
#pragma unroll
                        for (int j = 0; j < 4; ++j) mx = fmaxf(mx, acc[ai][bj][m][n][j] * r_);
                mx = fmaxf(mx, __shfl_xor(mx, 16)); mx = fmaxf(mx, __shfl_xor(mx, 32));
                float l = 0.f;
#pragma unroll
                for (int bj = 0; bj < 2; ++bj)
#pragma unroll
                    for (int n = 0; n < 2; ++n)
#pragma unroll
                        for (int j = 0; j < 4; ++j) l += __expf(acc[ai][bj][m][n][j] * r_ - mx);
                l += __shfl_xor(l, 16); l += __shfl_xor(l, 32);
                if (fq == 0) xt[rl * 4 + wc] = (f32x2){mx, l};
                asm volatile("" ::: "memory"); }
        LBAR();
#pragma unroll
        for (int ai = 0; ai < 2; ++ai)
#pragma unroll
            for (int m = 0; m < 4; ++m) { const int rl = ai * 128 + wr * 64 + m * 16 + fr; const long row = (long)u.pm * 256 + rl; const float r_ = rs8[ai * 4 + m];
                const f32x2 a = xt[rl * 4 + 0], b = xt[rl * 4 + 1], c = xt[rl * 4 + 2], d = xt[rl * 4 + 3];
                const float M = fmaxf(fmaxf(a.x, b.x), fmaxf(c.x, d.x));
                const float Ls = a.y * __expf(a.x - M) + b.y * __expf(b.x - M) + c.y * __expf(c.x - M) + d.y * __expf(d.x - M);
                const float inv = __builtin_amdgcn_rcpf(Ls);
#pragma unroll
                for (int bj = 0; bj < 2; ++bj) { const int col = u.pn * 256 + bj * 128 + wc * 32 + 8 * fq; float p[8];
#pragma unroll
                    for (int n = 0; n < 2; ++n)
#pragma unroll
                        for (int j = 0; j < 4; ++j) p[n * 4 + j] = __expf(acc[ai][bj][m][n][j] * r_ - M) * inv;
                    u32x4 w; w.x = cvt_pk_bf16(p[0], p[1]); w.y = cvt_pk_bf16(p[2], p[3]); w.z = cvt_pk_bf16(p[4], p[5]); w.w = cvt_pk_bf16(p[6], p[7]);
                    *(u32x4*)(P + row * DM + col) = w; }
                asm volatile("" ::: "memory"); }
    }
};


struct EpiAny {
    int kind;
    long o_off;
    int ldc, bstride; float scale; int h, r;
    __device__ __forceinline__ void operator()(const f32x4 (&acc)[2][2][4][2], const Unit& u, int wr, int wc, int fr, int fq, const Params& p, LAS unsigned char* lds) const {
        unsigned char* ws = p.ws; unsigned char* st = ws + OFF_STAGE; const float* part = (const float*)(ws + OFF_PART);
        if (EN(22) && kind == 0) { EpiPlain e{(bf16_t*)(ws + o_off), ldc, bstride}; e(acc, u, wr, wc, fr, fq); }
        else if (EN(23) && kind == 1) { EpiSwiGLU e{(bf16_t*)(ws + o_off), part}; e(acc, u, wr, wc, fr, fq); }
        else if (EN(24) && kind == 2) { EpiResid e{p.X, (bf16_t*)(ws + OFF_XB), (float*)(ws + OFF_PART), scale, (LAS float*)(lds + LDS_X)}; e(acc, u, wr, wc, fr, fq); }
        else if (EN(25) && kind == 3) { EpiGlaProj e{(bf16_t*)(st + ST_QK), (float*)(st + ST_GG), (bf16_t*)(st + ST_VV), (bf16_t*)(st + ST_ABUF), part, p.in[11], p.in[13], h}; e(acc, u, wr, wc, fr, fq); }
        else if (EN(26) && kind == 4) { EpiDilQK e{(bf16_t*)(ws + o_off), part, r}; e(acc, u, wr, wc, fr, fq); }
        else if (EN(27) && kind == 5) { EpiDilVT e{(bf16_t*)(ws + o_off), part, r}; e(acc, u, wr, wc, fr, fq); }
        else if (EN(28)) { EpiScores e{(bf16_t*)(ws + o_off), part, (LAS f32x2*)(lds + LDS_X)}; e(acc, u, wr, wc, fr, fq); }
    }
};

template <class Epi>
__device__ __forceinline__ void gemm_phase(LAS unsigned char* lds, const int K, const int lda, const int ldb, const Sched& S, const Epi& E) {
    int tid = threadIdx.x; asm volatile("" : "+v"(tid));
    const int wid = __builtin_amdgcn_readfirstlane(tid >> 6), lane = tid & 63, wr = wid >> 2, wc = wid & 3, fr = lane & 15, fq = lane >> 4;
    const int nt = K / BK;
    unsigned voffA[2], voffB[2];
#pragma unroll
    for (int i = 0; i < 2; ++i) { int R, C; stage_rc(tid * 16 + i * 8192, R, C); const int Rb = (R & ~31) + perm32(R & 31);
        voffA[i] = (unsigned)(R * lda + C) * 2u; voffB[i] = (unsigned)(Rb * ldb + C) * 2u; }
    const size_t kstep = (size_t)(BK * 2);
    const size_t hstepA = (size_t)HALF * lda * 2, hstepB = (size_t)HALF * ldb * 2;
    const unsigned ldsw = (unsigned)wid * 1024u;
    const int aoff = lds_byte(wr * 64 + fr, fq * 8), boff = lds_byte(wc * 32 + fr, fq * 8);
#define PG8_SA(b, h) (((b) * 2 + (h)) * HTB)
#define PG8_SB(b, h) ((4 + (b) * 2 + (h)) * HTB)
#define PG8_STAGE(bufoff, gbase, voff) do { _Pragma("unroll") for (int _i = 0; _i < 2; ++_i) \
        __builtin_amdgcn_global_load_lds((const unsigned*)((const char*)(gbase) + (voff)[_i]), (LAS unsigned*)(lds + (bufoff) + ldsw + _i * 8192), 16, 0, 0); } while (0)
#define PG8_LDA(dst, b, h) do { _Pragma("unroll") for (int m = 0; m < 4; ++m) _Pragma("unroll") for (int k = 0; k < 2; ++k) dst[m][k] = *(const LAS bf16x8*)(lds + PG8_SA(b, h) + aoff + m * 2048 + k * 1024); } while (0)
#define PG8_LDB(dst, b, h) do { _Pragma("unroll") for (int n = 0; n < 2; ++n) _Pragma("unroll") for (int k = 0; k < 2; ++k) dst[n][k] = *(const LAS bf16x8*)(lds + PG8_SB(b, h) + boff + n * 2048 + k * 1024); } while (0)
#define PG8_MMA(ai, bj, At, Bt) do { __builtin_amdgcn_s_setprio(1); _Pragma("unroll") for (int m = 0; m < 4; ++m) _Pragma("unroll") for (int n = 0; n < 2; ++n) _Pragma("unroll") for (int k = 0; k < 2; ++k) \
        acc[ai][bj][m][n] = __builtin_amdgcn_mfma_f32_16x16x32_bf16(Bt[n][k], At[m][k], acc[ai][bj][m][n], 0, 0, 0); __builtin_amdgcn_s_setprio(0); } while (0)
#define PG8_WAIT_V(n) asm volatile("s_waitcnt vmcnt(" #n ")" ::: "memory")
#define PG8_WAIT_L(n) asm volatile("s_waitcnt lgkmcnt(" #n ")" ::: "memory")
#define PG8_BAR __builtin_amdgcn_s_barrier()
#define PG8_SCHED __builtin_amdgcn_sched_barrier(0)
    Unit cur, nxt; int ui = 0;
    if (!S.next(0, cur)) return;
    f32x4 acc[2][2][4][2];
#pragma unroll
    for (int a = 0; a < 2; ++a)
#pragma unroll
        for (int b = 0; b < 2; ++b)
#pragma unroll
            for (int m = 0; m < 4; ++m)
#pragma unroll
                for (int n = 0; n < 2; ++n) acc[a][b][m][n] = (f32x4){0.f, 0.f, 0.f, 0.f};
    bf16x8 At[4][2], B0[2][2], B1[2][2];
    const char* cA = cur.a; const char* cB = cur.bt;
    PG8_STAGE(PG8_SB(0, 0), cB, voffB); PG8_STAGE(PG8_SA(0, 0), cA, voffA); PG8_STAGE(PG8_SB(0, 1), cB + hstepB, voffB); PG8_STAGE(PG8_SA(0, 1), cA + hstepA, voffA);
    if (wr == 1) PG8_BAR;
    PG8_WAIT_V(4); PG8_BAR;
    PG8_STAGE(PG8_SB(1, 0), cB + kstep, voffB); PG8_STAGE(PG8_SA(1, 0), cA + kstep, voffA); PG8_STAGE(PG8_SB(1, 1), cB + hstepB + kstep, voffB);
    PG8_WAIT_V(6); PG8_BAR;
    for (;;) {
        const bool has_next = S.next(ui + 1, nxt);
        const char* nA = has_next ? nxt.a : cA; const char* nB = has_next ? nxt.bt : cB;
        for (int t = 0; t < nt; t += 2) {
            const bool last = (t == nt - 2);
            const char* a1 = cA + (size_t)(t + 1) * kstep;
            const char* a2 = last ? nA : cA + (size_t)(t + 2) * kstep; const char* b2 = last ? nB : cB + (size_t)(t + 2) * kstep;
            const char* a3 = a2 + kstep; const char* b3 = b2 + kstep;
            PG8_LDB(B0, 0, 0); PG8_SCHED; PG8_LDA(At, 0, 0); PG8_STAGE(PG8_SA(1, 1), a1 + hstepA, voffA);
            PG8_WAIT_L(8); PG8_BAR; PG8_WAIT_L(0); PG8_MMA(0, 0, At, B0); PG8_BAR; PG8_SCHED;
            PG8_LDB(B1, 0, 1); PG8_STAGE(PG8_SB(0, 0), b2, voffB);
            PG8_BAR; PG8_WAIT_L(0); PG8_MMA(0, 1, At, B1); PG8_BAR;
            PG8_LDA(At, 0, 1); PG8_STAGE(PG8_SA(0, 0), a2, voffA);
            PG8_BAR; PG8_WAIT_L(0); PG8_MMA(1, 0, At, B0); PG8_BAR; PG8_SCHED;
            PG8_STAGE(PG8_SB(0, 1), b2 + hstepB, voffB);
            PG8_WAIT_V(6); PG8_BAR; PG8_MMA(1, 1, At, B1); PG8_BAR;
            PG8_LDB(B0, 1, 0); PG8_SCHED; PG8_LDA(At, 1, 0); PG8_STAGE(PG8_SA(0, 1), a2 + hstepA, voffA);
            PG8_WAIT_L(8); PG8_BAR; PG8_WAIT_L(0); PG8_MMA(0, 0, At, B0); PG8_BAR; PG8_SCHED;
            PG8_LDB(B1, 1, 1); PG8_STAGE(PG8_SB(1, 0), b3, voffB);
            PG8_BAR; PG8_WAIT_L(0); PG8_MMA(0, 1, At, B1); PG8_BAR;
            PG8_LDA(At, 1, 1); PG8_STAGE(PG8_SA(1, 0), a3, voffA);
            PG8_BAR; PG8_WAIT_L(0); PG8_MMA(1, 0, At, B0); PG8_BAR; PG8_SCHED;
            PG8_STAGE(PG8_SB(1, 1), b3 + hstepB, voffB);
            PG8_WAIT_V(6); PG8_BAR; PG8_MMA(1, 1, At, B1); PG8_BAR;
        }
        { int t2 = threadIdx.x; asm volatile("" : "+v"(t2)); const int w2 = __builtin_amdgcn_readfirstlane(t2 >> 6), l2 = t2 & 63;
          E(acc, cur, w2 >> 2, w2 & 3, l2 & 15, l2 >> 4); }
        if (!has_next) break;
#pragma unroll
        for (int a = 0; a < 2; ++a)
#pragma unroll
            for (int b = 0; b < 2; ++b)
#pragma unroll
                for (int m = 0; m < 4; ++m)
#pragma unroll
                    for (int n = 0; n < 2; ++n) acc[a][b][m][n] = (f32x4){0.f, 0.f, 0.f, 0.f};
        cur = nxt; cA = nA; cB = nB; ++ui;
    }
    PG8_WAIT_V(0);
    if (wr == 0) PG8_BAR;
    PG8_BAR;
#undef PG8_SA
#undef PG8_SB
#undef PG8_STAGE
#undef PG8_LDA
#undef PG8_LDB
#undef PG8_MMA
#undef PG8_WAIT_V
#undef PG8_WAIT_L
#undef PG8_BAR
#undef PG8_SCHED
}

__device__ __forceinline__ Sched mk_sched(const void* A, const void* Bt, int M, int N, int lda, int ldb, int rot) {
    Sched s; s.A = (const char*)A; s.Bt = (const char*)Bt; s.a_tile = 256 * lda * 2; s.b_tile = 256 * ldb * 2; s.a_batch = 0; s.b_batch = 0; s.seqB = 0;
    s.nM = M / 256; s.nN = N / 256; s.nB = 1; s.G = gridDim.x; s.c = (int)((blockIdx.x + (unsigned)rot) % gridDim.x); s.mode = 0; s.r = 1; return s;
}


struct GemmJob { int K, lda, ldb; Sched s; EpiAny e; };
__device__ __forceinline__ int rotc(int rot) { return (int)((blockIdx.x + gridDim.x - ((unsigned)rot % gridDim.x)) % gridDim.x); }
__device__ __forceinline__ bool get_job(const Params& p, int op, int arg, int j, GemmJob& J) {
    unsigned char* ws = p.ws; bf16_t* WB = (bf16_t*)ws; bf16_t* XB = (bf16_t*)(ws + OFF_XB); unsigned char* st = ws + OFF_STAGE;
    EpiAny e; e.kind = 0; e.o_off = 0; e.ldc = DM; e.bstride = 0; e.scale = 1.0f; e.h = 0; e.r = 1;
    J.K = DM; J.lda = DM; J.ldb = DM;
    if (op == 1) {
        if (j == 0) { J.s = mk_sched(st + ST_MEMN, WB + E_CKV, 768, 2048, DM, DM, 0); e.o_off = OFF_STAGE + ST_KV; e.ldc = 2048; }
        else if (j == 1) { J.s = mk_sched(XB, WB + E_FFN1_IN, T, 2 * DFF, DM, DM, 0); J.s.c = rotc(24); e.kind = 1; e.o_off = OFF_STAGE + ST_HID; }
        else return false;
    } else if (op == 2) {
        if (j == 0) { J.s = mk_sched(st + ST_HID, WB + E_FFN1_OUT, T, DM, DFF, DFF, 0); J.K = DFF; J.lda = DFF; J.ldb = DFF; e.kind = 2; e.scale = 0.5f; }
        else if (j <= 3) { const int sq = j - 1;
            J.s = mk_sched((const char*)(st + ST_KV) + (size_t)sq * 256 * 2048 * 2, WB + E_CQ, 256, 1024, 2048, DM, 0); J.s.nB = 4; J.s.a_batch = 512; J.s.b_batch = 512; J.s.c = rotc(sq * 16);
            J.K = 256; J.lda = 2048; J.ldb = DM; e.o_off = (E_GT + (size_t)sq * DM * DM) * 2; e.ldc = DM; e.bstride = 256 * DM; }
        else if (j <= 6) { const int sq = j - 4;
            J.s = mk_sched(WB + E_CO, (const char*)(st + ST_KV) + (size_t)sq * 256 * 2048 * 2 + 1024 * 2, 1024, 256, DM, 2048, 0); J.s.nB = 4; J.s.a_batch = 512; J.s.b_batch = 512; J.s.c = rotc(48 + sq * 16);
            J.K = 256; J.lda = DM; J.ldb = 2048; e.o_off = (E_HM + (size_t)sq * DM * DM) * 2; e.ldc = DM; e.bstride = 256; }
        else return false;
    } else if (op == 3) { if (j) return false; J.s = mk_sched(st + ST_ABUF, WB + E_MIX_OUT, T, DM, DM, DM, 0); e.kind = 2; }
    else if (op == 4) { if (j) return false; J.s = mk_sched(XB, WB + E_GT, T, DM, DM, DM, 0); J.s.mode = 1; J.s.seqB = DM * DM * 2; e.kind = 6; e.o_off = OFF_STAGE + ST_ABUF; }
    else if (op == 5) { if (j) return false; J.s = mk_sched(st + ST_ABUF, WB + E_HM, T, DM, DM, DM, 0); J.s.mode = 1; J.s.seqB = DM * DM * 2; e.kind = 2; }
    else if (op == 6) { if (j) return false; J.s = mk_sched(XB, WB + E_FFN2_IN, T, 2 * DFF, DM, DM, 0); e.kind = 1; e.o_off = OFF_STAGE + ST_HID; }
    else if (op == 7) { if (j) return false; J.s = mk_sched(st + ST_HID, WB + E_FFN2_OUT, T, DM, DFF, DFF, 0); J.K = DFF; J.lda = DFF; J.ldb = DFF; e.kind = 2; e.scale = 0.5f; }
    else if (op == 10) { if (j) return false; J.s = mk_sched(XB, WB + E_MIX_IN + (size_t)arg * 1024 * DM, T, 1024, DM, DM, 0); e.kind = 3; e.h = arg; }
    else if (op == 20) { if (j >= 6) return false; const int g = j >> 1, r = g == 0 ? 1 : (g == 1 ? 4 : 16); e.r = r;
        if ((j & 1) == 0) { J.s = mk_sched(XB, WB + E_MIX_IN + (size_t)(arg * 2304 + g * 512) * DM, T, 512, r * DM, DM, 0); J.s.mode = 2; J.s.r = r; J.s.c = rotc(g * 384);
            J.lda = r * DM; e.kind = 4; e.o_off = OFF_STAGE + ST_QKG + (size_t)g * T * 512 * 2; }
        else { J.s = mk_sched(WB + E_MIX_IN + (size_t)(arg * 2304 + 1536 + g * 256) * DM, XB, 256, T, DM, r * DM, 0); J.s.mode = 3; J.s.r = r; J.s.c = rotc(g * 384 + 256);
            J.ldb = r * DM; e.kind = 5; e.o_off = OFF_STAGE + ST_VTG + (size_t)g * 256 * T * 2; } }
    else return false;
    J.e = e; return true;
}

template <int NT>
__device__ __forceinline__ void conv_tiles(const float* src, int ld_src, const int (&k0)[NT], const int (&n0)[NT], bf16_t* dst, int ld_dst, const int (&dr0)[NT], const float* gain,
                                           const float (&scale)[NT], int nvalid, LAS float* tile) {
    int tid = threadIdx.x; asm volatile("" : "+v"(tid)); const int tx = tid & 63, ty = tid >> 6;
    float v[NT][8];
#pragma unroll
    for (int t = 0; t < NT; ++t) if (t < nvalid) {
#pragma unroll
        for (int i = 0; i < 8; ++i) v[t][i] = src[(size_t)(k0[t] + ty + 8 * i) * ld_src + n0[t] + tx];
    }
#pragma unroll
    for (int t = 0; t < NT; ++t) if (t < nvalid) {
#pragma unroll
        for (int i = 0; i < 8; ++i) { float x = v[t][i] * scale[t]; if (gain) x *= gain[k0[t] + ty + 8 * i]; tile[t * 4160 + (ty + 8 * i) * 65 + tx] = x; }
    }
    __syncthreads();
    const int i2 = tid & 31;
#pragma unroll
    for (int t = 0; t < NT; ++t) if (t < nvalid) {
#pragma unroll
        for (int jj = 0; jj < 4; ++jj) { const int j = (tid >> 5) + 16 * jj; const float a = tile[t * 4160 + (2 * i2) * 65 + j], b = tile[t * 4160 + (2 * i2 + 1) * 65 + j];
            *(unsigned*)(dst + (size_t)(dr0[t] + j) * ld_dst + k0[t] + 2 * i2) = cvt_pk_bf16(a, b); }
    }
    __syncthreads();
}
__device__ __forceinline__ int map_row(int kind, int n0, float& scale) {
    scale = 1.0f;
    if (EN(23) && kind == 1) { if (n0 < DFF) return (n0 / 128) * 256 + (n0 % 128); const int j = n0 - DFF; return (j / 128) * 256 + 128 + (j % 128); }
    if (EN(24) && kind == 2) {
        if (n0 < 512) { scale = 0.08838834764831845f; return (n0 / 128) * 1024 + (n0 % 128); }
        if (n0 < 1024) { const int j = n0 - 512; return (j / 128) * 1024 + 128 + (j % 128); }
        if (n0 < 2048) { const int j = n0 - 1024; return (j / 256) * 1024 + 512 + (j % 256); }
        const int j = n0 - 2048; return (j / 256) * 1024 + 768 + (j % 256);
    }
    if (EN(25) && kind == 3) { const int tg = n0 / 1024, h = (n0 % 1024) / 64, t = tg / 3, g = tg % 3, hc = h >> 2, hl = h & 3;
        if (t == 0) scale = 0.125f;
        if (t < 2) return hc * 2304 + g * 512 + t * 256 + hl * 64;
        return hc * 2304 + 1536 + g * 256 + hl * 64; }
    return n0;
}
__device__ __forceinline__ void conv_weight(const float* src, int K, int N, int ld_src, bf16_t* dst, const float* gain, int kind, LAS float* tile, int& rot) {
    constexpr int NT = 4;
    const int nk = K / 64, nn = N / 64, tot = nk * nn, G = gridDim.x;
    for (int t0 = (int)((blockIdx.x + G - (rot % G)) % G); t0 < tot; t0 += G * NT) {
        int k0[NT], n0[NT], dr0[NT]; float sc[NT]; int nvalid = 0;
#pragma unroll
        for (int j = 0; j < NT; ++j) { const int t = t0 + j * G; const bool ok = t < tot; const int tt = ok ? t : t0; const int kt = tt % nk, ntile = tt / nk;
            k0[j] = kt * 64; n0[j] = ntile * 64; dr0[j] = map_row(kind, ntile * 64, sc[j]); nvalid += ok ? 1 : 0; }
        conv_tiles<NT>(src, ld_src, k0, n0, dst, K, dr0, gain, sc, nvalid, tile);
    }
    rot += tot;
}
__device__ __forceinline__ const float* x_in_row(const Params& p, int t) { return t < 16384 ? p.in[0] + (size_t)t * DM : p.in[1] + (size_t)(t - 16384) * DM; }

__device__ __forceinline__ void phase_prologue(const Params& p, int layer, LAS unsigned char* lds) {
    unsigned char* ws = p.ws; bf16_t* WB = (bf16_t*)ws; LAS float* tile = (LAS float*)lds;
    int tid = threadIdx.x; asm volatile("" : "+v"(tid)); const int lane = tid & 63, wid = tid >> 6, nwv = gridDim.x * 8, gw = blockIdx.x * 8 + wid;
    int rot = 0;
    conv_weight(p.in[6] + (size_t)layer * DM * 2 * DFF, DM, 2 * DFF, 2 * DFF, WB + E_FFN1_IN, p.in[5] + layer * DM, 1, tile, rot);
    conv_weight(p.in[7] + (size_t)layer * DFF * DM, DFF, DM, DM, WB + E_FFN1_OUT, nullptr, 0, tile, rot);
    conv_weight(p.in[24] + (size_t)layer * DM * 2 * DFF, DM, 2 * DFF, 2 * DFF, WB + E_FFN2_IN, p.in[23] + layer * DM, 1, tile, rot);
    conv_weight(p.in[25] + (size_t)layer * DFF * DM, DFF, DM, DM, WB + E_FFN2_OUT, nullptr, 0, tile, rot);
    conv_weight(p.in[21] + (size_t)layer * DM * 2048, DM, 2048, 2048, WB + E_CKV, nullptr, 0, tile, rot);
    conv_weight(p.in[22] + (size_t)layer * DM * DM, DM, DM, DM, WB + E_CO, nullptr, 0, tile, rot);
    if (layer == 0) {
        conv_weight(p.in[9], DM, 3072, 3104, WB + E_MIX_IN, p.in[8], 2, tile, rot);
        conv_weight(p.in[15], DM, DM, DM, WB + E_MIX_OUT, nullptr, 0, tile, rot);
        for (size_t idx = (size_t)blockIdx.x * 512 + tid; idx < (size_t)2 * 512 * 1024; idx += (size_t)gridDim.x * 512) {
            const int c = (int)(idx & 1023), n = (int)((idx >> 10) & 511), dir = (int)(idx >> 19);
            const float* wi = p.in[9] + (size_t)c * 3104 + 3072 + dir * 16; const float* wg = (dir ? p.in[12] : p.in[10]) + n;
            float s = 0.f;
#pragma unroll
            for (int r = 0; r < 16; ++r) s += wi[r] * wg[r * 512];
            s *= p.in[8][c];
            WB[E_MIX_IN + (size_t)((n >> 7) * 1024 + 256 + dir * 128 + (n & 127)) * DM + c] = f2bf(s);
        }
    } else {
        conv_weight(p.in[16], DM, 9216, 9216, WB + E_MIX_IN, p.in[8] + DM, 3, tile, rot);
        conv_weight(p.in[17], DM, DM, DM, WB + E_MIX_OUT, nullptr, 0, tile, rot);
    }
    { const float* src = p.in[20] + (size_t)layer * DM * DM; const float* g = p.in[18] + layer * DM;
      for (size_t idx = ((size_t)blockIdx.x * 512 + tid) * 4; idx < (size_t)DM * DM; idx += (size_t)gridDim.x * 512 * 4) {
          const f32x4 v = *(const f32x4*)(src + idx); const float s = g[idx >> 10] * 0.0625f;
          u32x2 w; w.x = cvt_pk_bf16(v[0] * s, v[1] * s); w.y = cvt_pk_bf16(v[2] * s, v[3] * s);
          *(u32x2*)(WB + E_CQ + idx) = w; } }
    { bf16_t* MEMN = (bf16_t*)(ws + OFF_STAGE + ST_MEMN); const float* g = p.in[19] + layer * DM;
      for (int row = gw; row < 768; row += nwv) {
          const float* src = row < 512 ? p.in[2] + (size_t)row * DM : p.in[3] + (size_t)(row - 512) * DM;
          f32x4 v[4]; float ss = 0.f;
#pragma unroll
          for (int i = 0; i < 4; ++i) { v[i] = *(const f32x4*)(src + i * 256 + lane * 4); ss += (v[i][0] * v[i][0] + v[i][1] * v[i][1]) + (v[i][2] * v[i][2] + v[i][3] * v[i][3]); }
#pragma unroll
          for (int o = 1; o < 64; o <<= 1) ss += __shfl_xor(ss, o);
          const float rs = rsqrtf(ss * (1.0f / 1024.0f) + EPS);
#pragma unroll
          for (int i = 0; i < 4; ++i) { const f32x4 gg = *(const f32x4*)(g + i * 256 + lane * 4);
              u32x2 w; w.x = cvt_pk_bf16(v[i][0] * rs * gg[0], v[i][1] * rs * gg[1]); w.y = cvt_pk_bf16(v[i][2] * rs * gg[2], v[i][3] * rs * gg[3]);
              *(u32x2*)(MEMN + (size_t)row * DM + i * 256 + lane * 4) = w; } } }
    if (layer == 0) {
        bf16_t* XB = (bf16_t*)(ws + OFF_XB); float* part = (float*)(ws + OFF_PARTV);
        for (int row = gw; row < T; row += nwv) {
            const float* src = x_in_row(p, row); f32x4 v[4]; float ss = 0.f;
#pragma unroll
            for (int i = 0; i < 4; ++i) { v[i] = *(const f32x4*)(src + i * 256 + lane * 4); ss += (v[i][0] * v[i][0] + v[i][1] * v[i][1]) + (v[i][2] * v[i][2] + v[i][3] * v[i][3]); }
#pragma unroll
            for (int o = 1; o < 64; o <<= 1) ss += __shfl_xor(ss, o);
#pragma unroll
            for (int i = 0; i < 4; ++i) { *(f32x4*)(p.X + (size_t)row * DM + i * 256 + lane * 4) = v[i];
                u32x2 w; w.x = cvt_pk_bf16(v[i][0], v[i][1]); w.y = cvt_pk_bf16(v[i][2], v[i][3]);
                *(u32x2*)(XB + (size_t)row * DM + i * 256 + lane * 4) = w; }
            if (lane == 0) *(f32x4*)(part + (size_t)row * 4) = (f32x4){ss, 0.f, 0.f, 0.f};
        }
        float* bt = (float*)(ws + OFF_BTAB);
        for (int idx = blockIdx.x * 512 + tid; idx < 3 * 16 * 129; idx += gridDim.x * 512) {
            const int rel = idx % 129 - 64, h = (idx / 129) % 16, g = idx / (129 * 16); const int r = g == 0 ? 1 : (g == 1 ? 4 : 16);
            const int rr = rel * r, n = rr < 0 ? -rr : rr; int bk;
            if (n < 8) bk = n; else bk = 8 + (n >= 15) + (n >= 27) + (n >= 50) + (n >= 91) + (n >= 166) + (n >= 305) + (n >= 559);
            if (rr > 0) bk += 16;
            bt[idx] = p.in[4][bk * 48 + g * 16 + h];
        }
    }
}

__device__ __forceinline__ void phase_final(const Params& p) {
    const float* part = (const float*)(p.ws + OFF_PARTV + 8 * PARTV_BYTES); const float* g = p.in[26];
    int tid = threadIdx.x; asm volatile("" : "+v"(tid)); const int lane = tid & 63, wid = tid >> 6, nwv = gridDim.x * 8, gw = blockIdx.x * 8 + wid;
    for (int row = gw; row < T; row += nwv) { const float rs = rstd_of(part, row);
#pragma unroll
        for (int i = 0; i < 4; ++i) { float* xp = p.X + (size_t)row * DM + i * 256 + lane * 4; const f32x4 v = ld_sys16f(xp); const f32x4 gg = *(const f32x4*)(g + i * 256 + lane * 4);
            *(f32x4*)xp = (f32x4){v[0] * rs * gg[0], v[1] * rs * gg[1], v[2] * rs * gg[2], v[3] * rs * gg[3]}; } }
}

__device__ __forceinline__ void gla_combine(const Params& p, int h) {
    unsigned char* st = p.ws + OFF_STAGE; const float* OF = (const float*)(st + ST_OF); const float* OB = (const float*)(st + ST_OB); bf16_t* AB = (bf16_t*)(st + ST_ABUF);
    const float* gn = p.in[14] + h * 256;
    int tid = threadIdx.x; asm volatile("" : "+v"(tid)); const int lane = tid & 63, wid = tid >> 6, nwv = gridDim.x * 8, gw = blockIdx.x * 8 + wid;
    const f32x4 gg = *(const f32x4*)(gn + lane * 4);
    for (int row = gw; row < T; row += nwv) {
        const f32x4 a = ld_sys16f(OF + (size_t)row * 256 + lane * 4), b = ld_sys16f(OB + (size_t)row * 256 + lane * 4);
        const f32x4 o = a + b; float ss = (o[0] * o[0] + o[1] * o[1]) + (o[2] * o[2] + o[3] * o[3]);
#pragma unroll
        for (int s = 1; s < 64; s <<= 1) ss += __shfl_xor(ss, s);
        const float rs = rsqrtf(ss * (1.0f / 256.0f) + EPS);
        bf16_t* ap = AB + (size_t)row * DM + h * 256 + lane * 4; const u32x2 rr = ld_sys8(ap);
        const float r0 = __uint_as_float(rr.x << 16), r1 = __uint_as_float(rr.x & 0xffff0000u), r2 = __uint_as_float(rr.y << 16), r3 = __uint_as_float(rr.y & 0xffff0000u);
        u32x2 w; w.x = cvt_pk_bf16(o[0] * rs * gg[0] * r0, o[1] * rs * gg[1] * r1); w.y = cvt_pk_bf16(o[2] * rs * gg[2] * r2, o[3] * rs * gg[3] * r3);
        *(u32x2*)ap = w;
    }
}

constexpr int SC_QP = 0, SC_KP = 17408, SC_KT = 34816, SC_VT = 53248, SC_ATT = 62464, SC_SS = 71680, SC_QS = 89088, SC_BL = 91136;

template <bool OUT>
__device__ __forceinline__ void gla_scan(const Params& p, LAS unsigned char* lds) {
    unsigned char* st = p.ws + OFF_STAGE;
    const bf16_t* QK = (const bf16_t*)(st + ST_QK); const float* GG = (const float*)(st + ST_GG); const bf16_t* VV = (const bf16_t*)(st + ST_VV);
    float* SLOC = (float*)(st + ST_SLOC); float* DVEC = (float*)(st + ST_DVEC);
    int tid = threadIdx.x; asm volatile("" : "+v"(tid)); const int lane = tid & 63, w = tid >> 6, l15 = lane & 15, quad = lane >> 4;
    LAS bf16_t* QP = (LAS bf16_t*)(lds + SC_QP); LAS bf16_t* KP = (LAS bf16_t*)(lds + SC_KP); LAS bf16_t* KT = (LAS bf16_t*)(lds + SC_KT);
    LAS bf16_t* VT = (LAS bf16_t*)(lds + SC_VT); LAS bf16_t* ATT = (LAS bf16_t*)(lds + SC_ATT); LAS bf16_t* SS = (LAS bf16_t*)(lds + SC_SS);
    LAS float* QS = (LAS float*)(lds + SC_QS); LAS float* BL = (LAS float*)(lds + SC_BL);
    for (int unit = blockIdx.x; unit < 256; unit += gridDim.x) {
        const int slice = unit & 3, dir = (unit >> 2) & 1, seg = unit >> 3;
        const int sfirst = seg < 8 ? 0 : (seg < 16 ? 8 : 16), nseg = seg < 16 ? 8 : 16;
        const int sigma = dir == 0 ? seg - sfirst : sfirst + nseg - 1 - seg;
        float* oout = (float*)(st + (dir == 0 ? ST_OF : ST_OB));
        f32x4 S[4];
#pragma unroll
        for (int d = 0; d < 4; ++d) S[d] = (f32x4){0.f, 0.f, 0.f, 0.f};
        if (OUT) {
            for (int sp = 0; sp < sigma; ++sp) {
                const int sg = dir == 0 ? sfirst + sp : sfirst + nseg - 1 - sp;
                const float* sl = SLOC + (size_t)(sg * 2 + dir) * 128 * 256; const float* dv = DVEC + (size_t)(sg * 2 + dir) * 128;
#pragma unroll
                for (int r = 0; r < 4; ++r) { const int dk = 16 * w + 4 * quad + r; const float dd = ldsys_f(dv + dk);
#pragma unroll
                    for (int d = 0; d < 4; ++d) S[d][r] = S[d][r] * dd + ldsys_f(sl + (size_t)dk * 256 + slice * 64 + d * 16 + l15); }
            }
        }
        float dsum = 0.f;
        const int dkc = tid & 127, qr = tid >> 7;
        const int dvc = tid & 63, jr = tid >> 6;
        for (int ch = 0; ch < 16; ++ch) {
            const int tb = seg * 1024 + (dir == 0 ? ch * 64 : (15 - ch) * 64);
            float g[16]; float q[16], k[16];
#pragma unroll
            for (int ii = 0; ii < 16; ++ii) { const int ip = qr * 16 + ii; const int tok = tb + (dir == 0 ? ip : 63 - ip);
                g[ii] = ldsys_f(GG + (size_t)tok * 256 + dir * 128 + dkc);
                if (OUT) q[ii] = bf2f(ldsys_h(QK + (size_t)tok * 256 + dkc));
                k[ii] = bf2f(ldsys_h(QK + (size_t)tok * 256 + 128 + dkc)); }
            unsigned vpk[4];
            { float v[8];
#pragma unroll
              for (int jj = 0; jj < 8; ++jj) { const int jp = jr * 8 + jj; const int tok = tb + (dir == 0 ? jp : 63 - jp); v[jj] = bf2f(ldsys_h(VV + (size_t)tok * 256 + slice * 64 + dvc)); }
#pragma unroll
              for (int jj = 0; jj < 4; ++jj) vpk[jj] = cvt_pk_bf16(v[2 * jj], v[2 * jj + 1]); }
#pragma unroll
            for (int ii = 1; ii < 16; ++ii) g[ii] += g[ii - 1];
            QS[qr * 128 + dkc] = g[15];
            *(LAS u32x4*)(VT + dvc * 72 + jr * 8) = (u32x4){vpk[0], vpk[1], vpk[2], vpk[3]};
            __syncthreads();
            float off = 0.f, tot = 0.f;
#pragma unroll
            for (int qq = 0; qq < 4; ++qq) { const float s = QS[qq * 128 + dkc]; tot += s; if (qq < qr) off += s; }
            if (qr == 0) { BL[dkc] = __expf(tot); dsum += tot; }
            unsigned kt[8];
#pragma unroll
            for (int ii = 0; ii < 16; ii += 2) {
                const float b0 = off + g[ii], b1 = off + g[ii + 1];
                if (OUT) { const int ip = qr * 16 + ii;
                    QP[ip * 136 + dkc] = f2bf(q[ii] * __expf(b0)); QP[(ip + 1) * 136 + dkc] = f2bf(q[ii + 1] * __expf(b1));
                    KP[ip * 136 + dkc] = f2bf(k[ii] * __expf(-b0)); KP[(ip + 1) * 136 + dkc] = f2bf(k[ii + 1] * __expf(-b1)); }
                kt[ii >> 1] = cvt_pk_bf16(k[ii] * __expf(tot - b0), k[ii + 1] * __expf(tot - b1));
            }
            *(LAS u32x4*)(KT + dkc * 72 + qr * 16) = (u32x4){kt[0], kt[1], kt[2], kt[3]};
            *(LAS u32x4*)(KT + dkc * 72 + qr * 16 + 8) = (u32x4){kt[4], kt[5], kt[6], kt[7]};
            if (OUT) {
#pragma unroll
                for (int d = 0; d < 4; ++d) { u32x2 sw; sw.x = cvt_pk_bf16(S[d][0], S[d][1]); sw.y = cvt_pk_bf16(S[d][2], S[d][3]);
                    *(LAS u32x2*)(SS + (d * 16 + l15) * 136 + 16 * w + 4 * quad) = sw; }
            }
            __syncthreads();
            f32x4 O[2];
            if (OUT) {
                const int it = w >> 1, c0 = (w & 1) * 2;
                f32x4 at[2] = {(f32x4){0.f, 0.f, 0.f, 0.f}, (f32x4){0.f, 0.f, 0.f, 0.f}};
                O[0] = (f32x4){0.f, 0.f, 0.f, 0.f}; O[1] = (f32x4){0.f, 0.f, 0.f, 0.f};
#pragma unroll
                for (int kk = 0; kk < 4; ++kk) {
                    const bf16x8 af = *(const LAS bf16x8*)(QP + (it * 16 + l15) * 136 + kk * 32 + quad * 8);
#pragma unroll
                    for (int x = 0; x < 2; ++x) {
                        const bf16x8 kf = *(const LAS bf16x8*)(KP + ((c0 + x) * 16 + l15) * 136 + kk * 32 + quad * 8);
                        at[x] = __builtin_amdgcn_mfma_f32_16x16x32_bf16(af, kf, at[x], 0, 0, 0);
                        const bf16x8 sf = *(const LAS bf16x8*)(SS + ((c0 + x) * 16 + l15) * 136 + kk * 32 + quad * 8);
                        O[x] = __builtin_amdgcn_mfma_f32_16x16x32_bf16(af, sf, O[x], 0, 0, 0);
                    }
                }
#pragma unroll
                for (int x = 0; x < 2; ++x)
#pragma unroll
                    for (int r = 0; r < 4; ++r) { const int i = it * 16 + quad * 4 + r, j = (c0 + x) * 16 + l15;
                        ATT[i * 72 + j] = f2bf(j <= i ? at[x][r] : 0.f); }
            }
            {
#pragma unroll
                for (int r = 0; r < 4; ++r) { const float dd = BL[16 * w + 4 * quad + r];
#pragma unroll
                    for (int d = 0; d < 4; ++d) S[d][r] *= dd; }
#pragma unroll
                for (int kk = 0; kk < 2; ++kk) {
                    const bf16x8 af = *(const LAS bf16x8*)(KT + (16 * w + l15) * 72 + kk * 32 + quad * 8);
#pragma unroll
                    for (int d = 0; d < 4; ++d) { const bf16x8 vf = *(const LAS bf16x8*)(VT + (d * 16 + l15) * 72 + kk * 32 + quad * 8);
                        S[d] = __builtin_amdgcn_mfma_f32_16x16x32_bf16(af, vf, S[d], 0, 0, 0); }
                }
            }
            if (OUT) {
                __syncthreads();
                const int it = w >> 1, c0 = (w & 1) * 2;
#pragma unroll
                for (int kk = 0; kk < 2; ++kk) {
                    const bf16x8 af = *(const LAS bf16x8*)(ATT + (it * 16 + l15) * 72 + kk * 32 + quad * 8);
#pragma unroll
                    for (int x = 0; x < 2; ++x) { const bf16x8 vf = *(const LAS bf16x8*)(VT + ((c0 + x) * 16 + l15) * 72 + kk * 32 + quad * 8);
                        O[x] = __builtin_amdgcn_mfma_f32_16x16x32_bf16(af, vf, O[x], 0, 0, 0); }
                }
#pragma unroll
                for (int x = 0; x < 2; ++x)
#pragma unroll
                    for (int r = 0; r < 4; ++r) { const int ip = it * 16 + quad * 4 + r; const int tok = tb + (dir == 0 ? ip : 63 - ip);
                        oout[(size_t)tok * 256 + slice * 64 + (c0 + x) * 16 + l15] = O[x][r]; }
            }
            __syncthreads();
        }
        if (!OUT) {
            float* sl = SLOC + (size_t)(seg * 2 + dir) * 128 * 256;
#pragma unroll
            for (int r = 0; r < 4; ++r) { const int dk = 16 * w + 4 * quad + r;
#pragma unroll
                for (int d = 0; d < 4; ++d) sl[(size_t)dk * 256 + slice * 64 + d * 16 + l15] = S[d][r]; }
            if (slice == 0 && tid < 128) DVEC[(size_t)(seg * 2 + dir) * 128 + tid] = __expf(dsum);
        }
    }
}

typedef float f32x16 __attribute__((ext_vector_type(16)));
__device__ __forceinline__ void dil_attn(const Params& p, int hc, LAS unsigned char* lds) {
    unsigned char* st = p.ws + OFF_STAGE; bf16_t* AB = (bf16_t*)(st + ST_ABUF); const float* btab = (const float*)(p.ws + OFF_BTAB);
    LAS float* OST = (LAS float*)lds; LAS float* MST = (LAS float*)(lds + 139264); LAS float* LST = (LAS float*)(lds + 141312); LAS float* BTL = (LAS float*)(lds + 143360);
    int tid = threadIdx.x; asm volatile("" : "+v"(tid)); const int lane = tid & 63, w = tid >> 6, l31 = lane & 31, hh = lane >> 5;
    const int kap = (l31 & 16) | ((l31 & 4) << 1) | ((l31 & 8) >> 1) | (l31 & 3);
    for (int unit = blockIdx.x; unit < 256; unit += gridDim.x) {
        const int hl = unit & 3, tbk = unit >> 2, t0 = tbk * 512;
        const int sb = t0 < 8192 ? 0 : (t0 < 16384 ? 8192 : 16384), Sq = t0 < 16384 ? 8192 : 16384;
        const int h = hc * 4 + hl;
#pragma unroll 1
        for (int g = 0; g < 3; ++g) {
            const int r = g == 0 ? 1 : (g == 1 ? 4 : 16), L = Sq / r;
            const bf16_t* QKg = (const bf16_t*)(st + ST_QKG) + (size_t)g * T * 512; const bf16_t* VTg = (const bf16_t*)(st + ST_VTG) + (size_t)g * 256 * T;
            const float* bt = btab + (g * 16 + h) * 129;
            if (tid < 256) { const int ri = tid - 96; BTL[tid] = (ri >= 0 && ri <= 128) ? bt[ri] : 0.f; }
            __syncthreads();
#pragma unroll 1
            for (int itx = 0; itx < 2; ++itx) {
                const int item = 2 * w + itx;
                int c, l0;
                if (g == 0) { c = 0; l0 = (t0 - sb) + 32 * item; } else if (g == 1) { c = item >> 2; l0 = (t0 - sb) / 4 + 32 * (item & 3); } else { c = item; l0 = (t0 - sb) / 16; }
                const int nq0 = sb + c * L + l0, nbase = nq0 - 64;
                const int tokl = (l0 + l31) * r + c - (t0 - sb);
                bf16x8 qf[4];
#pragma unroll
                for (int ks = 0; ks < 4; ++ks) qf[ks] = ld_sys16(QKg + (unsigned)((nq0 + l31) * 512 + hl * 64 + ks * 16 + hh * 8));
                f32x16 sT[5];
                bf16x8 kf[4];
#define DIL_LOADK(kt) do { const int lkh_ = l0 - 64 + 32 * (kt) + (l31 & 16); const bool in_ = (lkh_ >= 0) && (lkh_ < L); \
                    const int nrow_ = in_ ? nbase + 32 * (kt) + kap : nq0 + l31; \
                    _Pragma("unroll") for (int ks_ = 0; ks_ < 4; ++ks_) kf[ks_] = ld_sys16(QKg + (unsigned)(nrow_ * 512 + 256 + hl * 64 + ks_ * 16 + hh * 8)); } while (0)
#pragma unroll
                for (int kt = 0; kt < 5; ++kt) {
                    DIL_LOADK(kt);
                    f32x16 a;
#pragma unroll
                    for (int j = 0; j < 16; ++j) a[j] = 0.f;
#pragma unroll
                    for (int ks = 0; ks < 4; ++ks) a = __builtin_amdgcn_mfma_f32_32x32x16_bf16(kf[ks], qf[ks], a, 0, 0, 0);
                    sT[kt] = a;
                }
                bf16x8 vf[4];
#define DIL_LOADV(kt) do { _Pragma("unroll") for (int s_ = 0; s_ < 2; ++s_) { const int lkh_ = l0 - 64 + 32 * (kt) + 16 * s_; const bool in_ = (lkh_ >= 0) && (lkh_ < L); \
                    const int ncol_ = in_ ? nbase + 32 * (kt) + 16 * s_ + 8 * hh : nq0; \
                    _Pragma("unroll") for (int dt_ = 0; dt_ < 2; ++dt_) vf[2 * s_ + dt_] = ld_sys16(VTg + (unsigned)((hl * 64 + dt_ * 32 + l31) * T + ncol_)); } } while (0)
                DIL_LOADV(0);
#pragma unroll
                for (int kt = 0; kt < 5; ++kt)
#pragma unroll
                    for (int j = 0; j < 16; ++j) { const int lkh = l0 - 64 + 32 * kt + 16 * (j >> 3); const bool inr = (lkh >= 0) && (lkh < L);
                        const int rel = -64 + 32 * kt + 16 * (j >> 3) + 8 * hh + (j & 7) - l31; const bool ok = inr && rel >= -64 && rel <= 64;
                        sT[kt][j] = ok ? sT[kt][j] + BTL[rel + 160] : -1.0e30f; }
                float mo = -1.0e30f, lo = 0.f;
                if (g > 0) { mo = MST[tokl]; lo = LST[tokl]; }
                float mx = mo;
#pragma unroll
                for (int kt = 0; kt < 5; ++kt)
#pragma unroll
                    for (int j = 0; j < 16; ++j) mx = fmaxf(mx, sT[kt][j]);
                mx = fmaxf(mx, __shfl_xor(mx, 32));
                const float alpha = __expf(mo - mx);
                float ls = 0.f;
#pragma unroll
                for (int kt = 0; kt < 5; ++kt)
#pragma unroll
                    for (int j = 0; j < 16; ++j) { const float e = __expf(sT[kt][j] - mx); sT[kt][j] = e; ls += e; }
                ls += __shfl_xor(ls, 32);
                const float ln = lo * alpha + ls;
                f32x16 O[2];
#pragma unroll
                for (int dt = 0; dt < 2; ++dt)
#pragma unroll
                    for (int j = 0; j < 16; ++j) O[dt][j] = 0.f;
                if (g > 0) {
#pragma unroll
                    for (int dt = 0; dt < 2; ++dt)
#pragma unroll
                        for (int g4 = 0; g4 < 4; ++g4) { const f32x4 o4 = *(const LAS f32x4*)(OST + tokl * 68 + dt * 32 + g4 * 8 + hh * 4);
                            O[dt][4 * g4] = o4[0] * alpha; O[dt][4 * g4 + 1] = o4[1] * alpha; O[dt][4 * g4 + 2] = o4[2] * alpha; O[dt][4 * g4 + 3] = o4[3] * alpha; } }
#pragma unroll
                for (int kt = 0; kt < 5; ++kt) {
                    if (kt > 0) DIL_LOADV(kt);
#pragma unroll
                    for (int s2 = 0; s2 < 2; ++s2) {
                        u32x4 pw; pw.x = cvt_pk_bf16(sT[kt][8 * s2], sT[kt][8 * s2 + 1]); pw.y = cvt_pk_bf16(sT[kt][8 * s2 + 2], sT[kt][8 * s2 + 3]);
                        pw.z = cvt_pk_bf16(sT[kt][8 * s2 + 4], sT[kt][8 * s2 + 5]); pw.w = cvt_pk_bf16(sT[kt][8 * s2 + 6], sT[kt][8 * s2 + 7]);
                        const bf16x8 pf = __builtin_bit_cast(bf16x8, pw);
#pragma unroll
                        for (int dt = 0; dt < 2; ++dt) O[dt] = __builtin_amdgcn_mfma_f32_32x32x16_bf16(vf[2 * s2 + dt], pf, O[dt], 0, 0, 0);
                    }
                }
#undef DIL_LOADK
#undef DIL_LOADV
                if (g < 2) {
                    if (hh == 0) { MST[tokl] = mx; LST[tokl] = ln; }
#pragma unroll
                    for (int dt = 0; dt < 2; ++dt)
#pragma unroll
                        for (int g4 = 0; g4 < 4; ++g4) *(LAS f32x4*)(OST + tokl * 68 + dt * 32 + g4 * 8 + hh * 4) = (f32x4){O[dt][4 * g4], O[dt][4 * g4 + 1], O[dt][4 * g4 + 2], O[dt][4 * g4 + 3]};
                } else {
                    const float inv = 1.0f / ln;
#pragma unroll
                    for (int dt = 0; dt < 2; ++dt)
#pragma unroll
                        for (int g4 = 0; g4 < 4; ++g4) { u32x2 ow; ow.x = cvt_pk_bf16(O[dt][4 * g4] * inv, O[dt][4 * g4 + 1] * inv); ow.y = cvt_pk_bf16(O[dt][4 * g4 + 2] * inv, O[dt][4 * g4 + 3] * inv);
                            *(u32x2*)(AB + (size_t)(t0 + tokl) * DM + h * 64 + dt * 32 + g4 * 8 + hh * 4) = ow; }
                }
            }
            __syncthreads();
        }
    }
}

#define XB_TMO      128
#define XB_XCNT(j)  (256  + 64 * (j))
#define XB_XSUB(j)  (1280 + 64 * (j))
#define XB_XGEN(j)  (2304 + 64 * (j))
#define XB_TOP      3328
#define XB_TOPGEN   3392
#define XCD_BAR_WORDS 3456
#define XB_SPIN_CAP (1u << 22)
__device__ __forceinline__ unsigned xb_ld(unsigned* p)              { return __hip_atomic_load(p, __ATOMIC_RELAXED, __HIP_MEMORY_SCOPE_AGENT); }
__device__ __forceinline__ unsigned xb_add(unsigned* p, unsigned v) { return __hip_atomic_fetch_add(p, v, __ATOMIC_RELAXED, __HIP_MEMORY_SCOPE_AGENT); }
__device__ __forceinline__ unsigned xb_xcc_id() { return (unsigned)__builtin_amdgcn_s_getreg((3 << 11) | 20) & 0xFu; }
#define XB_SPIN(cond, bar) do { unsigned _sp = 0; while (cond) { __builtin_amdgcn_s_sleep(1); \
    if ((++_sp & 255u) == 0u) { if (xb_ld(&(bar)[XB_TMO])) break; if (_sp > XB_SPIN_CAP) { atomicAdd(&(bar)[XB_TMO], 1u); break; } } } } while (0)
struct XcdBarrier { unsigned* bar; unsigned x; volatile LAS unsigned* st; };
__device__ __forceinline__ XcdBarrier xcd_barrier_post(unsigned* bar, volatile LAS unsigned* st) {
    XcdBarrier b; b.bar = bar; b.x = xb_xcc_id(); b.st = st;
    if (threadIdx.x == 0) (void)xb_add(&bar[XB_XCNT(b.x)], 1u);
    return b;
}
__device__ __forceinline__ void xcd_barrier_complete(unsigned* bar, unsigned x, unsigned& nloc, unsigned& nx) {
    const unsigned G = gridDim.x * gridDim.y * gridDim.z;
    unsigned sum, cnt, mine, sp = 0u;
    for (;;) {
        sum = 0u; cnt = 0u; mine = 0u;
#pragma unroll
        for (unsigned j = 0; j < 16; ++j) { const unsigned c = xb_ld(&bar[XB_XCNT(j)]); sum += c; cnt += (c > 0u) ? 1u : 0u; mine = (j == x) ? c : mine; }
        if (sum == G) break;
        __builtin_amdgcn_s_sleep(1);
        if ((++sp & 255u) == 0u) { if (xb_ld(&bar[XB_TMO])) break; if (sp > XB_SPIN_CAP) { atomicAdd(&bar[XB_TMO], 1u); break; } }
    }
    nloc = mine > 0u ? mine : 1u; nx = cnt > 0u ? cnt : 1u;
}
__device__ __forceinline__ void xcd_barrier(const XcdBarrier& b) {
    asm volatile("s_waitcnt vmcnt(0)" ::: "memory");
    __syncthreads();
    if (threadIdx.x == 0) {
        unsigned* bar = b.bar;
        __builtin_amdgcn_s_waitcnt(0);
        unsigned nloc = b.st[0], nx = b.st[1];
        if (nloc == 0u) { xcd_barrier_complete(bar, b.x, nloc, nx); b.st[0] = nloc; b.st[1] = nx; }
        const unsigned old = xb_add(&bar[XB_XSUB(b.x)], 1u);
        const unsigned gen = old / nloc;
        if (old + 1u == (gen + 1u) * nloc) {
            __builtin_amdgcn_fence(__ATOMIC_RELEASE, "agent");
            asm volatile("s_waitcnt vmcnt(0)" ::: "memory");
            const unsigned og = xb_add(&bar[XB_TOP], 1u);
            const unsigned tg = og / nx;
            if (og + 1u == (tg + 1u) * nx) xb_add(&bar[XB_TOPGEN], 1u);
            else XB_SPIN(xb_ld(&bar[XB_TOPGEN]) == tg, bar);
            __builtin_amdgcn_fence(__ATOMIC_ACQUIRE, "agent");
            xb_add(&bar[XB_XGEN(b.x)], 1u);
            asm volatile("s_waitcnt vmcnt(0)" ::: "memory");
        } else {
            XB_SPIN(xb_ld(&bar[XB_XGEN(b.x)]) == gen, bar);
            __builtin_amdgcn_fence(__ATOMIC_ACQUIRE, "agent");
            asm volatile("s_waitcnt vmcnt(0)" ::: "memory");
        }
    }
    __syncthreads();
}

__global__ void __launch_bounds__(512, 2) fwd_megakernel(Params p) {
    extern __shared__ __attribute__((aligned(16))) unsigned char smem[];
    LAS unsigned char* lds = (LAS unsigned char*)smem;
    cg::grid_group grid = cg::this_grid();
    if (threadIdx.x < 2) ((volatile LAS unsigned*)(lds + LDS_CTL))[threadIdx.x] = 0u;
    __syncthreads();
    const XcdBarrier bar = xcd_barrier_post((unsigned*)(p.ws + OFF_CTL), (volatile LAS unsigned*)(lds + LDS_CTL));
    grid.sync();
    unsigned char* ws = p.ws; bf16_t* WB = (bf16_t*)ws; bf16_t* XB = (bf16_t*)(ws + OFF_XB); float* part = (float*)(ws + OFF_PART);
    unsigned char* st = ws + OFF_STAGE;
    for (int ph = p.ph_lo; ph < p.ph_hi; ++ph) {
        if (ph > p.ph_lo) { for (int xs = 0; xs <= PROBE_SYNC; ++xs) xcd_barrier(bar); }
        if (ph == 37) { phase_final(p); continue; }
        const int layer = ph >= 21 ? 1 : 0, q = ph - layer * 21;
        int op = -1, arg = 0;
        if (q == 0) op = 0; else if (q == 1) op = 1; else if (q == 2) op = 2;
        else if (layer == 0) {
            if (q <= 14) { const int hh = (q - 3) / 3, s = (q - 3) % 3; arg = hh; op = 10 + s; }
            else if (q == 15) { op = 13; arg = 3; } else op = q - 16 + 3;
        } else {
            if (q <= 10) { arg = (q - 3) >> 1; op = 20 + ((q - 3) & 1); } else op = q - 11 + 3;
        }
        if (op == 10 && arg > 0) gla_combine(p, arg - 1);
        for (int rep = 0; rep < (((PROBE_REP >> op) & 1u) ? 2 : 1); ++rep) {
        if (op == 0) { if (EN(0)) phase_prologue(p, layer, lds); }
        else if (op == 11) { if (EN(11)) gla_scan<false>(p, lds); }
        else if (op == 12) { if (EN(12)) gla_scan<true>(p, lds); }
        else if (op == 13) { if (EN(13)) gla_combine(p, arg); }
        else if (op == 21) { if (EN(21)) dil_attn(p, arg, lds); }
        else if (EN(1)) {
            GemmJob J;
            for (int j = 0; j < 8; ++j) { if (!get_job(p, op, arg, j, J)) break;
                const int nres = layer * 4 + (op >= 7 ? 3 : (op >= 5 && op < 10 ? 2 : (op == 4 || op == 3 ? 1 : (op == 2 ? 0 : (op == 1 ? 0 : (op == 6 ? 3 : 1))))));
                const int vr = (op == 1) ? layer * 4 : ((op == 10 || op == 20) ? layer * 4 + 1 : (op == 4 ? layer * 4 + 2 : layer * 4 + 3));
                const float* part = (const float*)(ws + OFF_PARTV + (size_t)vr * PARTV_BYTES); float* partw = (float*)(ws + OFF_PARTV + (size_t)(nres + 1) * PARTV_BYTES); const int kind = J.e.kind;
                if (EN(22) && kind == 0) { EpiPlain e{(bf16_t*)(ws + J.e.o_off), J.e.ldc, J.e.bstride}; gemm_phase(lds, J.K, J.lda, J.ldb, J.s, e); }
                else if (EN(23) && kind == 1) { EpiSwiGLU e{(bf16_t*)(ws + J.e.o_off), part}; gemm_phase(lds, DM, DM, DM, J.s, e); }
                else if (EN(24) && kind == 2) { EpiResid e{p.X, XB, partw, J.e.scale, (LAS float*)(lds + LDS_X)}; gemm_phase(lds, J.K, J.K, J.K, J.s, e); }
                else if (EN(25) && kind == 3) { EpiGlaProj e{(bf16_t*)(st + ST_QK), (float*)(st + ST_GG), (bf16_t*)(st + ST_VV), (bf16_t*)(st + ST_ABUF), part, p.in[11], p.in[13], J.e.h}; gemm_phase(lds, DM, DM, DM, J.s, e); }
                else if (EN(26) && kind == 4) { EpiDilQK e{(bf16_t*)(ws + J.e.o_off), part, J.e.r}; gemm_phase(lds, DM, J.lda, DM, J.s, e); }
                else if (EN(27) && kind == 5) { EpiDilVT e{(bf16_t*)(ws + J.e.o_off), part, J.e.r}; gemm_phase(lds, DM, DM, J.ldb, J.s, e); }
                else if (EN(28) && kind == 6) { EpiScores e{(bf16_t*)(ws + J.e.o_off), part, (LAS f32x2*)(lds + LDS_X)}; gemm_phase(lds, DM, DM, DM, J.s, e); }
            }
        }
        __syncthreads();
        }
    }
}

extern "C" void kernel_launch(void* const* d_in, const int* in_sizes, int n_in, void* d_out, int out_size, void* d_ws, size_t ws_size, hipStream_t stream) {
    static int grid_blocks = 0;
    if (!grid_blocks) {
        int dev = 0, cus = 0, per_cu = 0;
        hipGetDevice(&dev);
        hipDeviceGetAttribute(&cus, hipDeviceAttributeMultiprocessorCount, dev);
        hipFuncSetAttribute((const void*)fwd_megakernel, hipFuncAttributeMaxDynamicSharedMemorySize, LDS_BYTES);
        hipOccupancyMaxActiveBlocksPerMultiprocessor(&per_cu, fwd_megakernel, 512, LDS_BYTES);
        if (per_cu < 1) per_cu = 1;
        if (per_cu > 1) per_cu = 1;
        grid_blocks = cus * per_cu;
    }
    if (n_in != 27 || ws_size < WS_NEED) { fprintf(stderr, "kernel_launch: unexpected n_in %d / ws_size %zu (need %zu)\n", n_in, ws_size, (size_t)WS_NEED); return; }
    hipMemsetAsync((char*)d_ws + OFF_CTL, 0, CTL_BYTES, stream);
    Params p{};
    for (int i = 0; i < 27; ++i) p.in[i] = (const float*)d_in[i];
    p.X = (float*)d_out; p.ws = (unsigned char*)d_ws; p.ph_lo = 0; p.ph_hi = 38;
    void* args[] = {&p};
    hipError_t e = hipLaunchCooperativeKernel((const void*)fwd_megakernel, dim3(grid_blocks), dim3(512), args, LDS_BYTES, stream);
    if (e != hipSuccess) fprintf(stderr, "cooperative launch failed: %s (grid %d)\n", hipGetErrorString(e), grid_blocks);
}
```

```cpp
#include <hip/hip_runtime.h>
#include <hip/hip_cooperative_groups.h>
#include <cstdio>
#include <cstdint>
namespace cg = cooperative_groups;

#define LAS __attribute__((address_space(3)))
typedef unsigned short bf16_t;
typedef short bf16x8 __attribute__((ext_vector_type(8)));
typedef short bf16x4 __attribute__((ext_vector_type(4)));
typedef float f32x4 __attribute__((ext_vector_type(4)));
typedef float f32x2 __attribute__((ext_vector_type(2)));
typedef unsigned u32x4 __attribute__((ext_vector_type(4)));
typedef unsigned u32x2 __attribute__((ext_vector_type(2)));

#ifndef OPMASK
#define OPMASK 0xFFFFFFFFu
#endif
#define EN(o) ((OPMASK >> (o)) & 1u)
#ifndef PROBE_REP
#define PROBE_REP 0u
#endif
#ifndef PROBE_SYNC
#define PROBE_SYNC 0
#endif
constexpr int T = 32768, DM = 1024, DFF = 2816;
constexpr float EPS = 1e-6f;
constexpr int BM = 256, BK = 64, HALF = 128, HTB = HALF * BK * 2, STAGE_BYTES = 8 * HTB, NXCD = 8, WGM = 8;
constexpr int LDS_X = STAGE_BYTES;
constexpr int LDS_BYTES = 160 * 1024;
constexpr int LDS_CTL = LDS_BYTES - 64;

constexpr size_t E_FFN1_IN = 0, E_FFN1_OUT = 5767168, E_FFN2_IN = 8650752, E_FFN2_OUT = 14417920, E_CQ = 17301504, E_CKV = 18350080,
                 E_CO = 20447232, E_MIX_IN = 21495808, E_MIX_OUT = 30932992, E_GT = 31981568, E_HM = 35127296, E_WEND = 38273024;
constexpr size_t OFF_XB = E_WEND * 2, OFF_PART = OFF_XB + (size_t)T * DM * 2, OFF_BTAB = OFF_PART + (size_t)T * 16, OFF_STAGE = OFF_BTAB + 32768;
constexpr size_t ST_HID = 0, ST_MEMN = 184549376, ST_KV = 186122240;
constexpr size_t ST_ABUF = 0, ST_QK = 67108864, ST_GG = 83886080, ST_VV = 117440512, ST_OF = 134217728, ST_OB = 167772160, ST_SLOC = 201326592, ST_DVEC = 209715200;
constexpr size_t ST_QKG = 67108864, ST_VTG = 167772160;
constexpr size_t OFF_CTL = OFF_STAGE + 218103808;
constexpr size_t CTL_BYTES = 16384;
constexpr size_t OFF_PARTV = OFF_CTL + CTL_BYTES;
constexpr size_t PARTV_BYTES = (size_t)T * 16;
constexpr size_t WS_NEED = OFF_PARTV + 9 * PARTV_BYTES;

struct Params {
    const float* in[27];
    float* X;
    unsigned char* ws;
    int ph_lo, ph_hi;
};

__device__ __forceinline__ unsigned cvt_pk_bf16(float lo, float hi) { unsigned r; asm volatile("v_cvt_pk_bf16_f32 %0, %1, %2" : "=v"(r) : "v"(lo), "v"(hi)); return r; }
__device__ __forceinline__ float bf2f(bf16_t b) { return __uint_as_float(((unsigned)b) << 16); }
__device__ __forceinline__ bf16_t f2bf(float f) { return (bf16_t)(cvt_pk_bf16(f, 0.f) & 0xffffu); }

__host__ __device__ __forceinline__ int lds_byte(int r, int c) { const int st = (r >> 4) * 2 + (c >> 5), rr = r & 15, cc = c & 31, ob = rr * 64 + cc * 2; return st * 1024 + (ob ^ (((ob >> 9) & 1) << 5)); }
__host__ __device__ __forceinline__ void stage_rc(int b, int& R, int& C) { const int st = b / 1024, sb = b % 1024, swz = sb ^ (((sb >> 9) & 1) << 5); R = (st >> 1) * 16 + swz / 64; C = (st & 1) * 32 + (swz % 64) / 2; }
__host__ __device__ __forceinline__ int perm32(int rho) { const int n = rho >> 4, i = rho & 15; return 8 * (i >> 2) + 4 * n + (i & 3); }

struct Unit { int pm, pn, b; const char* a; const char* bt; };

__device__ __forceinline__ int dil_token0(int n0, int r) {
    const int sb = n0 < 8192 ? 0 : (n0 < 16384 ? 8192 : 16384), S = n0 < 16384 ? 8192 : 16384, L = S / r;
    const int c = (n0 - sb) / L, l0 = (n0 - sb) % L;
    return sb + l0 * r + c;
}

struct Sched {
    const char* A; const char* Bt;
    int a_tile, b_tile, a_batch, b_batch, seqB;
    int nM, nN, nB, G, c, mode, r;
    __device__ __forceinline__ bool next(int i, Unit& u) const {
        const int per = nM * nN; const long tot = (long)per * nB;
        const long L = (long)i * G + c; if (L >= tot) return false;
        int b = (int)(L / per); int wgid = (int)(L % per);
        { const int q = per / NXCD, rr = per % NXCD, xcd = wgid % NXCD, off = wgid / NXCD; wgid = (xcd < rr ? xcd * (q + 1) : rr * (q + 1) + (xcd - rr) * q) + off; }
        const int nig = WGM * nN, gid = wgid / nig, fm = gid * WGM, gsz = (nM - fm) < WGM ? (nM - fm) : WGM;
        u.pm = fm + ((wgid % nig) % gsz); u.pn = (wgid % nig) / gsz; u.b = b;
        const char* a = A + (long)b * a_batch; const char* bt = Bt + (long)b * b_batch;
        if (mode == 2) a += (long)dil_token0(u.pm * 256, r) * (DM * 2); else a += (long)u.pm * a_tile;
        if (mode == 3) bt += (long)dil_token0(u.pn * 256, r) * (DM * 2); else bt += (long)u.pn * b_tile;
        if (mode == 1) { const int s = u.pm < 32 ? 0 : (u.pm < 64 ? 1 : 2); bt += (long)s * seqB; }
        u.a = a; u.bt = bt; return true;
    }
};


typedef unsigned long long u64_t;
__device__ __forceinline__ float ldsys_f(const float* p) { return __hip_atomic_load(p, __ATOMIC_RELAXED, __HIP_MEMORY_SCOPE_SYSTEM); }
__device__ __forceinline__ bf16_t ldsys_h(const bf16_t* p) { return __hip_atomic_load(p, __ATOMIC_RELAXED, __HIP_MEMORY_SCOPE_SYSTEM); }
__device__ __forceinline__ u32x2 ld_sys8(const void* p) {
    const u64_t a = __hip_atomic_load((const u64_t*)p, __ATOMIC_RELAXED, __HIP_MEMORY_SCOPE_SYSTEM); return (u32x2){(unsigned)a, (unsigned)(a >> 32)};
}
__device__ __forceinline__ u32x4 ld_sys16u(const void* p) {
    const u64_t* q = (const u64_t*)p;
    const u64_t a = __hip_atomic_load(q, __ATOMIC_RELAXED, __HIP_MEMORY_SCOPE_SYSTEM), b = __hip_atomic_load(q + 1, __ATOMIC_RELAXED, __HIP_MEMORY_SCOPE_SYSTEM);
    return (u32x4){(unsigned)a, (unsigned)(a >> 32), (unsigned)b, (unsigned)(b >> 32)};
}
__device__ __forceinline__ bf16x8 ld_sys16(const void* p) { return __builtin_bit_cast(bf16x8, ld_sys16u(p)); }
__device__ __forceinline__ f32x4 ld_sys16f(const void* p) { return __builtin_bit_cast(f32x4, ld_sys16u(p)); }

__device__ __forceinline__ float rstd_of(const float* part, int row) {
    const f32x4 p = *(const f32x4*)(part + (size_t)row * 4);
    return rsqrtf(((p[0] + p[1]) + (p[2] + p[3])) * (1.0f / 1024.0f) + EPS);
}


__device__ __forceinline__ void rstd8(const float* part, int row0, float (&rs)[8]) {
    f32x4 pp[8];
#pragma unroll
    for (int i = 0; i < 8; ++i) pp[i] = *(const f32x4*)(part + (size_t)(row0 + (i >> 2) * 128 + (i & 3) * 16) * 4);
#pragma unroll
    for (int i = 0; i < 8; ++i) rs[i] = rsqrtf(((pp[i][0] + pp[i][1]) + (pp[i][2] + pp[i][3])) * (1.0f / 1024.0f) + EPS);
}

#define LBAR() do { asm volatile("s_waitcnt lgkmcnt(0)" ::: "memory"); __builtin_amdgcn_s_barrier(); asm volatile("" ::: "memory"); } while (0)

struct EpiPlain {
    bf16_t* O; int ldc; int bstride;
    __device__ __forceinline__ void operator()(const f32x4 (&acc)[2][2][4][2], const Unit& u, int wr, int wc, int fr, int fq) const {
        bf16_t* base = O + (long)u.b * bstride;
#pragma unroll
        for (int ai = 0; ai < 2; ++ai)
#pragma unroll
            for (int m = 0; m < 4; ++m) { const int row = u.pm * 256 + ai * 128 + wr * 64 + m * 16 + fr;
#pragma unroll
                for (int bj = 0; bj < 2; ++bj) { const int col = u.pn * 256 + bj * 128 + wc * 32 + 8 * fq;
                    const f32x4 v0 = acc[ai][bj][m][0], v1 = acc[ai][bj][m][1];
                    u32x4 w; w.x = cvt_pk_bf16(v0[0], v0[1]); w.y = cvt_pk_bf16(v0[2], v0[3]); w.z = cvt_pk_bf16(v1[0], v1[1]); w.w = cvt_pk_bf16(v1[2], v1[3]);
                    *(u32x4*)(base + (long)row * ldc + col) = w; } }
    }
};
struct EpiSwiGLU {
    bf16_t* H; const float* part;
    __device__ __forceinline__ void operator()(const f32x4 (&acc)[2][2][4][2], const Unit& u, int wr, int wc, int fr, int fq) const {
        float rs8[8]; rstd8(part, u.pm * 256 + wr * 64 + fr, rs8);
#pragma unroll
        for (int ai = 0; ai < 2; ++ai)
#pragma unroll
            for (int m = 0; m < 4; ++m) { const int row = u.pm * 256 + ai * 128 + wr * 64 + m * 16 + fr; const float rs = rs8[ai * 4 + m];
                float h[8];
#pragma unroll
                for (int n = 0; n < 2; ++n)
#pragma unroll
                    for (int j = 0; j < 4; ++j) { const float a = acc[ai][0][m][n][j] * rs, b = acc[ai][1][m][n][j] * rs; h[n * 4 + j] = a * b * __builtin_amdgcn_rcpf(1.0f + __expf(-a)); }
                u32x4 w; w.x = cvt_pk_bf16(h[0], h[1]); w.y = cvt_pk_bf16(h[2], h[3]); w.z = cvt_pk_bf16(h[4], h[5]); w.w = cvt_pk_bf16(h[6], h[7]);
                *(u32x4*)(H + (long)row * DFF + u.pn * 128 + wc * 32 + 8 * fq) = w; }
    }
};
struct EpiResid {
    float* X; bf16_t* XB; float* part; float scale; LAS float* xt;
    __device__ __forceinline__ void operator()(const f32x4 (&acc)[2][2][4][2], const Unit& u, int wr, int wc, int fr, int fq) const {
#pragma unroll
        for (int ai = 0; ai < 2; ++ai) {
            f32x4 xv[4][2][2];
#pragma unroll
            for (int m = 0; m < 4; ++m)
#pragma unroll
                for (int bj = 0; bj < 2; ++bj) { const float* xp = X + ((long)u.pm * 256 + ai * 128 + wr * 64 + m * 16 + fr) * DM + u.pn * 256 + bj * 128 + wc * 32 + 8 * fq;
                    xv[m][bj][0] = *(const f32x4*)xp; xv[m][bj][1] = *(const f32x4*)(xp + 4); }
#pragma unroll
            for (int m = 0; m < 4; ++m) { const int rl = ai * 128 + wr * 64 + m * 16 + fr; const long row = (long)u.pm * 256 + rl; float ss = 0.f;
#pragma unroll
                for (int bj = 0; bj < 2; ++bj) { const int col = u.pn * 256 + bj * 128 + wc * 32 + 8 * fq;
                    float* xp = X + row * DM + col;
                    const f32x4 x0 = xv[m][bj][0] + acc[ai][bj][m][0] * scale, x1 = xv[m][bj][1] + acc[ai][bj][m][1] * scale;
                    *(f32x4*)xp = x0; *(f32x4*)(xp + 4) = x1;
                    u32x4 w; w.x = cvt_pk_bf16(x0[0], x0[1]); w.y = cvt_pk_bf16(x0[2], x0[3]); w.z = cvt_pk_bf16(x1[0], x1[1]); w.w = cvt_pk_bf16(x1[2], x1[3]);
                    *(u32x4*)(XB + row * DM + col) = w;
                    ss += (x0[0] * x0[0] + x0[1] * x0[1]) + (x0[2] * x0[2] + x0[3] * x0[3]) + (x1[0] * x1[0] + x1[1] * x1[1]) + (x1[2] * x1[2] + x1[3] * x1[3]); }
                ss += __shfl_xor(ss, 16); ss += __shfl_xor(ss, 32);
                if (fq == 0) xt[rl * 4 + wc] = ss; }
            asm volatile("" ::: "memory");
        }
        LBAR();
        const int lane = fq * 16 + fr;
        if (lane < 32) { const int q = wc * 32 + lane, rl = (q >> 6) * 128 + wr * 64 + (q & 63);
            const f32x4 s = *(const LAS f32x4*)(xt + rl * 4);
            part[((size_t)u.pm * 256 + rl) * 4 + u.pn] = (s[0] + s[1]) + (s[2] + s[3]); }
    }
};
struct EpiGlaProj {
    bf16_t* QK; float* GG; bf16_t* VV; bf16_t* AB; const float* part; const float* bgf; const float* bgb; int h;
    __device__ __forceinline__ void operator()(const f32x4 (&acc)[2][2][4][2], const Unit& u, int wr, int wc, int fr, int fq) const {
        float rs8[8]; rstd8(part, u.pm * 256 + wr * 64 + fr, rs8);
#pragma unroll
        for (int ai = 0; ai < 2; ++ai)
#pragma unroll
            for (int m = 0; m < 4; ++m) { const long row = (long)u.pm * 256 + ai * 128 + wr * 64 + m * 16 + fr; const float rs = rs8[ai * 4 + m];
#pragma unroll
                for (int bj = 0; bj < 2; ++bj) { const int col = bj * 128 + wc * 32 + 8 * fq;
                    f32x4 v0 = acc[ai][bj][m][0] * rs, v1 = acc[ai][bj][m][1] * rs;
                    if (u.pn == 1) {
                        const float* bp = (bj == 0 ? bgf : bgb) + h * 128 + wc * 32 + 8 * fq;
                        const f32x4 b0 = *(const f32x4*)bp, b1 = *(const f32x4*)(bp + 4);
#pragma unroll
                        for (int j = 0; j < 4; ++j) { float z = v0[j] + b0[j]; v0[j] = (fminf(z, 0.f) - __logf(1.0f + __expf(-fabsf(z)))) * (1.0f / 16.0f);
                                                      z = v1[j] + b1[j]; v1[j] = (fminf(z, 0.f) - __logf(1.0f + __expf(-fabsf(z)))) * (1.0f / 16.0f); }
                        float* gp = GG + row * 256 + col; *(f32x4*)gp = v0; *(f32x4*)(gp + 4) = v1;
                    } else {
                        if (u.pn == 3) {
#pragma unroll
                            for (int j = 0; j < 4; ++j) { v0[j] = v0[j] * __builtin_amdgcn_rcpf(1.0f + __expf(-v0[j])); v1[j] = v1[j] * __builtin_amdgcn_rcpf(1.0f + __expf(-v1[j])); } }
                        u32x4 w; w.x = cvt_pk_bf16(v0[0], v0[1]); w.y = cvt_pk_bf16(v0[2], v0[3]); w.z = cvt_pk_bf16(v1[0], v1[1]); w.w = cvt_pk_bf16(v1[2], v1[3]);
                        bf16_t* dst = u.pn == 0 ? QK + row * 256 + col : (u.pn == 2 ? VV + row * 256 + col : AB + row * DM + h * 256 + col);
                        *(u32x4*)dst = w; } } }
    }
};
struct EpiDilQK {
    bf16_t* O; const float* part; int r;
    __device__ __forceinline__ void operator()(const f32x4 (&acc)[2][2][4][2], const Unit& u, int wr, int wc, int fr, int fq) const {
        const int tok0 = dil_token0(u.pm * 256, r);
        float rs8[8];
        { f32x4 pp[8];
#pragma unroll
          for (int i = 0; i < 8; ++i) pp[i] = *(const f32x4*)(part + (size_t)(tok0 + ((i >> 2) * 128 + wr * 64 + (i & 3) * 16 + fr) * r) * 4);
#pragma unroll
          for (int i = 0; i < 8; ++i) rs8[i] = rsqrtf(((pp[i][0] + pp[i][1]) + (pp[i][2] + pp[i][3])) * (1.0f / 1024.0f) + EPS); }
#pragma unroll
        for (int ai = 0; ai < 2; ++ai)
#pragma unroll
            for (int m = 0; m < 4; ++m) { const int rl = ai * 128 + wr * 64 + m * 16 + fr; const long row = (long)u.pm * 256 + rl; const float rs = rs8[ai * 4 + m];
#pragma unroll
                for (int bj = 0; bj < 2; ++bj) { const int col = u.pn * 256 + bj * 128 + wc * 32 + 8 * fq;
                    const f32x4 v0 = acc[ai][bj][m][0] * rs, v1 = acc[ai][bj][m][1] * rs;
                    u32x4 w; w.x = cvt_pk_bf16(v0[0], v0[1]); w.y = cvt_pk_bf16(v0[2], v0[3]); w.z = cvt_pk_bf16(v1[0], v1[1]); w.w = cvt_pk_bf16(v1[2], v1[3]);
                    if (u.pn == 0) *(u32x4*)(O + row * 256 + (bj * 128 + wc * 32 + 8 * fq)) = w;
                    else { const int kc = bj * 128 + wc * 32 + 8 * fq;
                        *(u32x4*)(O + (size_t)T * 256 + (size_t)((row >> 5) * 16 + (kc >> 6) * 4 + ((kc & 63) >> 4)) * 512 + (row & 31) * 16 + (kc & 8)) = w; } }
                asm volatile("" ::: "memory"); }
    }
};
struct EpiDilVT {
    bf16_t* O; const float* part; int r;
    __device__ __forceinline__ void operator()(const f32x4 (&acc)[2][2][4][2], const Unit& u, int wr, int wc, int fr, int fq) const {
        const int tok0 = dil_token0(u.pn * 256, r);
#pragma unroll
        for (int bj = 0; bj < 2; ++bj) { const int cl = bj * 128 + wc * 32 + 8 * fq; float rs[8];
#pragma unroll
            for (int j = 0; j < 8; ++j) rs[j] = rstd_of(part, tok0 + (cl + j) * r);
#pragma unroll
            for (int ai = 0; ai < 2; ++ai)
#pragma unroll
                for (int m = 0; m < 4; ++m) { const int row = ai * 128 + wr * 64 + m * 16 + fr;
                    const f32x4 v0 = acc[ai][bj][m][0], v1 = acc[ai][bj][m][1];
                    u32x4 w; w.x = cvt_pk_bf16(v0[0] * rs[0], v0[1] * rs[1]); w.y = cvt_pk_bf16(v0[2] * rs[2], v0[3] * rs[3]);
                    w.z = cvt_pk_bf16(v1[0] * rs[4], v1[1] * rs[5]); w.w = cvt_pk_bf16(v1[2] * rs[6], v1[3] * rs[7]);
                    { const int n_ = u.pn * 256 + cl; *(u32x4*)(O + (size_t)(n_ >> 5) * 8192 + row * 32 + (n_ & 31)) = w; }
                    asm volatile("" ::: "memory"); } }
    }
};
struct EpiScores {
    bf16_t* P; const float* part; LAS f32x2* xt;
    __device__ __forceinline__ void operator()(const f32x4 (&acc)[2][2][4][2], const Unit& u, int wr, int wc, int fr, int fq) const {
        float rs8[8]; rstd8(part, u.pm * 256 + wr * 64 + fr, rs8);
#pragma unroll
        for (int ai = 0; ai < 2; ++ai)
#pragma unroll
            for (int m = 0; m < 4; ++m) { const int rl = ai * 128 + wr * 64 + m * 16 + fr; const float r_ = rs8[ai * 4 + m];
                float mx = -3.0e38f;
#pragma unroll
                for (int bj = 0; bj < 2; ++bj)
#pragma unroll
                    for (int n = 0; n < 2; ++n)
#pragma unroll
                        for (int j = 0; j < 4; ++j) mx = fmaxf(mx, acc[ai][bj][m][n][j] * r_);
                mx = fmaxf(mx, __shfl_xor(mx, 16)); mx = fmaxf(mx, __shfl_xor(mx, 32));
                float l = 0.f;
#pragma unroll
                for (int bj = 0; bj < 2; ++bj)
#pragma unroll
                    for (int n = 0; n < 2; ++n)
#pragma unroll
                        for (int j = 0; j < 4; ++j) l += __expf(acc[ai][bj][m][n][j] * r_ - mx);
                l += __shfl_xor(l, 16); l += __shfl_xor(l, 32);
                if (fq == 0) xt[rl * 4 + wc] = (f32x2){mx, l};
                asm volatile("" ::: "memory"); }
        LBAR();
#pragma unroll
        for (int ai = 0; ai < 2; ++ai)
#pragma unroll
            for (int m = 0; m < 4; ++m) { const int rl = ai * 128 + wr * 64 + m * 16 + fr; const long row = (long)u.pm * 256 + rl; const float r_ = rs8[ai * 4 + m];
                const f32x2 a = xt[rl * 4 + 0], b = xt[rl * 4 + 1], c = xt[rl * 4 + 2], d = xt[rl * 4 + 3];
                const float M = fmaxf(fmaxf(a.x, b.x), fmaxf(c.x, d.x));
                const float Ls = a.y * __expf(a.x - M) + b.y * __expf(b.x - M) + c.y * __expf(c.x - M) + d.y * __expf(d.x - M);
                const float inv = __builtin_amdgcn_rcpf(Ls);
#pragma unroll
                for (int bj = 0; bj < 2; ++bj) { const int col = u.pn * 256 + bj * 128 + wc * 32 + 8 * fq; float p[8];
#pragma unroll
                    for (int n = 0; n < 2; ++n)
#pragma unroll
                        for (int j = 0; j < 4; ++j) p[n * 4 + j] = __expf(acc[ai][bj][m][n][j] * r_ - M) * inv;
                    u32x4 w; w.x = cvt_pk_bf16(p[0], p[1]); w.y = cvt_pk_bf16(p[2], p[3]); w.z = cvt_pk_bf16(p[4], p[5]); w.w = cvt_pk_bf16(p[6], p[7]);
                    *(u32x4*)(P + row * DM + col) = w; }
                asm volatile("" ::: "memory"); }
    }
};


struct EpiAny {
    int kind;
    long o_off;
    int ldc, bstride; float scale; int h, r;
    __device__ __forceinline__ void operator()(const f32x4 (&acc)[2][2][4][2], const Unit& u, int wr, int wc, int fr, int fq, const Params& p, LAS unsigned char* lds) const {
        unsigned char* ws = p.ws; unsigned char* st = ws + OFF_STAGE; const float* part = (const float*)(ws + OFF_PART);
        if (EN(22) && kind == 0) { EpiPlain e{(bf16_t*)(ws + o_off), ldc, bstride}; e(acc, u, wr, wc, fr, fq); }
        else if (EN(23) && kind == 1) { EpiSwiGLU e{(bf16_t*)(ws + o_off), part}; e(acc, u, wr, wc, fr, fq); }
        else if (EN(24) && kind == 2) { EpiResid e{p.X, (bf16_t*)(ws + OFF_XB), (float*)(ws + OFF_PART), scale, (LAS float*)(lds + LDS_X)}; e(acc, u, wr, wc, fr, fq); }
        else if (EN(25) && kind == 3) { EpiGlaProj e{(bf16_t*)(st + ST_QK), (float*)(st + ST_GG), (bf16_t*)(st + ST_VV), (bf16_t*)(st + ST_ABUF), part, p.in[11], p.in[13], h}; e(acc, u, wr, wc, fr, fq); }
        else if (EN(26) && kind == 4) { EpiDilQK e{(bf16_t*)(ws + o_off), part, r}; e(acc, u, wr, wc, fr, fq); }
        else if (EN(27) && kind == 5) { EpiDilVT e{(bf16_t*)(ws + o_off), part, r}; e(acc, u, wr, wc, fr, fq); }
        else if (EN(28)) { EpiScores e{(bf16_t*)(ws + o_off), part, (LAS f32x2*)(lds + LDS_X)}; e(acc, u, wr, wc, fr, fq); }
    }
};

template <class Epi>
__device__ __forceinline__ void gemm_phase(LAS unsigned char* lds, const int K, const int lda, const int ldb, const Sched& S, const Epi& E) {
    int tid = threadIdx.x; asm volatile("" : "+v"(tid));
    const int wid = __builtin_amdgcn_readfirstlane(tid >> 6), lane = tid & 63, wr = wid >> 2, wc = wid & 3, fr = lane & 15, fq = lane >> 4;
    const int nt = K / BK;
    unsigned voffA[2], voffB[2];
#pragma unroll
    for (int i = 0; i < 2; ++i) { int R, C; stage_rc(tid * 16 + i * 8192, R, C); const int Rb = (R & ~31) + perm32(R & 31);
        voffA[i] = (unsigned)(R * lda + C) * 2u; voffB[i] = (unsigned)(Rb * ldb + C) * 2u; }
    const size_t kstep = (size_t)(BK * 2);
    const size_t hstepA = (size_t)HALF * lda * 2, hstepB = (size_t)HALF * ldb * 2;
    const unsigned ldsw = (unsigned)wid * 1024u;
    const int aoff = lds_byte(wr * 64 + fr, fq * 8), boff = lds_byte(wc * 32 + fr, fq * 8);
#define PG8_SA(b, h) (((b) * 2 + (h)) * HTB)
#define PG8_SB(b, h) ((4 + (b) * 2 + (h)) * HTB)
#define PG8_STAGE(bufoff, gbase, voff) do { _Pragma("unroll") for (int _i = 0; _i < 2; ++_i) \
        __builtin_amdgcn_global_load_lds((const unsigned*)((const char*)(gbase) + (voff)[_i]), (LAS unsigned*)(lds + (bufoff) + ldsw + _i * 8192), 16, 0, 0); } while (0)
#define PG8_LDA(dst, b, h) do { _Pragma("unroll") for (int m = 0; m < 4; ++m) _Pragma("unroll") for (int k = 0; k < 2; ++k) dst[m][k] = *(const LAS bf16x8*)(lds + PG8_SA(b, h) + aoff + m * 2048 + k * 1024); } while (0)
#define PG8_LDB(dst, b, h) do { _Pragma("unroll") for (int n = 0; n < 2; ++n) _Pragma("unroll") for (int k = 0; k < 2; ++k) dst[n][k] = *(const LAS bf16x8*)(lds + PG8_SB(b, h) + boff + n * 2048 + k * 1024); } while (0)
#define PG8_MMA(ai, bj, At, Bt) do { __builtin_amdgcn_s_setprio(1); _Pragma("unroll") for (int m = 0; m < 4; ++m) _Pragma("unroll") for (int n = 0; n < 2; ++n) _Pragma("unroll") for (int k = 0; k < 2; ++k) \
        acc[ai][bj][m][n] = __builtin_amdgcn_mfma_f32_16x16x32_bf16(Bt[n][k], At[m][k], acc[ai][bj][m][n], 0, 0, 0); __builtin_amdgcn_s_setprio(0); } while (0)
#define PG8_WAIT_V(n) asm volatile("s_waitcnt vmcnt(" #n ")" ::: "memory")
#define PG8_WAIT_L(n) asm volatile("s_waitcnt lgkmcnt(" #n ")" ::: "memory")
#define PG8_BAR __builtin_amdgcn_s_barrier()
#define PG8_SCHED __builtin_amdgcn_sched_barrier(0)
    Unit cur, nxt; int ui = 0;
    if (!S.next(0, cur)) return;
    f32x4 acc[2][2][4][2];
#pragma unroll
    for (int a = 0; a < 2; ++a)
#pragma unroll
        for (int b = 0; b < 2; ++b)
#pragma unroll
            for (int m = 0; m < 4; ++m)
#pragma unroll
                for (int n = 0; n < 2; ++n) acc[a][b][m][n] = (f32x4){0.f, 0.f, 0.f, 0.f};
    bf16x8 At[4][2], B0[2][2], B1[2][2];
    const char* cA = cur.a; const char* cB = cur.bt;
    PG8_STAGE(PG8_SB(0, 0), cB, voffB); PG8_STAGE(PG8_SA(0, 0), cA, voffA); PG8_STAGE(PG8_SB(0, 1), cB + hstepB, voffB); PG8_STAGE(PG8_SA(0, 1), cA + hstepA, voffA);
    if (wr == 1) PG8_BAR;
    PG8_WAIT_V(4); PG8_BAR;
    PG8_STAGE(PG8_SB(1, 0), cB + kstep, voffB); PG8_STAGE(PG8_SA(1, 0), cA + kstep, voffA); PG8_STAGE(PG8_SB(1, 1), cB + hstepB + kstep, voffB);
    PG8_WAIT_V(6); PG8_BAR;
    for (;;) {
        const bool has_next = S.next(ui + 1, nxt);
        const char* nA = has_next ? nxt.a : cA; const char* nB = has_next ? nxt.bt : cB;
        for (int t = 0; t < nt; t += 2) {
            const bool last = (t == nt - 2);
            const char* a1 = cA + (size_t)(t + 1) * kstep;
            const char* a2 = last ? nA : cA + (size_t)(t + 2) * kstep; const char* b2 = last ? nB : cB + (size_t)(t + 2) * kstep;
            const char* a3 = a2 + kstep; const char* b3 = b2 + kstep;
            PG8_LDB(B0, 0, 0); PG8_SCHED; PG8_LDA(At, 0, 0); PG8_STAGE(PG8_SA(1, 1), a1 + hstepA, voffA);
            PG8_WAIT_L(8); PG8_BAR; PG8_WAIT_L(0); PG8_MMA(0, 0, At, B0); PG8_BAR; PG8_SCHED;
            PG8_LDB(B1, 0, 1); PG8_STAGE(PG8_SB(0, 0), b2, voffB);
            PG8_BAR; PG8_WAIT_L(0); PG8_MMA(0, 1, At, B1); PG8_BAR;
            PG8_LDA(At, 0, 1); PG8_STAGE(PG8_SA(0, 0), a2, voffA);
            PG8_BAR; PG8_WAIT_L(0); PG8_MMA(1, 0, At, B0); PG8_BAR; PG8_SCHED;
            PG8_STAGE(PG8_SB(0, 1), b2 + hstepB, voffB);
            PG8_WAIT_V(6); PG8_BAR; PG8_MMA(1, 1, At, B1); PG8_BAR;
            PG8_LDB(B0, 1, 0); PG8_SCHED; PG8_LDA(At, 1, 0); PG8_STAGE(PG8_SA(0, 1), a2 + hstepA, voffA);
            PG8_WAIT_L(8); PG8_BAR; PG8_WAIT_L(0); PG8_MMA(0, 0, At, B0); PG8_BAR; PG8_SCHED;
            PG8_LDB(B1, 1, 1); PG8_STAGE(PG8_SB(1, 0), b3, voffB);
            PG8_BAR; PG8_WAIT_L(0); PG8_MMA(0, 1, At, B1); PG8_BAR;
            PG8_LDA(At, 1, 1); PG8_STAGE(PG8_SA(1, 0), a3, voffA);
            PG8_BAR; PG8_WAIT_L(0); PG8_MMA(1, 0, At, B0); PG8_BAR; PG8_SCHED;
            PG8_STAGE(PG8_SB(1, 1), b3 + hstepB, voffB);
            PG8_WAIT_V(6); PG8_BAR; PG8_MMA(1, 1, At, B1); PG8_BAR;
        }
        { int t2 = threadIdx.x; asm volatile("" : "+v"(t2)); const int w2 = __builtin_amdgcn_readfirstlane(t2 >> 6), l2 = t2 & 63;
          E(acc, cur, w2 >> 2, w2 & 3, l2 & 15, l2 >> 4); }
        if (!has_next) break;
#pragma unroll
        for (int a = 0; a < 2; ++a)
#pragma unroll
            for (int b = 0; b < 2; ++b)
#pragma unroll
                for (int m = 0; m < 4; ++m)
#pragma unroll
                    for (int n = 0; n < 2; ++n) acc[a][b][m][n] = (f32x4){0.f, 0.f, 0.f, 0.f};
        cur = nxt; cA = nA; cB = nB; ++ui;
    }
    PG8_WAIT_V(0);
    if (wr == 0) PG8_BAR;
    PG8_BAR;
#undef PG8_SA
#undef PG8_SB
#undef PG8_STAGE
#undef PG8_LDA
#undef PG8_LDB
#undef PG8_MMA
#undef PG8_WAIT_V
#undef PG8_WAIT_L
#undef PG8_BAR
#undef PG8_SCHED
}

__device__ __forceinline__ Sched mk_sched(const void* A, const void* Bt, int M, int N, int lda, int ldb, int rot) {
    Sched s; s.A = (const char*)A; s.Bt = (const char*)Bt; s.a_tile = 256 * lda * 2; s.b_tile = 256 * ldb * 2; s.a_batch = 0; s.b_batch = 0; s.seqB = 0;
    s.nM = M / 256; s.nN = N / 256; s.nB = 1; s.G = gridDim.x; s.c = (int)((blockIdx.x + (unsigned)rot) % gridDim.x); s.mode = 0; s.r = 1; return s;
}


struct GemmJob { int K, lda, ldb; Sched s; EpiAny e; };
__device__ __forceinline__ int rotc(int rot) { return (int)((blockIdx.x + gridDim.x - ((unsigned)rot % gridDim.x)) % gridDim.x); }
__device__ __forceinline__ bool get_job(const Params& p, int op, int arg, int j, GemmJob& J) {
    unsigned char* ws = p.ws; bf16_t* WB = (bf16_t*)ws; bf16_t* XB = (bf16_t*)(ws + OFF_XB); unsigned char* st = ws + OFF_STAGE;
    EpiAny e; e.kind = 0; e.o_off = 0; e.ldc = DM; e.bstride = 0; e.scale = 1.0f; e.h = 0; e.r = 1;
    J.K = DM; J.lda = DM; J.ldb = DM;
    if (op == 1) {
        if (j == 0) { J.s = mk_sched(st + ST_MEMN, WB + E_CKV, 768, 2048, DM, DM, 0); e.o_off = OFF_STAGE + ST_KV; e.ldc = 2048; }
        else if (j == 1) { J.s = mk_sched(XB, WB + E_FFN1_IN, T, 2 * DFF, DM, DM, 0); J.s.c = rotc(24); e.kind = 1; e.o_off = OFF_STAGE + ST_HID; }
        else return false;
    } else if (op == 2) {
        if (j == 0) { J.s = mk_sched(st + ST_HID, WB + E_FFN1_OUT, T, DM, DFF, DFF, 0); J.K = DFF; J.lda = DFF; J.ldb = DFF; e.kind = 2; e.scale = 0.5f; }
        else if (j <= 3) { const int sq = j - 1;
            J.s = mk_sched((const char*)(st + ST_KV) + (size_t)sq * 256 * 2048 * 2, WB + E_CQ, 256, 1024, 2048, DM, 0); J.s.nB = 4; J.s.a_batch = 512; J.s.b_batch = 512; J.s.c = rotc(sq * 16);
            J.K = 256; J.lda = 2048; J.ldb = DM; e.o_off = (E_GT + (size_t)sq * DM * DM) * 2; e.ldc = DM; e.bstride = 256 * DM; }
        else if (j <= 6) { const int sq = j - 4;
            J.s = mk_sched(WB + E_CO, (const char*)(st + ST_KV) + (size_t)sq * 256 * 2048 * 2 + 1024 * 2, 1024, 256, DM, 2048, 0); J.s.nB = 4; J.s.a_batch = 512; J.s.b_batch = 512; J.s.c = rotc(48 + sq * 16);
            J.K = 256; J.lda = DM; J.ldb = 2048; e.o_off = (E_HM + (size_t)sq * DM * DM) * 2; e.ldc = DM; e.bstride = 256; }
        else return false;
    } else if (op == 3) { if (j) return false; J.s = mk_sched(st + ST_ABUF, WB + E_MIX_OUT, T, DM, DM, DM, 0); e.kind = 2; }
    else if (op == 4) { if (j) return false; J.s = mk_sched(XB, WB + E_GT, T, DM, DM, DM, 0); J.s.mode = 1; J.s.seqB = DM * DM * 2; e.kind = 6; e.o_off = OFF_STAGE + ST_ABUF; }
    else if (op == 5) { if (j) return false; J.s = mk_sched(st + ST_ABUF, WB + E_HM, T, DM, DM, DM, 0); J.s.mode = 1; J.s.seqB = DM * DM * 2; e.kind = 2; }
    else if (op == 6) { if (j) return false; J.s = mk_sched(XB, WB + E_FFN2_IN, T, 2 * DFF, DM, DM, 0); e.kind = 1; e.o_off = OFF_STAGE + ST_HID; }
    else if (op == 7) { if (j) return false; J.s = mk_sched(st + ST_HID, WB + E_FFN2_OUT, T, DM, DFF, DFF, 0); J.K = DFF; J.lda = DFF; J.ldb = DFF; e.kind = 2; e.scale = 0.5f; }
    else if (op == 10) { if (j) return false; J.s = mk_sched(XB, WB + E_MIX_IN + (size_t)arg * 1024 * DM, T, 1024, DM, DM, 0); e.kind = 3; e.h = arg; }
    else if (op == 20) { if (j >= 6) return false; const int g = j >> 1, r = g == 0 ? 1 : (g == 1 ? 4 : 16); e.r = r;
        if ((j & 1) == 0) { J.s = mk_sched(XB, WB + E_MIX_IN + (size_t)(arg * 2304 + g * 512) * DM, T, 512, r * DM, DM, 0); J.s.mode = 2; J.s.r = r; J.s.c = rotc(g * 384);
            J.lda = r * DM; e.kind = 4; e.o_off = OFF_STAGE + ST_QKG + (size_t)g * T * 512 * 2; }
        else { J.s = mk_sched(WB + E_MIX_IN + (size_t)(arg * 2304 + 1536 + g * 256) * DM, XB, 256, T, DM, r * DM, 0); J.s.mode = 3; J.s.r = r; J.s.c = rotc(g * 384 + 256);
            J.ldb = r * DM; e.kind = 5; e.o_off = OFF_STAGE + ST_VTG + (size_t)g * 256 * T * 2; } }
    else return false;
    J.e = e; return true;
}

template <int NT>
__device__ __forceinline__ void conv_tiles(const float* src, int ld_src, const int (&k0)[NT], const int (&n0)[NT], bf16_t* dst, int ld_dst, const int (&dr0)[NT], const float* gain,
                                           const float (&scale)[NT], int nvalid, LAS float* tile) {
    int tid = threadIdx.x; asm volatile("" : "+v"(tid)); const int tx = tid & 63, ty = tid >> 6;
    float v[NT][8];
#pragma unroll
    for (int t = 0; t < NT; ++t) if (t < nvalid) {
#pragma unroll
        for (int i = 0; i < 8; ++i) v[t][i] = src[(size_t)(k0[t] + ty + 8 * i) * ld_src + n0[t] + tx];
    }
#pragma unroll
    for (int t = 0; t < NT; ++t) if (t < nvalid) {
#pragma unroll
        for (int i = 0; i < 8; ++i) { float x = v[t][i] * scale[t]; if (gain) x *= gain[k0[t] + ty + 8 * i]; tile[t * 4160 + (ty + 8 * i) * 65 + tx] = x; }
    }
    __syncthreads();
    const int i2 = tid & 31;
#pragma unroll
    for (int t = 0; t < NT; ++t) if (t < nvalid) {
#pragma unroll
        for (int jj = 0; jj < 4; ++jj) { const int j = (tid >> 5) + 16 * jj; const float a = tile[t * 4160 + (2 * i2) * 65 + j], b = tile[t * 4160 + (2 * i2 + 1) * 65 + j];
            *(unsigned*)(dst + (size_t)(dr0[t] + j) * ld_dst + k0[t] + 2 * i2) = cvt_pk_bf16(a, b); }
    }
    __syncthreads();
}
__device__ __forceinline__ int map_row(int kind, int n0, float& scale) {
    scale = 1.0f;
    if (EN(23) && kind == 1) { if (n0 < DFF) return (n0 / 128) * 256 + (n0 % 128); const int j = n0 - DFF; return (j / 128) * 256 + 128 + (j % 128); }
    if (EN(24) && kind == 2) {
        if (n0 < 512) { scale = 0.08838834764831845f; return (n0 / 128) * 1024 + (n0 % 128); }
        if (n0 < 1024) { const int j = n0 - 512; return (j / 128) * 1024 + 128 + (j % 128); }
        if (n0 < 2048) { const int j = n0 - 1024; return (j / 256) * 1024 + 512 + (j % 256); }
        const int j = n0 - 2048; return (j / 256) * 1024 + 768 + (j % 256);
    }
    if (EN(25) && kind == 3) { const int tg = n0 / 1024, h = (n0 % 1024) / 64, t = tg / 3, g = tg % 3, hc = h >> 2, hl = h & 3;
        if (t == 0) scale = 0.125f;
        if (t < 2) return hc * 2304 + g * 512 + t * 256 + hl * 64;
        return hc * 2304 + 1536 + g * 256 + hl * 64; }
    return n0;
}
__device__ __forceinline__ void conv_weight(const float* src, int K, int N, int ld_src, bf16_t* dst, const float* gain, int kind, LAS float* tile, int& rot) {
    constexpr int NT = 4;
    const int nk = K / 64, nn = N / 64, tot = nk * nn, G = gridDim.x;
    for (int t0 = (int)((blockIdx.x + G - (rot % G)) % G); t0 < tot; t0 += G * NT) {
        int k0[NT], n0[NT], dr0[NT]; float sc[NT]; int nvalid = 0;
#pragma unroll
        for (int j = 0; j < NT; ++j) { const int t = t0 + j * G; const bool ok = t < tot; const int tt = ok ? t : t0; const int kt = tt % nk, ntile = tt / nk;
            k0[j] = kt * 64; n0[j] = ntile * 64; dr0[j] = map_row(kind, ntile * 64, sc[j]); nvalid += ok ? 1 : 0; }
        conv_tiles<NT>(src, ld_src, k0, n0, dst, K, dr0, gain, sc, nvalid, tile);
    }
    rot += tot;
}
__device__ __forceinline__ const float* x_in_row(const Params& p, int t) { return t < 16384 ? p.in[0] + (size_t)t * DM : p.in[1] + (size_t)(t - 16384) * DM; }

__device__ __forceinline__ void phase_prologue(const Params& p, int layer, LAS unsigned char* lds) {
    unsigned char* ws = p.ws; bf16_t* WB = (bf16_t*)ws; LAS float* tile = (LAS float*)lds;
    int tid = threadIdx.x; asm volatile("" : "+v"(tid)); const int lane = tid & 63, wid = tid >> 6, nwv = gridDim.x * 8, gw = blockIdx.x * 8 + wid;
    int rot = 0;
    conv_weight(p.in[6] + (size_t)layer * DM * 2 * DFF, DM, 2 * DFF, 2 * DFF, WB + E_FFN1_IN, p.in[5] + layer * DM, 1, tile, rot);
    conv_weight(p.in[7] + (size_t)layer * DFF * DM, DFF, DM, DM, WB + E_FFN1_OUT, nullptr, 0, tile, rot);
    conv_weight(p.in[24] + (size_t)layer * DM * 2 * DFF, DM, 2 * DFF, 2 * DFF, WB + E_FFN2_IN, p.in[23] + layer * DM, 1, tile, rot);
    conv_weight(p.in[25] + (size_t)layer * DFF * DM, DFF, DM, DM, WB + E_FFN2_OUT, nullptr, 0, tile, rot);
    conv_weight(p.in[21] + (size_t)layer * DM * 2048, DM, 2048, 2048, WB + E_CKV, nullptr, 0, tile, rot);
    conv_weight(p.in[22] + (size_t)layer * DM * DM, DM, DM, DM, WB + E_CO, nullptr, 0, tile, rot);
    if (layer == 0) {
        conv_weight(p.in[9], DM, 3072, 3104, WB + E_MIX_IN, p.in[8], 2, tile, rot);
        conv_weight(p.in[15], DM, DM, DM, WB + E_MIX_OUT, nullptr, 0, tile, rot);
        for (size_t idx = (size_t)blockIdx.x * 512 + tid; idx < (size_t)2 * 512 * 1024; idx += (size_t)gridDim.x * 512) {
            const int c = (int)(idx & 1023), n = (int)((idx >> 10) & 511), dir = (int)(idx >> 19);
            const float* wi = p.in[9] + (size_t)c * 3104 + 3072 + dir * 16; const float* wg = (dir ? p.in[12] : p.in[10]) + n;
            float s = 0.f;
#pragma unroll
            for (int r = 0; r < 16; ++r) s += wi[r] * wg[r * 512];
            s *= p.in[8][c];
            WB[E_MIX_IN + (size_t)((n >> 7) * 1024 + 256 + dir * 128 + (n & 127)) * DM + c] = f2bf(s);
        }
    } else {
        conv_weight(p.in[16], DM, 9216, 9216, WB + E_MIX_IN, p.in[8] + DM, 3, tile, rot);
        conv_weight(p.in[17], DM, DM, DM, WB + E_MIX_OUT, nullptr, 0, tile, rot);
    }
    { const float* src = p.in[20] + (size_t)layer * DM * DM; const float* g = p.in[18] + layer * DM;
      for (size_t idx = ((size_t)blockIdx.x * 512 + tid) * 4; idx < (size_t)DM * DM; idx += (size_t)gridDim.x * 512 * 4) {
          const f32x4 v = *(const f32x4*)(src + idx); const float s = g[idx >> 10] * 0.0625f;
          u32x2 w; w.x = cvt_pk_bf16(v[0] * s, v[1] * s); w.y = cvt_pk_bf16(v[2] * s, v[3] * s);
          *(u32x2*)(WB + E_CQ + idx) = w; } }
    { bf16_t* MEMN = (bf16_t*)(ws + OFF_STAGE + ST_MEMN); const float* g = p.in[19] + layer * DM;
      for (int row = gw; row < 768; row += nwv) {
          const float* src = row < 512 ? p.in[2] + (size_t)row * DM : p.in[3] + (size_t)(row - 512) * DM;
          f32x4 v[4]; float ss = 0.f;
#pragma unroll
          for (int i = 0; i < 4; ++i) { v[i] = *(const f32x4*)(src + i * 256 + lane * 4); ss += (v[i][0] * v[i][0] + v[i][1] * v[i][1]) + (v[i][2] * v[i][2] + v[i][3] * v[i][3]); }
#pragma unroll
          for (int o = 1; o < 64; o <<= 1) ss += __shfl_xor(ss, o);
          const float rs = rsqrtf(ss * (1.0f / 1024.0f) + EPS);
#pragma unroll
          for (int i = 0; i < 4; ++i) { const f32x4 gg = *(const f32x4*)(g + i * 256 + lane * 4);
              u32x2 w; w.x = cvt_pk_bf16(v[i][0] * rs * gg[0], v[i][1] * rs * gg[1]); w.y = cvt_pk_bf16(v[i][2] * rs * gg[2], v[i][3] * rs * gg[3]);
              *(u32x2*)(MEMN + (size_t)row * DM + i * 256 + lane * 4) = w; } } }
    if (layer == 0) {
        bf16_t* XB = (bf16_t*)(ws + OFF_XB); float* part = (float*)(ws + OFF_PARTV);
        for (int row = gw; row < T; row += nwv) {
            const float* src = x_in_row(p, row); f32x4 v[4]; float ss = 0.f;
#pragma unroll
            for (int i = 0; i < 4; ++i) { v[i] = *(const f32x4*)(src + i * 256 + lane * 4); ss += (v[i][0] * v[i][0] + v[i][1] * v[i][1]) + (v[i][2] * v[i][2] + v[i][3] * v[i][3]); }
#pragma unroll
            for (int o = 1; o < 64; o <<= 1) ss += __shfl_xor(ss, o);
#pragma unroll
            for (int i = 0; i < 4; ++i) { *(f32x4*)(p.X + (size_t)row * DM + i * 256 + lane * 4) = v[i];
                u32x2 w; w.x = cvt_pk_bf16(v[i][0], v[i][1]); w.y = cvt_pk_bf16(v[i][2], v[i][3]);
                *(u32x2*)(XB + (size_t)row * DM + i * 256 + lane * 4) = w; }
            if (lane == 0) *(f32x4*)(part + (size_t)row * 4) = (f32x4){ss, 0.f, 0.f, 0.f};
        }
        float* bt = (float*)(ws + OFF_BTAB);
        for (int idx = blockIdx.x * 512 + tid; idx < 3 * 16 * 129; idx += gridDim.x * 512) {
            const int rel = idx % 129 - 64, h = (idx / 129) % 16, g = idx / (129 * 16); const int r = g == 0 ? 1 : (g == 1 ? 4 : 16);
            const int rr = rel * r, n = rr < 0 ? -rr : rr; int bk;
            if (n < 8) bk = n; else bk = 8 + (n >= 15) + (n >= 27) + (n >= 50) + (n >= 91) + (n >= 166) + (n >= 305) + (n >= 559);
            if (rr > 0) bk += 16;
            bt[idx] = p.in[4][bk * 48 + g * 16 + h];
        }
    }
}

__device__ __forceinline__ void phase_final(const Params& p) {
    const float* part = (const float*)(p.ws + OFF_PARTV + 8 * PARTV_BYTES); const float* g = p.in[26];
    int tid = threadIdx.x; asm volatile("" : "+v"(tid)); const int lane = tid & 63, wid = tid >> 6, nwv = gridDim.x * 8, gw = blockIdx.x * 8 + wid;
    for (int row = gw; row < T; row += nwv) { const float rs = rstd_of(part, row);
#pragma unroll
        for (int i = 0; i < 4; ++i) { float* xp = p.X + (size_t)row * DM + i * 256 + lane * 4; const f32x4 v = ld_sys16f(xp); const f32x4 gg = *(const f32x4*)(g + i * 256 + lane * 4);
            *(f32x4*)xp = (f32x4){v[0] * rs * gg[0], v[1] * rs * gg[1], v[2] * rs * gg[2], v[3] * rs * gg[3]}; } }
}

__device__ __forceinline__ void gla_combine(const Params& p, int h) {
    unsigned char* st = p.ws + OFF_STAGE; const float* OF = (const float*)(st + ST_OF); const float* OB = (const float*)(st + ST_OB); bf16_t* AB = (bf16_t*)(st + ST_ABUF);
    const float* gn = p.in[14] + h * 256;
    int tid = threadIdx.x; asm volatile("" : "+v"(tid)); const int lane = tid & 63, wid = tid >> 6, nwv = gridDim.x * 8, gw = blockIdx.x * 8 + wid;
    const f32x4 gg = *(const f32x4*)(gn + lane * 4);
    for (int row = gw; row < T; row += nwv) {
        const f32x4 a = ld_sys16f(OF + (size_t)row * 256 + lane * 4), b = ld_sys16f(OB + (size_t)row * 256 + lane * 4);
        const f32x4 o = a + b; float ss = (o[0] * o[0] + o[1] * o[1]) + (o[2] * o[2] + o[3] * o[3]);
#pragma unroll
        for (int s = 1; s < 64; s <<= 1) ss += __shfl_xor(ss, s);
        const float rs = rsqrtf(ss * (1.0f / 256.0f) + EPS);
        bf16_t* ap = AB + (size_t)row * DM + h * 256 + lane * 4; const u32x2 rr = ld_sys8(ap);
        const float r0 = __uint_as_float(rr.x << 16), r1 = __uint_as_float(rr.x & 0xffff0000u), r2 = __uint_as_float(rr.y << 16), r3 = __uint_as_float(rr.y & 0xffff0000u);
        u32x2 w; w.x = cvt_pk_bf16(o[0] * rs * gg[0] * r0, o[1] * rs * gg[1] * r1); w.y = cvt_pk_bf16(o[2] * rs * gg[2] * r2, o[3] * rs * gg[3] * r3);
        *(u32x2*)ap = w;
    }
}

constexpr int SC_QP = 0, SC_KP = 17408, SC_KT = 34816, SC_VT = 53248, SC_ATT = 62464, SC_SS = 71680, SC_QS = 89088, SC_BL = 91136;

template <bool OUT>
__device__ __forceinline__ void gla_scan(const Params& p, LAS unsigned char* lds) {
    unsigned char* st = p.ws + OFF_STAGE;
    const bf16_t* QK = (const bf16_t*)(st + ST_QK); const float* GG = (const float*)(st + ST_GG); const bf16_t* VV = (const bf16_t*)(st + ST_VV);
    float* SLOC = (float*)(st + ST_SLOC); float* DVEC = (float*)(st + ST_DVEC);
    int tid = threadIdx.x; asm volatile("" : "+v"(tid)); const int lane = tid & 63, w = tid >> 6, l15 = lane & 15, quad = lane >> 4;
    LAS bf16_t* QP = (LAS bf16_t*)(lds + SC_QP); LAS bf16_t* KP = (LAS bf16_t*)(lds + SC_KP); LAS bf16_t* KT = (LAS bf16_t*)(lds + SC_KT);
    LAS bf16_t* VT = (LAS bf16_t*)(lds + SC_VT); LAS bf16_t* ATT = (LAS bf16_t*)(lds + SC_ATT); LAS bf16_t* SS = (LAS bf16_t*)(lds + SC_SS);
    LAS float* QS = (LAS float*)(lds + SC_QS); LAS float* BL = (LAS float*)(lds + SC_BL);
    for (int unit = blockIdx.x; unit < 256; unit += gridDim.x) {
        const int slice = unit & 3, dir = (unit >> 2) & 1, seg = unit >> 3;
        const int sfirst = seg < 8 ? 0 : (seg < 16 ? 8 : 16), nseg = seg < 16 ? 8 : 16;
        const int sigma = dir == 0 ? seg - sfirst : sfirst + nseg - 1 - seg;
        float* oout = (float*)(st + (dir == 0 ? ST_OF : ST_OB));
        f32x4 S[4];
#pragma unroll
        for (int d = 0; d < 4; ++d) S[d] = (f32x4){0.f, 0.f, 0.f, 0.f};
        if (OUT) {
            for (int sp = 0; sp < sigma; ++sp) {
                const int sg = dir == 0 ? sfirst + sp : sfirst + nseg - 1 - sp;
                const float* sl = SLOC + (size_t)(sg * 2 + dir) * 128 * 256; const float* dv = DVEC + (size_t)(sg * 2 + dir) * 128;
#pragma unroll
                for (int r = 0; r < 4; ++r) { const int dk = 16 * w + 4 * quad + r; const float dd = ldsys_f(dv + dk);
#pragma unroll
                    for (int d = 0; d < 4; ++d) S[d][r] = S[d][r] * dd + ldsys_f(sl + (size_t)dk * 256 + slice * 64 + d * 16 + l15); }
            }
        }
        float dsum = 0.f;
        const int dkc = tid & 127, qr = tid >> 7;
        const int dvc = tid & 63, jr = tid >> 6;
        for (int ch = 0; ch < 16; ++ch) {
            const int tb = seg * 1024 + (dir == 0 ? ch * 64 : (15 - ch) * 64);
            float g[16]; float q[16], k[16];
#pragma unroll
            for (int ii = 0; ii < 16; ++ii) { const int ip = qr * 16 + ii; const int tok = tb + (dir == 0 ? ip : 63 - ip);
                g[ii] = ldsys_f(GG + (size_t)tok * 256 + dir * 128 + dkc);
                if (OUT) q[ii] = bf2f(ldsys_h(QK + (size_t)tok * 256 + dkc));
                k[ii] = bf2f(ldsys_h(QK + (size_t)tok * 256 + 128 + dkc)); }
            unsigned vpk[4];
            { float v[8];
#pragma unroll
              for (int jj = 0; jj < 8; ++jj) { const int jp = jr * 8 + jj; const int tok = tb + (dir == 0 ? jp : 63 - jp); v[jj] = bf2f(ldsys_h(VV + (size_t)tok * 256 + slice * 64 + dvc)); }
#pragma unroll
              for (int jj = 0; jj < 4; ++jj) vpk[jj] = cvt_pk_bf16(v[2 * jj], v[2 * jj + 1]); }
#pragma unroll
            for (int ii = 1; ii < 16; ++ii) g[ii] += g[ii - 1];
            QS[qr * 128 + dkc] = g[15];
            *(LAS u32x4*)(VT + dvc * 72 + jr * 8) = (u32x4){vpk[0], vpk[1], vpk[2], vpk[3]};
            __syncthreads();
            float off = 0.f, tot = 0.f;
#pragma unroll
            for (int qq = 0; qq < 4; ++qq) { const float s = QS[qq * 128 + dkc]; tot += s; if (qq < qr) off += s; }
            if (qr == 0) { BL[dkc] = __expf(tot); dsum += tot; }
            unsigned kt[8];
#pragma unroll
            for (int ii = 0; ii < 16; ii += 2) {
                const float b0 = off + g[ii], b1 = off + g[ii + 1];
                if (OUT) { const int ip = qr * 16 + ii;
                    QP[ip * 136 + dkc] = f2bf(q[ii] * __expf(b0)); QP[(ip + 1) * 136 + dkc] = f2bf(q[ii + 1] * __expf(b1));
                    KP[ip * 136 + dkc] = f2bf(k[ii] * __expf(-b0)); KP[(ip + 1) * 136 + dkc] = f2bf(k[ii + 1] * __expf(-b1)); }
                kt[ii >> 1] = cvt_pk_bf16(k[ii] * __expf(tot - b0), k[ii + 1] * __expf(tot - b1));
            }
            *(LAS u32x4*)(KT + dkc * 72 + qr * 16) = (u32x4){kt[0], kt[1], kt[2], kt[3]};
            *(LAS u32x4*)(KT + dkc * 72 + qr * 16 + 8) = (u32x4){kt[4], kt[5], kt[6], kt[7]};
            if (OUT) {
#pragma unroll
                for (int d = 0; d < 4; ++d) { u32x2 sw; sw.x = cvt_pk_bf16(S[d][0], S[d][1]); sw.y = cvt_pk_bf16(S[d][2], S[d][3]);
                    *(LAS u32x2*)(SS + (d * 16 + l15) * 136 + 16 * w + 4 * quad) = sw; }
            }
            __syncthreads();
            f32x4 O[2];
            if (OUT) {
                const int it = w >> 1, c0 = (w & 1) * 2;
                f32x4 at[2] = {(f32x4){0.f, 0.f, 0.f, 0.f}, (f32x4){0.f, 0.f, 0.f, 0.f}};
                O[0] = (f32x4){0.f, 0.f, 0.f, 0.f}; O[1] = (f32x4){0.f, 0.f, 0.f, 0.f};
#pragma unroll
                for (int kk = 0; kk < 4; ++kk) {
                    const bf16x8 af = *(const LAS bf16x8*)(QP + (it * 16 + l15) * 136 + kk * 32 + quad * 8);
#pragma unroll
                    for (int x = 0; x < 2; ++x) {
                        const bf16x8 kf = *(const LAS bf16x8*)(KP + ((c0 + x) * 16 + l15) * 136 + kk * 32 + quad * 8);
                        at[x] = __builtin_amdgcn_mfma_f32_16x16x32_bf16(af, kf, at[x], 0, 0, 0);
                        const bf16x8 sf = *(const LAS bf16x8*)(SS + ((c0 + x) * 16 + l15) * 136 + kk * 32 + quad * 8);
                        O[x] = __builtin_amdgcn_mfma_f32_16x16x32_bf16(af, sf, O[x], 0, 0, 0);
                    }
                }
#pragma unroll
                for (int x = 0; x < 2; ++x)
#pragma unroll
                    for (int r = 0; r < 4; ++r) { const int i = it * 16 + quad * 4 + r, j = (c0 + x) * 16 + l15;
                        ATT[i * 72 + j] = f2bf(j <= i ? at[x][r] : 0.f); }
            }
            {
#pragma unroll
                for (int r = 0; r < 4; ++r) { const float dd = BL[16 * w + 4 * quad + r];
#pragma unroll
                    for (int d = 0; d < 4; ++d) S[d][r] *= dd; }
#pragma unroll
                for (int kk = 0; kk < 2; ++kk) {
                    const bf16x8 af = *(const LAS bf16x8*)(KT + (16 * w + l15) * 72 + kk * 32 + quad * 8);
#pragma unroll
                    for (int d = 0; d < 4; ++d) { const bf16x8 vf = *(const LAS bf16x8*)(VT + (d * 16 + l15) * 72 + kk * 32 + quad * 8);
                        S[d] = __builtin_amdgcn_mfma_f32_16x16x32_bf16(af, vf, S[d], 0, 0, 0); }
                }
            }
            if (OUT) {
                __syncthreads();
                const int it = w >> 1, c0 = (w & 1) * 2;
#pragma unroll
                for (int kk = 0; kk < 2; ++kk) {
                    const bf16x8 af = *(const LAS bf16x8*)(ATT + (it * 16 + l15) * 72 + kk * 32 + quad * 8);
#pragma unroll
                    for (int x = 0; x < 2; ++x) { const bf16x8 vf = *(const LAS bf16x8*)(VT + ((c0 + x) * 16 + l15) * 72 + kk * 32 + quad * 8);
                        O[x] = __builtin_amdgcn_mfma_f32_16x16x32_bf16(af, vf, O[x], 0, 0, 0); }
                }
#pragma unroll
                for (int x = 0; x < 2; ++x)
#pragma unroll
                    for (int r = 0; r < 4; ++r) { const int ip = it * 16 + quad * 4 + r; const int tok = tb + (dir == 0 ? ip : 63 - ip);
                        oout[(size_t)tok * 256 + slice * 64 + (c0 + x) * 16 + l15] = O[x][r]; }
            }
            __syncthreads();
        }
        if (!OUT) {
            float* sl = SLOC + (size_t)(seg * 2 + dir) * 128 * 256;
#pragma unroll
            for (int r = 0; r < 4; ++r) { const int dk = 16 * w + 4 * quad + r;
#pragma unroll
                for (int d = 0; d < 4; ++d) sl[(size_t)dk * 256 + slice * 64 + d * 16 + l15] = S[d][r]; }
            if (slice == 0 && tid < 128) DVEC[(size_t)(seg * 2 + dir) * 128 + tid] = __expf(dsum);
        }
    }
}

typedef float f32x16 __attribute__((ext_vector_type(16)));
__device__ __forceinline__ void dil_attn(const Params& p, int hc, LAS unsigned char* lds) {
    unsigned char* st = p.ws + OFF_STAGE; bf16_t* AB = (bf16_t*)(st + ST_ABUF); const float* btab = (const float*)(p.ws + OFF_BTAB);
    LAS float* OST = (LAS float*)lds; LAS float* MST = (LAS float*)(lds + 139264); LAS float* LST = (LAS float*)(lds + 141312); LAS float* BTL = (LAS float*)(lds + 143360);
    int tid = threadIdx.x; asm volatile("" : "+v"(tid)); const int lane = tid & 63, w = tid >> 6, l31 = lane & 31, hh = lane >> 5;
    const int kap = (l31 & 16) | ((l31 & 4) << 1) | ((l31 & 8) >> 1) | (l31 & 3);
    for (int unit = blockIdx.x; unit < 256; unit += gridDim.x) {
        const int hl = unit & 3, tbk = unit >> 2, t0 = tbk * 512;
        const int sb = t0 < 8192 ? 0 : (t0 < 16384 ? 8192 : 16384), Sq = t0 < 16384 ? 8192 : 16384;
        const int h = hc * 4 + hl;
#pragma unroll 1
        for (int g = 0; g < 3; ++g) {
            const int r = g == 0 ? 1 : (g == 1 ? 4 : 16), L = Sq / r;
            const bf16_t* QKg = (const bf16_t*)(st + ST_QKG) + (size_t)g * T * 512; const bf16_t* VTg = (const bf16_t*)(st + ST_VTG) + (size_t)g * 256 * T;
            const float* bt = btab + (g * 16 + h) * 129;
            if (tid < 256) { const int ri = tid - 96; BTL[tid] = (ri >= 0 && ri <= 128) ? bt[ri] : 0.f; }
            __syncthreads();
#pragma unroll 1
            for (int itx = 0; itx < 2; ++itx) {
                const int item = 2 * w + itx;
                int c, l0;
                if (g == 0) { c = 0; l0 = (t0 - sb) + 32 * item; } else if (g == 1) { c = item >> 2; l0 = (t0 - sb) / 4 + 32 * (item & 3); } else { c = item; l0 = (t0 - sb) / 16; }
                const int nq0 = sb + c * L + l0, nbase = nq0 - 64;
                const int tokl = (l0 + l31) * r + c - (t0 - sb);
                bf16x8 qf[4];
#pragma unroll
                for (int ks = 0; ks < 4; ++ks) qf[ks] = ld_sys16(QKg + (unsigned)((nq0 + l31) * 256 + hl * 64 + ks * 16 + hh * 8));
                f32x16 sT[5];
                bf16x8 kf[4];
#define DIL_LOADK(kt) do { const int lkh_ = l0 - 64 + 32 * (kt) + (l31 & 16); const bool in_ = (lkh_ >= 0) && (lkh_ < L); \
                    const int nrow_ = in_ ? nbase + 32 * (kt) + kap : nq0 + l31; \
                    _Pragma("unroll") for (int ks_ = 0; ks_ < 4; ++ks_) kf[ks_] = ld_sys16(QKg + (unsigned)(T * 256 + ((nrow_ >> 5) * 16 + hl * 4 + ks_) * 512 + (nrow_ & 31) * 16 + hh * 8)); } while (0)
#pragma unroll
                for (int kt = 0; kt < 5; ++kt) {
                    DIL_LOADK(kt);
                    f32x16 a;
#pragma unroll
                    for (int j = 0; j < 16; ++j) a[j] = 0.f;
#pragma unroll
                    for (int ks = 0; ks < 4; ++ks) a = __builtin_amdgcn_mfma_f32_32x32x16_bf16(kf[ks], qf[ks], a, 0, 0, 0);
                    sT[kt] = a;
                }
                bf16x8 vf[4];
#define DIL_LOADV(kt) do { _Pragma("unroll") for (int s_ = 0; s_ < 2; ++s_) { const int lkh_ = l0 - 64 + 32 * (kt) + 16 * s_; const bool in_ = (lkh_ >= 0) && (lkh_ < L); \
                    const int ncol_ = in_ ? nbase + 32 * (kt) + 16 * s_ + 8 * hh : nq0; \
                    _Pragma("unroll") for (int dt_ = 0; dt_ < 2; ++dt_) vf[2 * s_ + dt_] = ld_sys16(VTg + (unsigned)((ncol_ >> 5) * 8192 + (hl * 64 + dt_ * 32 + l31) * 32 + (ncol_ & 31))); } } while (0)
                DIL_LOADV(0);
#pragma unroll
                for (int kt = 0; kt < 5; ++kt)
#pragma unroll
                    for (int j = 0; j < 16; ++j) { const int lkh = l0 - 64 + 32 * kt + 16 * (j >> 3); const bool inr = (lkh >= 0) && (lkh < L);
                        const int rel = -64 + 32 * kt + 16 * (j >> 3) + 8 * hh + (j & 7) - l31; const bool ok = inr && rel >= -64 && rel <= 64;
                        sT[kt][j] = ok ? sT[kt][j] + BTL[rel + 160] : -1.0e30f; }
                float mo = -1.0e30f, lo = 0.f;
                if (g > 0) { mo = MST[tokl]; lo = LST[tokl]; }
                float mx = mo;
#pragma unroll
                for (int kt = 0; kt < 5; ++kt)
#pragma unroll
                    for (int j = 0; j < 16; ++j) mx = fmaxf(mx, sT[kt][j]);
                mx = fmaxf(mx, __shfl_xor(mx, 32));
                const float alpha = __expf(mo - mx);
                float ls = 0.f;
#pragma unroll
                for (int kt = 0; kt < 5; ++kt)
#pragma unroll
                    for (int j = 0; j < 16; ++j) { const float e = __expf(sT[kt][j] - mx); sT[kt][j] = e; ls += e; }
                ls += __shfl_xor(ls, 32);
                const float ln = lo * alpha + ls;
                f32x16 O[2];
#pragma unroll
                for (int dt = 0; dt < 2; ++dt)
#pragma unroll
                    for (int j = 0; j < 16; ++j) O[dt][j] = 0.f;
                if (g > 0) {
#pragma unroll
                    for (int dt = 0; dt < 2; ++dt)
#pragma unroll
                        for (int g4 = 0; g4 < 4; ++g4) { const f32x4 o4 = *(const LAS f32x4*)(OST + tokl * 68 + dt * 32 + g4 * 8 + hh * 4);
                            O[dt][4 * g4] = o4[0] * alpha; O[dt][4 * g4 + 1] = o4[1] * alpha; O[dt][4 * g4 + 2] = o4[2] * alpha; O[dt][4 * g4 + 3] = o4[3] * alpha; } }
#pragma unroll
                for (int kt = 0; kt < 5; ++kt) {
                    if (kt > 0) DIL_LOADV(kt);
#pragma unroll
                    for (int s2 = 0; s2 < 2; ++s2) {
                        u32x4 pw; pw.x = cvt_pk_bf16(sT[kt][8 * s2], sT[kt][8 * s2 + 1]); pw.y = cvt_pk_bf16(sT[kt][8 * s2 + 2], sT[kt][8 * s2 + 3]);
                        pw.z = cvt_pk_bf16(sT[kt][8 * s2 + 4], sT[kt][8 * s2 + 5]); pw.w = cvt_pk_bf16(sT[kt][8 * s2 + 6], sT[kt][8 * s2 + 7]);
                        const bf16x8 pf = __builtin_bit_cast(bf16x8, pw);
#pragma unroll
                        for (int dt = 0; dt < 2; ++dt) O[dt] = __builtin_amdgcn_mfma_f32_32x32x16_bf16(vf[2 * s2 + dt], pf, O[dt], 0, 0, 0);
                    }
                }
#undef DIL_LOADK
#undef DIL_LOADV
                if (g < 2) {
                    if (hh == 0) { MST[tokl] = mx; LST[tokl] = ln; }
#pragma unroll
                    for (int dt = 0; dt < 2; ++dt)
#pragma unroll
                        for (int g4 = 0; g4 < 4; ++g4) *(LAS f32x4*)(OST + tokl * 68 + dt * 32 + g4 * 8 + hh * 4) = (f32x4){O[dt][4 * g4], O[dt][4 * g4 + 1], O[dt][4 * g4 + 2], O[dt][4 * g4 + 3]};
                } else {
                    const float inv = 1.0f / ln;
#pragma unroll
                    for (int dt = 0; dt < 2; ++dt)
#pragma unroll
                        for (int g4 = 0; g4 < 4; ++g4) { u32x2 ow; ow.x = cvt_pk_bf16(O[dt][4 * g4] * inv, O[dt][4 * g4 + 1] * inv); ow.y = cvt_pk_bf16(O[dt][4 * g4 + 2] * inv, O[dt][4 * g4 + 3] * inv);
                            *(u32x2*)(AB + (size_t)(t0 + tokl) * DM + h * 64 + dt * 32 + g4 * 8 + hh * 4) = ow; }
                }
            }
            __syncthreads();
        }
    }
}

#define XB_TMO      128
#define XB_XCNT(j)  (256  + 64 * (j))
#define XB_XSUB(j)  (1280 + 64 * (j))
#define XB_XGEN(j)  (2304 + 64 * (j))
#define XB_TOP      3328
#define XB_TOPGEN   3392
#define XCD_BAR_WORDS 3456
#define XB_SPIN_CAP (1u << 22)
__device__ __forceinline__ unsigned xb_ld(unsigned* p)              { return __hip_atomic_load(p, __ATOMIC_RELAXED, __HIP_MEMORY_SCOPE_AGENT); }
__device__ __forceinline__ unsigned xb_add(unsigned* p, unsigned v) { return __hip_atomic_fetch_add(p, v, __ATOMIC_RELAXED, __HIP_MEMORY_SCOPE_AGENT); }
__device__ __forceinline__ unsigned xb_xcc_id() { return (unsigned)__builtin_amdgcn_s_getreg((3 << 11) | 20) & 0xFu; }
#define XB_SPIN(cond, bar) do { unsigned _sp = 0; while (cond) { __builtin_amdgcn_s_sleep(1); \
    if ((++_sp & 255u) == 0u) { if (xb_ld(&(bar)[XB_TMO])) break; if (_sp > XB_SPIN_CAP) { atomicAdd(&(bar)[XB_TMO], 1u); break; } } } } while (0)
struct XcdBarrier { unsigned* bar; unsigned x; volatile LAS unsigned* st; };
__device__ __forceinline__ XcdBarrier xcd_barrier_post(unsigned* bar, volatile LAS unsigned* st) {
    XcdBarrier b; b.bar = bar; b.x = xb_xcc_id(); b.st = st;
    if (threadIdx.x == 0) (void)xb_add(&bar[XB_XCNT(b.x)], 1u);
    return b;
}
__device__ __forceinline__ void xcd_barrier_complete(unsigned* bar, unsigned x, unsigned& nloc, unsigned& nx) {
    const unsigned G = gridDim.x * gridDim.y * gridDim.z;
    unsigned sum, cnt, mine, sp = 0u;
    for (;;) {
        sum = 0u; cnt = 0u; mine = 0u;
#pragma unroll
        for (unsigned j = 0; j < 16; ++j) { const unsigned c = xb_ld(&bar[XB_XCNT(j)]); sum += c; cnt += (c > 0u) ? 1u : 0u; mine = (j == x) ? c : mine; }
        if (sum == G) break;
        __builtin_amdgcn_s_sleep(1);
        if ((++sp & 255u) == 0u) { if (xb_ld(&bar[XB_TMO])) break; if (sp > XB_SPIN_CAP) { atomicAdd(&bar[XB_TMO], 1u); break; } }
    }
    nloc = mine > 0u ? mine : 1u; nx = cnt > 0u ? cnt : 1u;
}
__device__ __forceinline__ void xcd_barrier(const XcdBarrier& b) {
    asm volatile("s_waitcnt vmcnt(0)" ::: "memory");
    __syncthreads();
    if (threadIdx.x == 0) {
        unsigned* bar = b.bar;
        __builtin_amdgcn_s_waitcnt(0);
        unsigned nloc = b.st[0], nx = b.st[1];
        if (nloc == 0u) { xcd_barrier_complete(bar, b.x, nloc, nx); b.st[0] = nloc; b.st[1] = nx; }
        const unsigned old = xb_add(&bar[XB_XSUB(b.x)], 1u);
        const unsigned gen = old / nloc;
        if (old + 1u == (gen + 1u) * nloc) {
            __builtin_amdgcn_fence(__ATOMIC_RELEASE, "agent");
            asm volatile("s_waitcnt vmcnt(0)" ::: "memory");
            const unsigned og = xb_add(&bar[XB_TOP], 1u);
            const unsigned tg = og / nx;
            if (og + 1u == (tg + 1u) * nx) xb_add(&bar[XB_TOPGEN], 1u);
            else XB_SPIN(xb_ld(&bar[XB_TOPGEN]) == tg, bar);
            __builtin_amdgcn_fence(__ATOMIC_ACQUIRE, "agent");
            xb_add(&bar[XB_XGEN(b.x)], 1u);
            asm volatile("s_waitcnt vmcnt(0)" ::: "memory");
        } else {
            XB_SPIN(xb_ld(&bar[XB_XGEN(b.x)]) == gen, bar);
            __builtin_amdgcn_fence(__ATOMIC_ACQUIRE, "agent");
            asm volatile("s_waitcnt vmcnt(0)" ::: "memory");
        }
    }
    __syncthreads();
}

__global__ void __launch_bounds__(512, 2) fwd_megakernel(Params p) {
    extern __shared__ __attribute__((aligned(16))) unsigned char smem[];
    LAS unsigned char* lds = (LAS unsigned char*)smem;
    cg::grid_group grid = cg::this_grid();
    if (threadIdx.x < 2) ((volatile LAS unsigned*)(lds + LDS_CTL))[threadIdx.x] = 0u;
    __syncthreads();
    const XcdBarrier bar = xcd_barrier_post((unsigned*)(p.ws + OFF_CTL), (volatile LAS unsigned*)(lds + LDS_CTL));
    grid.sync();
    unsigned char* ws = p.ws; bf16_t* WB = (bf16_t*)ws; bf16_t* XB = (bf16_t*)(ws + OFF_XB); float* part = (float*)(ws + OFF_PART);
    unsigned char* st = ws + OFF_STAGE;
    for (int ph = p.ph_lo; ph < p.ph_hi; ++ph) {
        if (ph > p.ph_lo) { for (int xs = 0; xs <= PROBE_SYNC; ++xs) xcd_barrier(bar); }
        if (ph == 37) { phase_final(p); continue; }
        const int layer = ph >= 21 ? 1 : 0, q = ph - layer * 21;
        int op = -1, arg = 0;
        if (q == 0) op = 0; else if (q == 1) op = 1; else if (q == 2) op = 2;
        else if (layer == 0) {
            if (q <= 14) { const int hh = (q - 3) / 3, s = (q - 3) % 3; arg = hh; op = 10 + s; }
            else if (q == 15) { op = 13; arg = 3; } else op = q - 16 + 3;
        } else {
            if (q <= 10) { arg = (q - 3) >> 1; op = 20 + ((q - 3) & 1); } else op = q - 11 + 3;
        }
        if (op == 10 && arg > 0) gla_combine(p, arg - 1);
        for (int rep = 0; rep < (((PROBE_REP >> op) & 1u) ? 2 : 1); ++rep) {
        if (op == 0) { if (EN(0)) phase_prologue(p, layer, lds); }
        else if (op == 11) { if (EN(11)) gla_scan<false>(p, lds); }
        else if (op == 12) { if (EN(12)) gla_scan<true>(p, lds); }
        else if (op == 13) { if (EN(13)) gla_combine(p, arg); }
        else if (op == 21) { if (EN(21)) dil_attn(p, arg, lds); }
        else if (EN(1)) {
            GemmJob J;
            for (int j = 0; j < 8; ++j) { if (!get_job(p, op, arg, j, J)) break;
                const int nres = layer * 4 + (op >= 7 ? 3 : (op >= 5 && op < 10 ? 2 : (op == 4 || op == 3 ? 1 : (op == 2 ? 0 : (op == 1 ? 0 : (op == 6 ? 3 : 1))))));
                const int vr = (op == 1) ? layer * 4 : ((op == 10 || op == 20) ? layer * 4 + 1 : (op == 4 ? layer * 4 + 2 : layer * 4 + 3));
                const float* part = (const float*)(ws + OFF_PARTV + (size_t)vr * PARTV_BYTES); float* partw = (float*)(ws + OFF_PARTV + (size_t)(nres + 1) * PARTV_BYTES); const int kind = J.e.kind;
                if (EN(22) && kind == 0) { EpiPlain e{(bf16_t*)(ws + J.e.o_off), J.e.ldc, J.e.bstride}; gemm_phase(lds, J.K, J.lda, J.ldb, J.s, e); }
                else if (EN(23) && kind == 1) { EpiSwiGLU e{(bf16_t*)(ws + J.e.o_off), part}; gemm_phase(lds, DM, DM, DM, J.s, e); }
                else if (EN(24) && kind == 2) { EpiResid e{p.X, XB, partw, J.e.scale, (LAS float*)(lds + LDS_X)}; gemm_phase(lds, J.K, J.K, J.K, J.s, e); }
                else if (EN(25) && kind == 3) { EpiGlaProj e{(bf16_t*)(st + ST_QK), (float*)(st + ST_GG), (bf16_t*)(st + ST_VV), (bf16_t*)(st + ST_ABUF), part, p.in[11], p.in[13], J.e.h}; gemm_phase(lds, DM, DM, DM, J.s, e); }
                else if (EN(26) && kind == 4) { EpiDilQK e{(bf16_t*)(ws + J.e.o_off), part, J.e.r}; gemm_phase(lds, DM, J.lda, DM, J.s, e); }
                else if (EN(27) && kind == 5) { EpiDilVT e{(bf16_t*)(ws + J.e.o_off), part, J.e.r}; gemm_phase(lds, DM, DM, J.ldb, J.s, e); }
                else if (EN(28) && kind == 6) { EpiScores e{(bf16_t*)(ws + J.e.o_off), part, (LAS f32x2*)(lds + LDS_X)}; gemm_phase(lds, DM, DM, DM, J.s, e); }
            }
        }
        __syncthreads();
        }
    }
}

extern "C" void kernel_launch(void* const* d_in, const int* in_sizes, int n_in, void* d_out, int out_size, void* d_ws, size_t ws_size, hipStream_t stream) {
    static int grid_blocks = 0;
    if (!grid_blocks) {
        int dev = 0, cus = 0, per_cu = 0;
        hipGetDevice(&dev);
        hipDeviceGetAttribute(&cus, hipDeviceAttributeMultiprocessorCount, dev);
        hipFuncSetAttribute((const void*)fwd_megakernel, hipFuncAttributeMaxDynamicSharedMemorySize, LDS_BYTES);
        hipOccupancyMaxActiveBlocksPerMultiprocessor(&per_cu, fwd_megakernel, 512, LDS_BYTES);
        if (per_cu < 1) per_cu = 1;
        if (per_cu > 1) per_cu = 1;
        grid_blocks = cus * per_cu;
    }
    if (n_in != 27 || ws_size < WS_NEED) { fprintf(stderr, "kernel_launch: unexpected n_in %d / ws_size %zu (need %zu)\n", n_in, ws_size, (size_t)WS_NEED); return; }
    hipMemsetAsync((char*)d_ws + OFF_CTL, 0, CTL_BYTES, stream);
    Params p{};
    for (int i = 0; i < 27; ++i) p.in[i] = (const float*)d_in[i];
    p.X = (float*)d_out; p.ws = (unsigned char*)d_ws; p.ph_lo = 0; p.ph_hi = 38;
    void* args[] = {&p};
    hipError_t e = hipLaunchCooperativeKernel((const void*)fwd_megakernel, dim3(grid_blocks), dim3(512), args, LDS_BYTES, stream);
    if (e != hipSuccess) fprintf(stderr, "cooperative launch failed: %s (grid %d)\n", hipGetErrorString(e), grid_blocks);
}
```

```cpp
#include <hip/hip_runtime.h>
#include <hip/hip_cooperative_groups.h>
#include <cstdio>
#include <cstdint>
namespace cg = cooperative_groups;

#define LAS __attribute__((address_space(3)))
typedef unsigned short bf16_t;
typedef short bf16x8 __attribute__((ext_vector_type(8)));
typedef short bf16x4 __attribute__((ext_vector_type(4)));
typedef float f32x4 __attribute__((ext_vector_type(4)));
typedef float f32x2 __attribute__((ext_vector_type(2)));
typedef unsigned u32x4 __attribute__((ext_vector_type(4)));
typedef unsigned u32x2 __attribute__((ext_vector_type(2)));

#ifndef OPMASK
#define OPMASK 0xFFFFFFFFu
#endif
#define EN(o) ((OPMASK >> (o)) & 1u)
#ifndef PROBE_REP
#define PROBE_REP 0u
#endif
#ifndef PROBE_SYNC
#define PROBE_SYNC 0
#endif
constexpr int T = 32768, DM = 1024, DFF = 2816;
constexpr float EPS = 1e-6f;
constexpr int BM = 256, BK = 64, HALF = 128, HTB = HALF * BK * 2, STAGE_BYTES = 8 * HTB, NXCD = 8, WGM = 8;
constexpr int LDS_X = STAGE_BYTES;
constexpr int LDS_BYTES = 160 * 1024;
constexpr int LDS_CTL = LDS_BYTES - 64;

constexpr size_t E_FFN1_IN = 0, E_FFN1_OUT = 5767168, E_FFN2_IN = 8650752, E_FFN2_OUT = 14417920, E_CQ = 17301504, E_CKV = 18350080,
                 E_CO = 20447232, E_MIX_IN = 21495808, E_MIX_OUT = 30932992, E_GT = 31981568, E_HM = 35127296, E_WEND = 38273024;
constexpr size_t OFF_XB = E_WEND * 2, OFF_PART = OFF_XB + (size_t)T * DM * 2, OFF_BTAB = OFF_PART + (size_t)T * 16, OFF_STAGE = OFF_BTAB + 32768;
constexpr size_t ST_HID = 0, ST_MEMN = 184549376, ST_KV = 186122240;
constexpr size_t ST_ABUF = 0, ST_QK = 67108864, ST_GG = 83886080, ST_VV = 117440512, ST_OF = 134217728, ST_OB = 167772160, ST_SLOC = 201326592, ST_DVEC = 209715200;
constexpr size_t ST_QKG = 67108864, ST_VTG = 167772160;
constexpr size_t OFF_CTL = OFF_STAGE + 218103808;
constexpr size_t CTL_BYTES = 16384;
constexpr size_t OFF_PARTV = OFF_CTL + CTL_BYTES;
constexpr size_t PARTV_BYTES = (size_t)T * 16;
constexpr size_t WS_NEED = OFF_PARTV + 9 * PARTV_BYTES;

struct Params {
    const float* in[27];
    float* X;
    unsigned char* ws;
    int ph_lo, ph_hi;
};

__device__ __forceinline__ unsigned cvt_pk_bf16(float lo, float hi) { unsigned r; asm volatile("v_cvt_pk_bf16_f32 %0, %1, %2" : "=v"(r) : "v"(lo), "v"(hi)); return r; }
__device__ __forceinline__ float bf2f(bf16_t b) { return __uint_as_float(((unsigned)b) << 16); }
__device__ __forceinline__ bf16_t f2bf(float f) { return (bf16_t)(cvt_pk_bf16(f, 0.f) & 0xffffu); }

__host__ __device__ __forceinline__ int lds_byte(int r, int c) { const int st = (r >> 4) * 2 + (c >> 5), rr = r & 15, cc = c & 31, ob = rr * 64 + cc * 2; return st * 1024 + (ob ^ (((ob >> 9) & 1) << 5)); }
__host__ __device__ __forceinline__ void stage_rc(int b, int& R, int& C) { const int st = b / 1024, sb = b % 1024, swz = sb ^ (((sb >> 9) & 1) << 5); R = (st >> 1) * 16 + swz / 64; C = (st & 1) * 32 + (swz % 64) / 2; }
__host__ __device__ __forceinline__ int perm32(int rho) { const int n = rho >> 4, i = rho & 15; return 8 * (i >> 2) + 4 * n + (i & 3); }

struct Unit { int pm, pn, b; const char* a; const char* bt; };

__device__ __forceinline__ int dil_token0(int n0, int r) {
    const int sb = n0 < 8192 ? 0 : (n0 < 16384 ? 8192 : 16384), S = n0 < 16384 ? 8192 : 16384, L = S / r;
    const int c = (n0 - sb) / L, l0 = (n0 - sb) % L;
    return sb + l0 * r + c;
}

struct Sched {
    const char* A; const char* Bt;
    int a_tile, b_tile, a_batch, b_batch, seqB;
    int nM, nN, nB, G, c, mode, r;
    __device__ __forceinline__ bool next(int i, Unit& u) const {
        const int per = nM * nN; const long tot = (long)per * nB;
        const long L = (long)i * G + c; if (L >= tot) return false;
        int b = (int)(L / per); int wgid = (int)(L % per);
        { const int q = per / NXCD, rr = per % NXCD, xcd = wgid % NXCD, off = wgid / NXCD; wgid = (xcd < rr ? xcd * (q + 1) : rr * (q + 1) + (xcd - rr) * q) + off; }
        const int nig = WGM * nN, gid = wgid / nig, fm = gid * WGM, gsz = (nM - fm) < WGM ? (nM - fm) : WGM;
        u.pm = fm + ((wgid % nig) % gsz); u.pn = (wgid % nig) / gsz; u.b = b;
        const char* a = A + (long)b * a_batch; const char* bt = Bt + (long)b * b_batch;
        if (mode == 2) a += (long)dil_token0(u.pm * 256, r) * (DM * 2); else a += (long)u.pm * a_tile;
        if (mode == 3) bt += (long)dil_token0(u.pn * 256, r) * (DM * 2); else bt += (long)u.pn * b_tile;
        if (mode == 1) { const int s = u.pm < 32 ? 0 : (u.pm < 64 ? 1 : 2); bt += (long)s * seqB; }
        u.a = a; u.bt = bt; return true;
    }
};


typedef unsigned long long u64_t;
__device__ __forceinline__ float ldsys_f(const float* p) { return __hip_atomic_load(p, __ATOMIC_RELAXED, __HIP_MEMORY_SCOPE_SYSTEM); }
__device__ __forceinline__ bf16_t ldsys_h(const bf16_t* p) { return __hip_atomic_load(p, __ATOMIC_RELAXED, __HIP_MEMORY_SCOPE_SYSTEM); }
__device__ __forceinline__ u32x2 ld_sys8(const void* p) {
    const u64_t a = __hip_atomic_load((const u64_t*)p, __ATOMIC_RELAXED, __HIP_MEMORY_SCOPE_SYSTEM); return (u32x2){(unsigned)a, (unsigned)(a >> 32)};
}
__device__ __forceinline__ u32x4 ld_sys16u(const void* p) {
    const u64_t* q = (const u64_t*)p;
    const u64_t a = __hip_atomic_load(q, __ATOMIC_RELAXED, __HIP_MEMORY_SCOPE_SYSTEM), b = __hip_atomic_load(q + 1, __ATOMIC_RELAXED, __HIP_MEMORY_SCOPE_SYSTEM);
    return (u32x4){(unsigned)a, (unsigned)(a >> 32), (unsigned)b, (unsigned)(b >> 32)};
}
__device__ __forceinline__ bf16x8 ld_sys16(const void* p) { return __builtin_bit_cast(bf16x8, ld_sys16u(p)); }
__device__ __forceinline__ f32x4 ld_sys16f(const void* p) { return __builtin_bit_cast(f32x4, ld_sys16u(p)); }

__device__ __forceinline__ float rstd_of(const float* part, int row) {
    const f32x4 p = *(const f32x4*)(part + (size_t)row * 4);
    return rsqrtf(((p[0] + p[1]) + (p[2] + p[3])) * (1.0f / 1024.0f) + EPS);
}


__device__ __forceinline__ void rstd8(const float* part, int row0, float (&rs)[8]) {
    f32x4 pp[8];
#pragma unroll
    for (int i = 0; i < 8; ++i) pp[i] = *(const f32x4*)(part + (size_t)(row0 + (i >> 2) * 128 + (i & 3) * 16) * 4);
#pragma unroll
    for (int i = 0; i < 8; ++i) rs[i] = rsqrtf(((pp[i][0] + pp[i][1]) + (pp[i][2] + pp[i][3])) * (1.0f / 1024.0f) + EPS);
}

#define LBAR() do { asm volatile("s_waitcnt lgkmcnt(0)" ::: "memory"); __builtin_amdgcn_s_barrier(); asm volatile("" ::: "memory"); } while (0)

struct EpiPlain {
    bf16_t* O; int ldc; int bstride;
    __device__ __forceinline__ void operator()(const f32x4 (&acc)[2][2][4][2], const Unit& u, int wr, int wc, int fr, int fq) const {
        bf16_t* base = O + (long)u.b * bstride;
#pragma unroll
        for (int ai = 0; ai < 2; ++ai)
#pragma unroll
            for (int m = 0; m < 4; ++m) { const int row = u.pm * 256 + ai * 128 + wr * 64 + m * 16 + fr;
#pragma unroll
                for (int bj = 0; bj < 2; ++bj) { const int col = u.pn * 256 + bj * 128 + wc * 32 + 8 * fq;
                    const f32x4 v0 = acc[ai][bj][m][0], v1 = acc[ai][bj][m][1];
                    u32x4 w; w.x = cvt_pk_bf16(v0[0], v0[1]); w.y = cvt_pk_bf16(v0[2], v0[3]); w.z = cvt_pk_bf16(v1[0], v1[1]); w.w = cvt_pk_bf16(v1[2], v1[3]);
                    *(u32x4*)(base + (long)row * ldc + col) = w; } }
    }
};
struct EpiSwiGLU {
    bf16_t* H; const float* part;
    __device__ __forceinline__ void operator()(const f32x4 (&acc)[2][2][4][2], const Unit& u, int wr, int wc, int fr, int fq) const {
        float rs8[8]; rstd8(part, u.pm * 256 + wr * 64 + fr, rs8);
#pragma unroll
        for (int ai = 0; ai < 2; ++ai)
#pragma unroll
            for (int m = 0; m < 4; ++m) { const int row = u.pm * 256 + ai * 128 + wr * 64 + m * 16 + fr; const float rs = rs8[ai * 4 + m];
                float h[8];
#pragma unroll
                for (int n = 0; n < 2; ++n)
#pragma unroll
                    for (int j = 0; j < 4; ++j) { const float a = acc[ai][0][m][n][j] * rs, b = acc[ai][1][m][n][j] * rs; h[n * 4 + j] = a * b * __builtin_amdgcn_rcpf(1.0f + __expf(-a)); }
                u32x4 w; w.x = cvt_pk_bf16(h[0], h[1]); w.y = cvt_pk_bf16(h[2], h[3]); w.z = cvt_pk_bf16(h[4], h[5]); w.w = cvt_pk_bf16(h[6], h[7]);
                *(u32x4*)(H + (long)row * DFF + u.pn * 128 + wc * 32 + 8 * fq) = w; }
    }
};
struct EpiResid {
    float* X; bf16_t* XB; float* part; float scale; LAS float* xt;
    __device__ __forceinline__ void operator()(const f32x4 (&acc)[2][2][4][2], const Unit& u, int wr, int wc, int fr, int fq) const {
#pragma unroll
        for (int ai = 0; ai < 2; ++ai) {
            f32x4 xv[4][2][2];
#pragma unroll
            for (int m = 0; m < 4; ++m)
#pragma unroll
                for (int bj = 0; bj < 2; ++bj) { const float* xp = X + ((long)u.pm * 256 + ai * 128 + wr * 64 + m * 16 + fr) * DM + u.pn * 256 + bj * 128 + wc * 32 + 8 * fq;
                    xv[m][bj][0] = *(const f32x4*)xp; xv[m][bj][1] = *(const f32x4*)(xp + 4); }
#pragma unroll
            for (int m = 0; m < 4; ++m) { const int rl = ai * 128 + wr * 64 + m * 16 + fr; const long row = (long)u.pm * 256 + rl; float ss = 0.f;
#pragma unroll
                for (int bj = 0; bj < 2; ++bj) { const int col = u.pn * 256 + bj * 128 + wc * 32 + 8 * fq;
                    float* xp = X + row * DM + col;
                    const f32x4 x0 = xv[m][bj][0] + acc[ai][bj][m][0] * scale, x1 = xv[m][bj][1] + acc[ai][bj][m][1] * scale;
                    *(f32x4*)xp = x0; *(f32x4*)(xp + 4) = x1;
                    u32x4 w; w.x = cvt_pk_bf16(x0[0], x0[1]); w.y = cvt_pk_bf16(x0[2], x0[3]); w.z = cvt_pk_bf16(x1[0], x1[1]); w.w = cvt_pk_bf16(x1[2], x1[3]);
                    *(u32x4*)(XB + row * DM + col) = w;
                    ss += (x0[0] * x0[0] + x0[1] * x0[1]) + (x0[2] * x0[2] + x0[3] * x0[3]) + (x1[0] * x1[0] + x1[1] * x1[1]) + (x1[2] * x1[2] + x1[3] * x1[3]); }
                ss += __shfl_xor(ss, 16); ss += __shfl_xor(ss, 32);
                if (fq == 0) xt[rl * 4 + wc] = ss; }
            asm volatile("" ::: "memory");
        }
        LBAR();
        const int lane = fq * 16 + fr;
        if (lane < 32) { const int q = wc * 32 + lane, rl = (q >> 6) * 128 + wr * 64 + (q & 63);
            const f32x4 s = *(const LAS f32x4*)(xt + rl * 4);
            part[((size_t)u.pm * 256 + rl) * 4 + u.pn] = (s[0] + s[1]) + (s[2] + s[3]); }
    }
};
struct EpiGlaProj {
    bf16_t* QK; float* GG; bf16_t* VV; bf16_t* AB; const float* part; const float* bgf; const float* bgb; int h;
    __device__ __forceinline__ void operator()(const f32x4 (&acc)[2][2][4][2], const Unit& u, int wr, int wc, int fr, int fq) const {
        float rs8[8]; rstd8(part, u.pm * 256 + wr * 64 + fr, rs8);
#pragma unroll
        for (int ai = 0; ai < 2; ++ai)
#pragma unroll
            for (int m = 0; m < 4; ++m) { const long row = (long)u.pm * 256 + ai * 128 + wr * 64 + m * 16 + fr; const float rs = rs8[ai * 4 + m];
#pragma unroll
                for (int bj = 0; bj < 2; ++bj) { const int col = bj * 128 + wc * 32 + 8 * fq;
                    f32x4 v0 = acc[ai][bj][m][0] * rs, v1 = acc[ai][bj][m][1] * rs;
                    if (u.pn == 1) {
                        const float* bp = (bj == 0 ? bgf : bgb) + h * 128 + wc * 32 + 8 * fq;
                        const f32x4 b0 = *(const f32x4*)bp, b1 = *(const f32x4*)(bp + 4);
#pragma unroll
                        for (int j = 0; j < 4; ++j) { float z = v0[j] + b0[j]; v0[j] = (fminf(z, 0.f) - __logf(1.0f + __expf(-fabsf(z)))) * (1.0f / 16.0f);
                                                      z = v1[j] + b1[j]; v1[j] = (fminf(z, 0.f) - __logf(1.0f + __expf(-fabsf(z)))) * (1.0f / 16.0f); }
                        float* gp = GG + row * 256 + col; *(f32x4*)gp = v0; *(f32x4*)(gp + 4) = v1;
                    } else {
                        if (u.pn == 3) {
#pragma unroll
                            for (int j = 0; j < 4; ++j) { v0[j] = v0[j] * __builtin_amdgcn_rcpf(1.0f + __expf(-v0[j])); v1[j] = v1[j] * __builtin_amdgcn_rcpf(1.0f + __expf(-v1[j])); } }
                        u32x4 w; w.x = cvt_pk_bf16(v0[0], v0[1]); w.y = cvt_pk_bf16(v0[2], v0[3]); w.z = cvt_pk_bf16(v1[0], v1[1]); w.w = cvt_pk_bf16(v1[2], v1[3]);
                        bf16_t* dst = u.pn == 0 ? QK + row * 256 + col : (u.pn == 2 ? VV + row * 256 + col : AB + row * DM + h * 256 + col);
                        *(u32x4*)dst = w; } } }
    }
};
struct EpiDilQK {
    bf16_t* O; const float* part; int r;
    __device__ __forceinline__ void operator()(const f32x4 (&acc)[2][2][4][2], const Unit& u, int wr, int wc, int fr, int fq) const {
        const int tok0 = dil_token0(u.pm * 256, r);
        float rs8[8];
        { f32x4 pp[8];
#pragma unroll
          for (int i = 0; i < 8; ++i) pp[i] = *(const f32x4*)(part + (size_t)(tok0 + ((i >> 2) * 128 + wr * 64 + (i & 3) * 16 + fr) * r) * 4);
#pragma unroll
          for (int i = 0; i < 8; ++i) rs8[i] = rsqrtf(((pp[i][0] + pp[i][1]) + (pp[i][2] + pp[i][3])) * (1.0f / 1024.0f) + EPS); }
#pragma unroll
        for (int ai = 0; ai < 2; ++ai)
#pragma unroll
            for (int m = 0; m < 4; ++m) { const int rl = ai * 128 + wr * 64 + m * 16 + fr; const long row = (long)u.pm * 256 + rl; const float rs = rs8[ai * 4 + m];
#pragma unroll
                for (int bj = 0; bj < 2; ++bj) { const int col = u.pn * 256 + bj * 128 + wc * 32 + 8 * fq;
                    const f32x4 v0 = acc[ai][bj][m][0] * rs, v1 = acc[ai][bj][m][1] * rs;
                    u32x4 w; w.x = cvt_pk_bf16(v0[0], v0[1]); w.y = cvt_pk_bf16(v0[2], v0[3]); w.z = cvt_pk_bf16(v1[0], v1[1]); w.w = cvt_pk_bf16(v1[2], v1[3]);
                    { const int kc = bj * 128 + wc * 32 + 8 * fq;
                      *(u32x4*)(O + (size_t)u.pn * T * 256 + (size_t)((row >> 5) * 16 + (kc >> 6) * 4 + ((kc & 63) >> 4)) * 512 + (row & 31) * 16 + (kc & 8)) = w; } }
                asm volatile("" ::: "memory"); }
    }
};
struct EpiDilVT {
    bf16_t* O; const float* part; int r;
    __device__ __forceinline__ void operator()(const f32x4 (&acc)[2][2][4][2], const Unit& u, int wr, int wc, int fr, int fq) const {
        const int tok0 = dil_token0(u.pn * 256, r);
#pragma unroll
        for (int bj = 0; bj < 2; ++bj) { const int cl = bj * 128 + wc * 32 + 8 * fq; float rs[8];
#pragma unroll
            for (int j = 0; j < 8; ++j) rs[j] = rstd_of(part, tok0 + (cl + j) * r);
#pragma unroll
            for (int ai = 0; ai < 2; ++ai)
#pragma unroll
                for (int m = 0; m < 4; ++m) { const int row = ai * 128 + wr * 64 + m * 16 + fr;
                    const f32x4 v0 = acc[ai][bj][m][0], v1 = acc[ai][bj][m][1];
                    u32x4 w; w.x = cvt_pk_bf16(v0[0] * rs[0], v0[1] * rs[1]); w.y = cvt_pk_bf16(v0[2] * rs[2], v0[3] * rs[3]);
                    w.z = cvt_pk_bf16(v1[0] * rs[4], v1[1] * rs[5]); w.w = cvt_pk_bf16(v1[2] * rs[6], v1[3] * rs[7]);
                    { const int n_ = u.pn * 256 + cl; *(u32x4*)(O + (size_t)(n_ >> 5) * 8192 + row * 32 + (n_ & 31)) = w; }
                    asm volatile("" ::: "memory"); } }
    }
};
struct EpiScores {
    bf16_t* P; const float* part; LAS f32x2* xt;
    __device__ __forceinline__ void operator()(const f32x4 (&acc)[2][2][4][2], const Unit& u, int wr, int wc, int fr, int fq) const {
        float rs8[8]; rstd8(part, u.pm * 256 + wr * 64 + fr, rs8);
#pragma unroll
        for (int ai = 0; ai < 2; ++ai)
#pragma unroll
            for (int m = 0; m < 4; ++m) { const int rl = ai * 128 + wr * 64 + m * 16 + fr; const float r_ = rs8[ai * 4 + m];
                float mx = -3.0e38f;
#pragma unroll
                for (int bj = 0; bj < 2; ++bj)
#pragma unroll
                    for (int n = 0; n < 2; ++n)
#pragma unroll
                        for (int j = 0; j < 4; ++j) mx = fmaxf(mx, acc[ai][bj][m][n][j] * r_);
                mx = fmaxf(mx, __shfl_xor(mx, 16)); mx = fmaxf(mx, __shfl_xor(mx, 32));
                float l = 0.f;
#pragma unroll
                for (int bj = 0; bj < 2; ++bj)
#pragma unroll
                    for (int n = 0; n < 2; ++n)
#pragma unroll
                        for (int j = 0; j < 4; ++j) l += __expf(acc[ai][bj][m][n][j] * r_ - mx);
                l += __shfl_xor(l, 16); l += __shfl_xor(l, 32);
                if (fq == 0) xt[rl * 4 + wc] = (f32x2){mx, l};
                asm volatile("" ::: "memory"); }
        LBAR();
#pragma unroll
        for (int ai = 0; ai < 2; ++ai)
#pragma unroll
            for (int m = 0; m < 4; ++m) { const int rl = ai * 128 + wr * 64 + m * 16 + fr; const long row = (long)u.pm * 256 + rl; const float r_ = rs8[ai * 4 + m];
                const f32x2 a = xt[rl * 4 + 0], b = xt[rl * 4 + 1], c = xt[rl * 4 + 2], d = xt[rl * 4 + 3];
                const float M = fmaxf(fmaxf(a.x, b.x), fmaxf(c.x, d.x));
                const float Ls = a.y * __expf(a.x - M) + b.y * __expf(b.x - M) + c.y * __expf(c.x - M) + d.y * __expf(d.x - M);
                const float inv = __builtin_amdgcn_rcpf(Ls);
#pragma unroll
                for (int bj = 0; bj < 2; ++bj) { const int col = u.pn * 256 + bj * 128 + wc * 32 + 8 * fq; float p[8];
#pragma unroll
                    for (int n = 0; n < 2; ++n)
#pragma unroll
                        for (int j = 0; j < 4; ++j) p[n * 4 + j] = __expf(acc[ai][bj][m][n][j] * r_ - M) * inv;
                    u32x4 w; w.x = cvt_pk_bf16(p[0], p[1]); w.y = cvt_pk_bf16(p[2], p[3]); w.z = cvt_pk_bf16(p[4], p[5]); w.w = cvt_pk_bf16(p[6], p[7]);
                    *(u32x4*)(P + row * DM + col) = w; }
                asm volatile("" ::: "memory"); }
    }
};


struct EpiAny {
    int kind;
    long o_off;
    int ldc, bstride; float scale; int h, r;
    __device__ __forceinline__ void operator()(const f32x4 (&acc)[2][2][4][2], const Unit& u, int wr, int wc, int fr, int fq, const Params& p, LAS unsigned char* lds) const {
        unsigned char* ws = p.ws; unsigned char* st = ws + OFF_STAGE; const float* part = (const float*)(ws + OFF_PART);
        if (EN(22) && kind == 0) { EpiPlain e{(bf16_t*)(ws + o_off), ldc, bstride}; e(acc, u, wr, wc, fr, fq); }
        else if (EN(23) && kind == 1) { EpiSwiGLU e{(bf16_t*)(ws + o_off), part}; e(acc, u, wr, wc, fr, fq); }
        else if (EN(24) && kind == 2) { EpiResid e{p.X, (bf16_t*)(ws + OFF_XB), (float*)(ws + OFF_PART), scale, (LAS float*)(lds + LDS_X)}; e(acc, u, wr, wc, fr, fq); }
        else if (EN(25) && kind == 3) { EpiGlaProj e{(bf16_t*)(st + ST_QK), (float*)(st + ST_GG), (bf16_t*)(st + ST_VV), (bf16_t*)(st + ST_ABUF), part, p.in[11], p.in[13], h}; e(acc, u, wr, wc, fr, fq); }
        else if (EN(26) && kind == 4) { EpiDilQK e{(bf16_t*)(ws + o_off), part, r}; e(acc, u, wr, wc, fr, fq); }
        else if (EN(27) && kind == 5) { EpiDilVT e{(bf16_t*)(ws + o_off), part, r}; e(acc, u, wr, wc, fr, fq); }
        else if (EN(28)) { EpiScores e{(bf16_t*)(ws + o_off), part, (LAS f32x2*)(lds + LDS_X)}; e(acc, u, wr, wc, fr, fq); }
    }
};

template <class Epi>
__device__ __forceinline__ void gemm_phase(LAS unsigned char* lds, const int K, const int lda, const int ldb, const Sched& S, const Epi& E) {
    int tid = threadIdx.x; asm volatile("" : "+v"(tid));
    const int wid = __builtin_amdgcn_readfirstlane(tid >> 6), lane = tid & 63, wr = wid >> 2, wc = wid & 3, fr = lane & 15, fq = lane >> 4;
    const int nt = K / BK;
    unsigned voffA[2], voffB[2];
#pragma unroll
    for (int i = 0; i < 2; ++i) { int R, C; stage_rc(tid * 16 + i * 8192, R, C); const int Rb = (R & ~31) + perm32(R & 31);
        voffA[i] = (unsigned)(R * lda + C) * 2u; voffB[i] = (unsigned)(Rb * ldb + C) * 2u; }
    const size_t kstep = (size_t)(BK * 2);
    const size_t hstepA = (size_t)HALF * lda * 2, hstepB = (size_t)HALF * ldb * 2;
    const unsigned ldsw = (unsigned)wid * 1024u;
    const int aoff = lds_byte(wr * 64 + fr, fq * 8), boff = lds_byte(wc * 32 + fr, fq * 8);
#define PG8_SA(b, h) (((b) * 2 + (h)) * HTB)
#define PG8_SB(b, h) ((4 + (b) * 2 + (h)) * HTB)
#define PG8_STAGE(bufoff, gbase, voff) do { _Pragma("unroll") for (int _i = 0; _i < 2; ++_i) \
        __builtin_amdgcn_global_load_lds((const unsigned*)((const char*)(gbase) + (voff)[_i]), (LAS unsigned*)(lds + (bufoff) + ldsw + _i * 8192), 16, 0, 0); } while (0)
#define PG8_LDA(dst, b, h) do { _Pragma("unroll") for (int m = 0; m < 4; ++m) _Pragma("unroll") for (int k = 0; k < 2; ++k) dst[m][k] = *(const LAS bf16x8*)(lds + PG8_SA(b, h) + aoff + m * 2048 + k * 1024); } while (0)
#define PG8_LDB(dst, b, h) do { _Pragma("unroll") for (int n = 0; n < 2; ++n) _Pragma("unroll") for (int k = 0; k < 2; ++k) dst[n][k] = *(const LAS bf16x8*)(lds + PG8_SB(b, h) + boff + n * 2048 + k * 1024); } while (0)
#define PG8_MMA(ai, bj, At, Bt) do { __builtin_amdgcn_s_setprio(1); _Pragma("unroll") for (int m = 0; m < 4; ++m) _Pragma("unroll") for (int n = 0; n < 2; ++n) _Pragma("unroll") for (int k = 0; k < 2; ++k) \
        acc[ai][bj][m][n] = __builtin_amdgcn_mfma_f32_16x16x32_bf16(Bt[n][k], At[m][k], acc[ai][bj][m][n], 0, 0, 0); __builtin_amdgcn_s_setprio(0); } while (0)
#define PG8_WAIT_V(n) asm volatile("s_waitcnt vmcnt(" #n ")" ::: "memory")
#define PG8_WAIT_L(n) asm volatile("s_waitcnt lgkmcnt(" #n ")" ::: "memory")
#define PG8_BAR __builtin_amdgcn_s_barrier()
#define PG8_SCHED __builtin_amdgcn_sched_barrier(0)
    Unit cur, nxt; int ui = 0;
    if (!S.next(0, cur)) return;
    f32x4 acc[2][2][4][2];
#pragma unroll
    for (int a = 0; a < 2; ++a)
#pragma unroll
        for (int b = 0; b < 2; ++b)
#pragma unroll
            for (int m = 0; m < 4; ++m)
#pragma unroll
                for (int n = 0; n < 2; ++n) acc[a][b][m][n] = (f32x4){0.f, 0.f, 0.f, 0.f};
    bf16x8 At[4][2], B0[2][2], B1[2][2];
    const char* cA = cur.a; const char* cB = cur.bt;
    PG8_STAGE(PG8_SB(0, 0), cB, voffB); PG8_STAGE(PG8_SA(0, 0), cA, voffA); PG8_STAGE(PG8_SB(0, 1), cB + hstepB, voffB); PG8_STAGE(PG8_SA(0, 1), cA + hstepA, voffA);
    if (wr == 1) PG8_BAR;
    PG8_WAIT_V(4); PG8_BAR;
    PG8_STAGE(PG8_SB(1, 0), cB + kstep, voffB); PG8_STAGE(PG8_SA(1, 0), cA + kstep, voffA); PG8_STAGE(PG8_SB(1, 1), cB + hstepB + kstep, voffB);
    PG8_WAIT_V(6); PG8_BAR;
    for (;;) {
        const bool has_next = S.next(ui + 1, nxt);
        const char* nA = has_next ? nxt.a : cA; const char* nB = has_next ? nxt.bt : cB;
        for (int t = 0; t < nt; t += 2) {
            const bool last = (t == nt - 2);
            const char* a1 = cA + (size_t)(t + 1) * kstep;
            const char* a2 = last ? nA : cA + (size_t)(t + 2) * kstep; const char* b2 = last ? nB : cB + (size_t)(t + 2) * kstep;
            const char* a3 = a2 + kstep; const char* b3 = b2 + kstep;
            PG8_LDB(B0, 0, 0); PG8_SCHED; PG8_LDA(At, 0, 0); PG8_STAGE(PG8_SA(1, 1), a1 + hstepA, voffA);
            PG8_WAIT_L(8); PG8_BAR; PG8_WAIT_L(0); PG8_MMA(0, 0, At, B0); PG8_BAR; PG8_SCHED;
            PG8_LDB(B1, 0, 1); PG8_STAGE(PG8_SB(0, 0), b2, voffB);
            PG8_BAR; PG8_WAIT_L(0); PG8_MMA(0, 1, At, B1); PG8_BAR;
            PG8_LDA(At, 0, 1); PG8_STAGE(PG8_SA(0, 0), a2, voffA);
            PG8_BAR; PG8_WAIT_L(0); PG8_MMA(1, 0, At, B0); PG8_BAR; PG8_SCHED;
            PG8_STAGE(PG8_SB(0, 1), b2 + hstepB, voffB);
            PG8_WAIT_V(6); PG8_BAR; PG8_MMA(1, 1, At, B1); PG8_BAR;
            PG8_LDB(B0, 1, 0); PG8_SCHED; PG8_LDA(At, 1, 0); PG8_STAGE(PG8_SA(0, 1), a2 + hstepA, voffA);
            PG8_WAIT_L(8); PG8_BAR; PG8_WAIT_L(0); PG8_MMA(0, 0, At, B0); PG8_BAR; PG8_SCHED;
            PG8_LDB(B1, 1, 1); PG8_STAGE(PG8_SB(1, 0), b3, voffB);
            PG8_BAR; PG8_WAIT_L(0); PG8_MMA(0, 1, At, B1); PG8_BAR;
            PG8_LDA(At, 1, 1); PG8_STAGE(PG8_SA(1, 0), a3, voffA);
            PG8_BAR; PG8_WAIT_L(0); PG8_MMA(1, 0, At, B0); PG8_BAR; PG8_SCHED;
            PG8_STAGE(PG8_SB(1, 1), b3 + hstepB, voffB);
            PG8_WAIT_V(6); PG8_BAR; PG8_MMA(1, 1, At, B1); PG8_BAR;
        }
        { int t2 = threadIdx.x; asm volatile("" : "+v"(t2)); const int w2 = __builtin_amdgcn_readfirstlane(t2 >> 6), l2 = t2 & 63;
          E(acc, cur, w2 >> 2, w2 & 3, l2 & 15, l2 >> 4); }
        if (!has_next) break;
#pragma unroll
        for (int a = 0; a < 2; ++a)
#pragma unroll
            for (int b = 0; b < 2; ++b)
#pragma unroll
                for (int m = 0; m < 4; ++m)
#pragma unroll
                    for (int n = 0; n < 2; ++n) acc[a][b][m][n] = (f32x4){0.f, 0.f, 0.f, 0.f};
        cur = nxt; cA = nA; cB = nB; ++ui;
    }
    PG8_WAIT_V(0);
    if (wr == 0) PG8_BAR;
    PG8_BAR;
#undef PG8_SA
#undef PG8_SB
#undef PG8_STAGE
#undef PG8_LDA
#undef PG8_LDB
#undef PG8_MMA
#undef PG8_WAIT_V
#undef PG8_WAIT_L
#undef PG8_BAR
#undef PG8_SCHED
}

__device__ __forceinline__ Sched mk_sched(const void* A, const void* Bt, int M, int N, int lda, int ldb, int rot) {
    Sched s; s.A = (const char*)A; s.Bt = (const char*)Bt; s.a_tile = 256 * lda * 2; s.b_tile = 256 * ldb * 2; s.a_batch = 0; s.b_batch = 0; s.seqB = 0;
    s.nM = M / 256; s.nN = N / 256; s.nB = 1; s.G = gridDim.x; s.c = (int)((blockIdx.x + (unsigned)rot) % gridDim.x); s.mode = 0; s.r = 1; return s;
}


struct GemmJob { int K, lda, ldb; Sched s; EpiAny e; };
__device__ __forceinline__ int rotc(int rot) { return (int)((blockIdx.x + gridDim.x - ((unsigned)rot % gridDim.x)) % gridDim.x); }
__device__ __forceinline__ bool get_job(const Params& p, int op, int arg, int j, GemmJob& J) {
    unsigned char* ws = p.ws; bf16_t* WB = (bf16_t*)ws; bf16_t* XB = (bf16_t*)(ws + OFF_XB); unsigned char* st = ws + OFF_STAGE;
    EpiAny e; e.kind = 0; e.o_off = 0; e.ldc = DM; e.bstride = 0; e.scale = 1.0f; e.h = 0; e.r = 1;
    J.K = DM; J.lda = DM; J.ldb = DM;
    if (op == 1) {
        if (j == 0) { J.s = mk_sched(st + ST_MEMN, WB + E_CKV, 768, 2048, DM, DM, 0); e.o_off = OFF_STAGE + ST_KV; e.ldc = 2048; }
        else if (j == 1) { J.s = mk_sched(XB, WB + E_FFN1_IN, T, 2 * DFF, DM, DM, 0); J.s.c = rotc(24); e.kind = 1; e.o_off = OFF_STAGE + ST_HID; }
        else return false;
    } else if (op == 2) {
        if (j == 0) { J.s = mk_sched(st + ST_HID, WB + E_FFN1_OUT, T, DM, DFF, DFF, 0); J.K = DFF; J.lda = DFF; J.ldb = DFF; e.kind = 2; e.scale = 0.5f; }
        else if (j <= 3) { const int sq = j - 1;
            J.s = mk_sched((const char*)(st + ST_KV) + (size_t)sq * 256 * 2048 * 2, WB + E_CQ, 256, 1024, 2048, DM, 0); J.s.nB = 4; J.s.a_batch = 512; J.s.b_batch = 512; J.s.c = rotc(sq * 16);
            J.K = 256; J.lda = 2048; J.ldb = DM; e.o_off = (E_GT + (size_t)sq * DM * DM) * 2; e.ldc = DM; e.bstride = 256 * DM; }
        else if (j <= 6) { const int sq = j - 4;
            J.s = mk_sched(WB + E_CO, (const char*)(st + ST_KV) + (size_t)sq * 256 * 2048 * 2 + 1024 * 2, 1024, 256, DM, 2048, 0); J.s.nB = 4; J.s.a_batch = 512; J.s.b_batch = 512; J.s.c = rotc(48 + sq * 16);
            J.K = 256; J.lda = DM; J.ldb = 2048; e.o_off = (E_HM + (size_t)sq * DM * DM) * 2; e.ldc = DM; e.bstride = 256; }
        else return false;
    } else if (op == 3) { if (j) return false; J.s = mk_sched(st + ST_ABUF, WB + E_MIX_OUT, T, DM, DM, DM, 0); e.kind = 2; }
    else if (op == 4) { if (j) return false; J.s = mk_sched(XB, WB + E_GT, T, DM, DM, DM, 0); J.s.mode = 1; J.s.seqB = DM * DM * 2; e.kind = 6; e.o_off = OFF_STAGE + ST_ABUF; }
    else if (op == 5) { if (j) return false; J.s = mk_sched(st + ST_ABUF, WB + E_HM, T, DM, DM, DM, 0); J.s.mode = 1; J.s.seqB = DM * DM * 2; e.kind = 2; }
    else if (op == 6) { if (j) return false; J.s = mk_sched(XB, WB + E_FFN2_IN, T, 2 * DFF, DM, DM, 0); e.kind = 1; e.o_off = OFF_STAGE + ST_HID; }
    else if (op == 7) { if (j) return false; J.s = mk_sched(st + ST_HID, WB + E_FFN2_OUT, T, DM, DFF, DFF, 0); J.K = DFF; J.lda = DFF; J.ldb = DFF; e.kind = 2; e.scale = 0.5f; }
    else if (op == 10) { if (j) return false; J.s = mk_sched(XB, WB + E_MIX_IN + (size_t)arg * 1024 * DM, T, 1024, DM, DM, 0); e.kind = 3; e.h = arg; }
    else if (op == 20) { if (j >= 6) return false; const int g = j >> 1, r = g == 0 ? 1 : (g == 1 ? 4 : 16); e.r = r;
        if ((j & 1) == 0) { J.s = mk_sched(XB, WB + E_MIX_IN + (size_t)(arg * 2304 + g * 512) * DM, T, 512, r * DM, DM, 0); J.s.mode = 2; J.s.r = r; J.s.c = rotc(g * 384);
            J.lda = r * DM; e.kind = 4; e.o_off = OFF_STAGE + ST_QKG + (size_t)g * T * 512 * 2; }
        else { J.s = mk_sched(WB + E_MIX_IN + (size_t)(arg * 2304 + 1536 + g * 256) * DM, XB, 256, T, DM, r * DM, 0); J.s.mode = 3; J.s.r = r; J.s.c = rotc(g * 384 + 256);
            J.ldb = r * DM; e.kind = 5; e.o_off = OFF_STAGE + ST_VTG + (size_t)g * 256 * T * 2; } }
    else return false;
    J.e = e; return true;
}

template <int NT>
__device__ __forceinline__ void conv_tiles(const float* src, int ld_src, const int (&k0)[NT], const int (&n0)[NT], bf16_t* dst, int ld_dst, const int (&dr0)[NT], const float* gain,
                                           const float (&scale)[NT], int nvalid, LAS float* tile) {
    int tid = threadIdx.x; asm volatile("" : "+v"(tid)); const int tx = tid & 63, ty = tid >> 6;
    float v[NT][8];
#pragma unroll
    for (int t = 0; t < NT; ++t) if (t < nvalid) {
#pragma unroll
        for (int i = 0; i < 8; ++i) v[t][i] = src[(size_t)(k0[t] + ty + 8 * i) * ld_src + n0[t] + tx];
    }
#pragma unroll
    for (int t = 0; t < NT; ++t) if (t < nvalid) {
#pragma unroll
        for (int i = 0; i < 8; ++i) { float x = v[t][i] * scale[t]; if (gain) x *= gain[k0[t] + ty + 8 * i]; tile[t * 4160 + (ty + 8 * i) * 65 + tx] = x; }
    }
    __syncthreads();
    const int i2 = tid & 31;
#pragma unroll
    for (int t = 0; t < NT; ++t) if (t < nvalid) {
#pragma unroll
        for (int jj = 0; jj < 4; ++jj) { const int j = (tid >> 5) + 16 * jj; const float a = tile[t * 4160 + (2 * i2) * 65 + j], b = tile[t * 4160 + (2 * i2 + 1) * 65 + j];
            *(unsigned*)(dst + (size_t)(dr0[t] + j) * ld_dst + k0[t] + 2 * i2) = cvt_pk_bf16(a, b); }
    }
    __syncthreads();
}
__device__ __forceinline__ int map_row(int kind, int n0, float& scale) {
    scale = 1.0f;
    if (EN(23) && kind == 1) { if (n0 < DFF) return (n0 / 128) * 256 + (n0 % 128); const int j = n0 - DFF; return (j / 128) * 256 + 128 + (j % 128); }
    if (EN(24) && kind == 2) {
        if (n0 < 512) { scale = 0.08838834764831845f; return (n0 / 128) * 1024 + (n0 % 128); }
        if (n0 < 1024) { const int j = n0 - 512; return (j / 128) * 1024 + 128 + (j % 128); }
        if (n0 < 2048) { const int j = n0 - 1024; return (j / 256) * 1024 + 512 + (j % 256); }
        const int j = n0 - 2048; return (j / 256) * 1024 + 768 + (j % 256);
    }
    if (EN(25) && kind == 3) { const int tg = n0 / 1024, h = (n0 % 1024) / 64, t = tg / 3, g = tg % 3, hc = h >> 2, hl = h & 3;
        if (t == 0) scale = 0.125f;
        if (t < 2) return hc * 2304 + g * 512 + t * 256 + hl * 64;
        return hc * 2304 + 1536 + g * 256 + hl * 64; }
    return n0;
}
__device__ __forceinline__ void conv_weight(const float* src, int K, int N, int ld_src, bf16_t* dst, const float* gain, int kind, LAS float* tile, int& rot) {
    constexpr int NT = 4;
    const int nk = K / 64, nn = N / 64, tot = nk * nn, G = gridDim.x;
    for (int t0 = (int)((blockIdx.x + G - (rot % G)) % G); t0 < tot; t0 += G * NT) {
        int k0[NT], n0[NT], dr0[NT]; float sc[NT]; int nvalid = 0;
#pragma unroll
        for (int j = 0; j < NT; ++j) { const int t = t0 + j * G; const bool ok = t < tot; const int tt = ok ? t : t0; const int kt = tt % nk, ntile = tt / nk;
            k0[j] = kt * 64; n0[j] = ntile * 64; dr0[j] = map_row(kind, ntile * 64, sc[j]); nvalid += ok ? 1 : 0; }
        conv_tiles<NT>(src, ld_src, k0, n0, dst, K, dr0, gain, sc, nvalid, tile);
    }
    rot += tot;
}
__device__ __forceinline__ const float* x_in_row(const Params& p, int t) { return t < 16384 ? p.in[0] + (size_t)t * DM : p.in[1] + (size_t)(t - 16384) * DM; }

__device__ __forceinline__ void phase_prologue(const Params& p, int layer, LAS unsigned char* lds) {
    unsigned char* ws = p.ws; bf16_t* WB = (bf16_t*)ws; LAS float* tile = (LAS float*)lds;
    int tid = threadIdx.x; asm volatile("" : "+v"(tid)); const int lane = tid & 63, wid = tid >> 6, nwv = gridDim.x * 8, gw = blockIdx.x * 8 + wid;
    int rot = 0;
    conv_weight(p.in[6] + (size_t)layer * DM * 2 * DFF, DM, 2 * DFF, 2 * DFF, WB + E_FFN1_IN, p.in[5] + layer * DM, 1, tile, rot);
    conv_weight(p.in[7] + (size_t)layer * DFF * DM, DFF, DM, DM, WB + E_FFN1_OUT, nullptr, 0, tile, rot);
    conv_weight(p.in[24] + (size_t)layer * DM * 2 * DFF, DM, 2 * DFF, 2 * DFF, WB + E_FFN2_IN, p.in[23] + layer * DM, 1, tile, rot);
    conv_weight(p.in[25] + (size_t)layer * DFF * DM, DFF, DM, DM, WB + E_FFN2_OUT, nullptr, 0, tile, rot);
    conv_weight(p.in[21] + (size_t)layer * DM * 2048, DM, 2048, 2048, WB + E_CKV, nullptr, 0, tile, rot);
    conv_weight(p.in[22] + (size_t)layer * DM * DM, DM, DM, DM, WB + E_CO, nullptr, 0, tile, rot);
    if (layer == 0) {
        conv_weight(p.in[9], DM, 3072, 3104, WB + E_MIX_IN, p.in[8], 2, tile, rot);
        conv_weight(p.in[15], DM, DM, DM, WB + E_MIX_OUT, nullptr, 0, tile, rot);
        for (size_t idx = (size_t)blockIdx.x * 512 + tid; idx < (size_t)2 * 512 * 1024; idx += (size_t)gridDim.x * 512) {
            const int c = (int)(idx & 1023), n = (int)((idx >> 10) & 511), dir = (int)(idx >> 19);
            const float* wi = p.in[9] + (size_t)c * 3104 + 3072 + dir * 16; const float* wg = (dir ? p.in[12] : p.in[10]) + n;
            float s = 0.f;
#pragma unroll
            for (int r = 0; r < 16; ++r) s += wi[r] * wg[r * 512];
            s *= p.in[8][c];
            WB[E_MIX_IN + (size_t)((n >> 7) * 1024 + 256 + dir * 128 + (n & 127)) * DM + c] = f2bf(s);
        }
    } else {
        conv_weight(p.in[16], DM, 9216, 9216, WB + E_MIX_IN, p.in[8] + DM, 3, tile, rot);
        conv_weight(p.in[17], DM, DM, DM, WB + E_MIX_OUT, nullptr, 0, tile, rot);
    }
    { const float* src = p.in[20] + (size_t)layer * DM * DM; const float* g = p.in[18] + layer * DM;
      for (size_t idx = ((size_t)blockIdx.x * 512 + tid) * 4; idx < (size_t)DM * DM; idx += (size_t)gridDim.x * 512 * 4) {
          const f32x4 v = *(const f32x4*)(src + idx); const float s = g[idx >> 10] * 0.0625f;
          u32x2 w; w.x = cvt_pk_bf16(v[0] * s, v[1] * s); w.y = cvt_pk_bf16(v[2] * s, v[3] * s);
          *(u32x2*)(WB + E_CQ + idx) = w; } }
    { bf16_t* MEMN = (bf16_t*)(ws + OFF_STAGE + ST_MEMN); const float* g = p.in[19] + layer * DM;
      for (int row = gw; row < 768; row += nwv) {
          const float* src = row < 512 ? p.in[2] + (size_t)row * DM : p.in[3] + (size_t)(row - 512) * DM;
          f32x4 v[4]; float ss = 0.f;
#pragma unroll
          for (int i = 0; i < 4; ++i) { v[i] = *(const f32x4*)(src + i * 256 + lane * 4); ss += (v[i][0] * v[i][0] + v[i][1] * v[i][1]) + (v[i][2] * v[i][2] + v[i][3] * v[i][3]); }
#pragma unroll
          for (int o = 1; o < 64; o <<= 1) ss += __shfl_xor(ss, o);
          const float rs = rsqrtf(ss * (1.0f / 1024.0f) + EPS);
#pragma unroll
          for (int i = 0; i < 4; ++i) { const f32x4 gg = *(const f32x4*)(g + i * 256 + lane * 4);
              u32x2 w; w.x = cvt_pk_bf16(v[i][0] * rs * gg[0], v[i][1] * rs * gg[1]); w.y = cvt_pk_bf16(v[i][2] * rs * gg[2], v[i][3] * rs * gg[3]);
              *(u32x2*)(MEMN + (size_t)row * DM + i * 256 + lane * 4) = w; } } }
    if (layer == 0) {
        bf16_t* XB = (bf16_t*)(ws + OFF_XB); float* part = (float*)(ws + OFF_PARTV);
        for (int row = gw; row < T; row += nwv) {
            const float* src = x_in_row(p, row); f32x4 v[4]; float ss = 0.f;
#pragma unroll
            for (int i = 0; i < 4; ++i) { v[i] = *(const f32x4*)(src + i * 256 + lane * 4); ss += (v[i][0] * v[i][0] + v[i][1] * v[i][1]) + (v[i][2] * v[i][2] + v[i][3] * v[i][3]); }
#pragma unroll
            for (int o = 1; o < 64; o <<= 1) ss += __shfl_xor(ss, o);
#pragma unroll
            for (int i = 0; i < 4; ++i) { *(f32x4*)(p.X + (size_t)row * DM + i * 256 + lane * 4) = v[i];
                u32x2 w; w.x = cvt_pk_bf16(v[i][0], v[i][1]); w.y = cvt_pk_bf16(v[i][2], v[i][3]);
                *(u32x2*)(XB + (size_t)row * DM + i * 256 + lane * 4) = w; }
            if (lane == 0) *(f32x4*)(part + (size_t)row * 4) = (f32x4){ss, 0.f, 0.f, 0.f};
        }
        float* bt = (float*)(ws + OFF_BTAB);
        for (int idx = blockIdx.x * 512 + tid; idx < 3 * 16 * 129; idx += gridDim.x * 512) {
            const int rel = idx % 129 - 64, h = (idx / 129) % 16, g = idx / (129 * 16); const int r = g == 0 ? 1 : (g == 1 ? 4 : 16);
            const int rr = rel * r, n = rr < 0 ? -rr : rr; int bk;
            if (n < 8) bk = n; else bk = 8 + (n >= 15) + (n >= 27) + (n >= 50) + (n >= 91) + (n >= 166) + (n >= 305) + (n >= 559);
            if (rr > 0) bk += 16;
            bt[idx] = p.in[4][bk * 48 + g * 16 + h];
        }
    }
}

__device__ __forceinline__ void phase_final(const Params& p) {
    const float* part = (const float*)(p.ws + OFF_PARTV + 8 * PARTV_BYTES); const float* g = p.in[26];
    int tid = threadIdx.x; asm volatile("" : "+v"(tid)); const int lane = tid & 63, wid = tid >> 6, nwv = gridDim.x * 8, gw = blockIdx.x * 8 + wid;
    for (int row = gw; row < T; row += nwv) { const float rs = rstd_of(part, row);
#pragma unroll
        for (int i = 0; i < 4; ++i) { float* xp = p.X + (size_t)row * DM + i * 256 + lane * 4; const f32x4 v = ld_sys16f(xp); const f32x4 gg = *(const f32x4*)(g + i * 256 + lane * 4);
            *(f32x4*)xp = (f32x4){v[0] * rs * gg[0], v[1] * rs * gg[1], v[2] * rs * gg[2], v[3] * rs * gg[3]}; } }
}

__device__ __forceinline__ void gla_combine(const Params& p, int h) {
    unsigned char* st = p.ws + OFF_STAGE; const float* OF = (const float*)(st + ST_OF); const float* OB = (const float*)(st + ST_OB); bf16_t* AB = (bf16_t*)(st + ST_ABUF);
    const float* gn = p.in[14] + h * 256;
    int tid = threadIdx.x; asm volatile("" : "+v"(tid)); const int lane = tid & 63, wid = tid >> 6, nwv = gridDim.x * 8, gw = blockIdx.x * 8 + wid;
    const f32x4 gg = *(const f32x4*)(gn + lane * 4);
    for (int row = gw; row < T; row += nwv) {
        const f32x4 a = ld_sys16f(OF + (size_t)row * 256 + lane * 4), b = ld_sys16f(OB + (size_t)row * 256 + lane * 4);
        const f32x4 o = a + b; float ss = (o[0] * o[0] + o[1] * o[1]) + (o[2] * o[2] + o[3] * o[3]);
#pragma unroll
        for (int s = 1; s < 64; s <<= 1) ss += __shfl_xor(ss, s);
        const float rs = rsqrtf(ss * (1.0f / 256.0f) + EPS);
        bf16_t* ap = AB + (size_t)row * DM + h * 256 + lane * 4; const u32x2 rr = ld_sys8(ap);
        const float r0 = __uint_as_float(rr.x << 16), r1 = __uint_as_float(rr.x & 0xffff0000u), r2 = __uint_as_float(rr.y << 16), r3 = __uint_as_float(rr.y & 0xffff0000u);
        u32x2 w; w.x = cvt_pk_bf16(o[0] * rs * gg[0] * r0, o[1] * rs * gg[1] * r1); w.y = cvt_pk_bf16(o[2] * rs * gg[2] * r2, o[3] * rs * gg[3] * r3);
        *(u32x2*)ap = w;
    }
}

constexpr int SC_QP = 0, SC_KP = 17408, SC_KT = 34816, SC_VT = 53248, SC_ATT = 62464, SC_SS = 71680, SC_QS = 89088, SC_BL = 91136;

template <bool OUT>
__device__ __forceinline__ void gla_scan(const Params& p, LAS unsigned char* lds) {
    unsigned char* st = p.ws + OFF_STAGE;
    const bf16_t* QK = (const bf16_t*)(st + ST_QK); const float* GG = (const float*)(st + ST_GG); const bf16_t* VV = (const bf16_t*)(st + ST_VV);
    float* SLOC = (float*)(st + ST_SLOC); float* DVEC = (float*)(st + ST_DVEC);
    int tid = threadIdx.x; asm volatile("" : "+v"(tid)); const int lane = tid & 63, w = tid >> 6, l15 = lane & 15, quad = lane >> 4;
    LAS bf16_t* QP = (LAS bf16_t*)(lds + SC_QP); LAS bf16_t* KP = (LAS bf16_t*)(lds + SC_KP); LAS bf16_t* KT = (LAS bf16_t*)(lds + SC_KT);
    LAS bf16_t* VT = (LAS bf16_t*)(lds + SC_VT); LAS bf16_t* ATT = (LAS bf16_t*)(lds + SC_ATT); LAS bf16_t* SS = (LAS bf16_t*)(lds + SC_SS);
    LAS float* QS = (LAS float*)(lds + SC_QS); LAS float* BL = (LAS float*)(lds + SC_BL);
    for (int unit = blockIdx.x; unit < 256; unit += gridDim.x) {
        const int slice = unit & 3, dir = (unit >> 2) & 1, seg = unit >> 3;
        const int sfirst = seg < 8 ? 0 : (seg < 16 ? 8 : 16), nseg = seg < 16 ? 8 : 16;
        const int sigma = dir == 0 ? seg - sfirst : sfirst + nseg - 1 - seg;
        float* oout = (float*)(st + (dir == 0 ? ST_OF : ST_OB));
        f32x4 S[4];
#pragma unroll
        for (int d = 0; d < 4; ++d) S[d] = (f32x4){0.f, 0.f, 0.f, 0.f};
        if (OUT) {
            for (int sp = 0; sp < sigma; ++sp) {
                const int sg = dir == 0 ? sfirst + sp : sfirst + nseg - 1 - sp;
                const float* sl = SLOC + (size_t)(sg * 2 + dir) * 128 * 256; const float* dv = DVEC + (size_t)(sg * 2 + dir) * 128;
#pragma unroll
                for (int r = 0; r < 4; ++r) { const int dk = 16 * w + 4 * quad + r; const float dd = ldsys_f(dv + dk);
#pragma unroll
                    for (int d = 0; d < 4; ++d) S[d][r] = S[d][r] * dd + ldsys_f(sl + (size_t)dk * 256 + slice * 64 + d * 16 + l15); }
            }
        }
        float dsum = 0.f;
        const int dkc = tid & 127, qr = tid >> 7;
        const int dvc = tid & 63, jr = tid >> 6;
        for (int ch = 0; ch < 16; ++ch) {
            const int tb = seg * 1024 + (dir == 0 ? ch * 64 : (15 - ch) * 64);
            float g[16]; float q[16], k[16];
#pragma unroll
            for (int ii = 0; ii < 16; ++ii) { const int ip = qr * 16 + ii; const int tok = tb + (dir == 0 ? ip : 63 - ip);
                g[ii] = ldsys_f(GG + (size_t)tok * 256 + dir * 128 + dkc);
                if (OUT) q[ii] = bf2f(ldsys_h(QK + (size_t)tok * 256 + dkc));
                k[ii] = bf2f(ldsys_h(QK + (size_t)tok * 256 + 128 + dkc)); }
            unsigned vpk[4];
            { float v[8];
#pragma unroll
              for (int jj = 0; jj < 8; ++jj) { const int jp = jr * 8 + jj; const int tok = tb + (dir == 0 ? jp : 63 - jp); v[jj] = bf2f(ldsys_h(VV + (size_t)tok * 256 + slice * 64 + dvc)); }
#pragma unroll
              for (int jj = 0; jj < 4; ++jj) vpk[jj] = cvt_pk_bf16(v[2 * jj], v[2 * jj + 1]); }
#pragma unroll
            for (int ii = 1; ii < 16; ++ii) g[ii] += g[ii - 1];
            QS[qr * 128 + dkc] = g[15];
            *(LAS u32x4*)(VT + dvc * 72 + jr * 8) = (u32x4){vpk[0], vpk[1], vpk[2], vpk[3]};
            __syncthreads();
            float off = 0.f, tot = 0.f;
#pragma unroll
            for (int qq = 0; qq < 4; ++qq) { const float s = QS[qq * 128 + dkc]; tot += s; if (qq < qr) off += s; }
            if (qr == 0) { BL[dkc] = __expf(tot); dsum += tot; }
            unsigned kt[8];
#pragma unroll
            for (int ii = 0; ii < 16; ii += 2) {
                const float b0 = off + g[ii], b1 = off + g[ii + 1];
                if (OUT) { const int ip = qr * 16 + ii;
                    QP[ip * 136 + dkc] = f2bf(q[ii] * __expf(b0)); QP[(ip + 1) * 136 + dkc] = f2bf(q[ii + 1] * __expf(b1));
                    KP[ip * 136 + dkc] = f2bf(k[ii] * __expf(-b0)); KP[(ip + 1) * 136 + dkc] = f2bf(k[ii + 1] * __expf(-b1)); }
                kt[ii >> 1] = cvt_pk_bf16(k[ii] * __expf(tot - b0), k[ii + 1] * __expf(tot - b1));
            }
            *(LAS u32x4*)(KT + dkc * 72 + qr * 16) = (u32x4){kt[0], kt[1], kt[2], kt[3]};
            *(LAS u32x4*)(KT + dkc * 72 + qr * 16 + 8) = (u32x4){kt[4], kt[5], kt[6], kt[7]};
            if (OUT) {
#pragma unroll
                for (int d = 0; d < 4; ++d) { u32x2 sw; sw.x = cvt_pk_bf16(S[d][0], S[d][1]); sw.y = cvt_pk_bf16(S[d][2], S[d][3]);
                    *(LAS u32x2*)(SS + (d * 16 + l15) * 136 + 16 * w + 4 * quad) = sw; }
            }
            __syncthreads();
            f32x4 O[2];
            if (OUT) {
                const int it = w >> 1, c0 = (w & 1) * 2;
                f32x4 at[2] = {(f32x4){0.f, 0.f, 0.f, 0.f}, (f32x4){0.f, 0.f, 0.f, 0.f}};
                O[0] = (f32x4){0.f, 0.f, 0.f, 0.f}; O[1] = (f32x4){0.f, 0.f, 0.f, 0.f};
#pragma unroll
                for (int kk = 0; kk < 4; ++kk) {
                    const bf16x8 af = *(const LAS bf16x8*)(QP + (it * 16 + l15) * 136 + kk * 32 + quad * 8);
#pragma unroll
                    for (int x = 0; x < 2; ++x) {
                        const bf16x8 kf = *(const LAS bf16x8*)(KP + ((c0 + x) * 16 + l15) * 136 + kk * 32 + quad * 8);
                        at[x] = __builtin_amdgcn_mfma_f32_16x16x32_bf16(af, kf, at[x], 0, 0, 0);
                        const bf16x8 sf = *(const LAS bf16x8*)(SS + ((c0 + x) * 16 + l15) * 136 + kk * 32 + quad * 8);
                        O[x] = __builtin_amdgcn_mfma_f32_16x16x32_bf16(af, sf, O[x], 0, 0, 0);
                    }
                }
#pragma unroll
                for (int x = 0; x < 2; ++x)
#pragma unroll
                    for (int r = 0; r < 4; ++r) { const int i = it * 16 + quad * 4 + r, j = (c0 + x) * 16 + l15;
                        ATT[i * 72 + j] = f2bf(j <= i ? at[x][r] : 0.f); }
            }
            {
#pragma unroll
                for (int r = 0; r < 4; ++r) { const float dd = BL[16 * w + 4 * quad + r];
#pragma unroll
                    for (int d = 0; d < 4; ++d) S[d][r] *= dd; }
#pragma unroll
                for (int kk = 0; kk < 2; ++kk) {
                    const bf16x8 af = *(const LAS bf16x8*)(KT + (16 * w + l15) * 72 + kk * 32 + quad * 8);
#pragma unroll
                    for (int d = 0; d < 4; ++d) { const bf16x8 vf = *(const LAS bf16x8*)(VT + (d * 16 + l15) * 72 + kk * 32 + quad * 8);
                        S[d] = __builtin_amdgcn_mfma_f32_16x16x32_bf16(af, vf, S[d], 0, 0, 0); }
                }
            }
            if (OUT) {
                __syncthreads();
                const int it = w >> 1, c0 = (w & 1) * 2;
#pragma unroll
                for (int kk = 0; kk < 2; ++kk) {
                    const bf16x8 af = *(const LAS bf16x8*)(ATT + (it * 16 + l15) * 72 + kk * 32 + quad * 8);
#pragma unroll
                    for (int x = 0; x < 2; ++x) { const bf16x8 vf = *(const LAS bf16x8*)(VT + ((c0 + x) * 16 + l15) * 72 + kk * 32 + quad * 8);
                        O[x] = __builtin_amdgcn_mfma_f32_16x16x32_bf16(af, vf, O[x], 0, 0, 0); }
                }
#pragma unroll
                for (int x = 0; x < 2; ++x)
#pragma unroll
                    for (int r = 0; r < 4; ++r) { const int ip = it * 16 + quad * 4 + r; const int tok = tb + (dir == 0 ? ip : 63 - ip);
                        oout[(size_t)tok * 256 + slice * 64 + (c0 + x) * 16 + l15] = O[x][r]; }
            }
            __syncthreads();
        }
        if (!OUT) {
            float* sl = SLOC + (size_t)(seg * 2 + dir) * 128 * 256;
#pragma unroll
            for (int r = 0; r < 4; ++r) { const int dk = 16 * w + 4 * quad + r;
#pragma unroll
                for (int d = 0; d < 4; ++d) sl[(size_t)dk * 256 + slice * 64 + d * 16 + l15] = S[d][r]; }
            if (slice == 0 && tid < 128) DVEC[(size_t)(seg * 2 + dir) * 128 + tid] = __expf(dsum);
        }
    }
}

typedef float f32x16 __attribute__((ext_vector_type(16)));
__device__ __forceinline__ void dil_attn(const Params& p, int hc, LAS unsigned char* lds) {
    unsigned char* st = p.ws + OFF_STAGE; bf16_t* AB = (bf16_t*)(st + ST_ABUF); const float* btab = (const float*)(p.ws + OFF_BTAB);
    LAS float* OST = (LAS float*)lds; LAS float* MST = (LAS float*)(lds + 139264); LAS float* LST = (LAS float*)(lds + 141312); LAS float* BTL = (LAS float*)(lds + 143360);
    int tid = threadIdx.x; asm volatile("" : "+v"(tid)); const int lane = tid & 63, w = tid >> 6, l31 = lane & 31, hh = lane >> 5;
    const int kap = (l31 & 16) | ((l31 & 4) << 1) | ((l31 & 8) >> 1) | (l31 & 3);
    for (int unit = blockIdx.x; unit < 256; unit += gridDim.x) {
        const int hl = unit & 3, tbk = unit >> 2, t0 = tbk * 512;
        const int sb = t0 < 8192 ? 0 : (t0 < 16384 ? 8192 : 16384), Sq = t0 < 16384 ? 8192 : 16384;
        const int h = hc * 4 + hl;
#pragma unroll 1
        for (int g = 0; g < 3; ++g) {
            const int r = g == 0 ? 1 : (g == 1 ? 4 : 16), L = Sq / r;
            const bf16_t* QKg = (const bf16_t*)(st + ST_QKG) + (size_t)g * T * 512; const bf16_t* VTg = (const bf16_t*)(st + ST_VTG) + (size_t)g * 256 * T;
            const float* bt = btab + (g * 16 + h) * 129;
            if (tid < 256) { const int ri = tid - 96; BTL[tid] = (ri >= 0 && ri <= 128) ? bt[ri] : 0.f; }
            __syncthreads();
#pragma unroll 1
            for (int itx = 0; itx < 2; ++itx) {
                const int item = 2 * w + itx;
                int c, l0;
                if (g == 0) { c = 0; l0 = (t0 - sb) + 32 * item; } else if (g == 1) { c = item >> 2; l0 = (t0 - sb) / 4 + 32 * (item & 3); } else { c = item; l0 = (t0 - sb) / 16; }
                const int nq0 = sb + c * L + l0, nbase = nq0 - 64;
                const int tokl = (l0 + l31) * r + c - (t0 - sb);
                bf16x8 qf[4];
#pragma unroll
                for (int ks = 0; ks < 4; ++ks) qf[ks] = ld_sys16(QKg + (unsigned)(((nq0 >> 5) * 16 + hl * 4 + ks) * 512 + l31 * 16 + hh * 8));
                f32x16 sT[5];
                bf16x8 kf[4];
#define DIL_LOADK(kt) do { const int lkh_ = l0 - 64 + 32 * (kt) + (l31 & 16); const bool in_ = (lkh_ >= 0) && (lkh_ < L); \
                    const int nrow_ = in_ ? nbase + 32 * (kt) + kap : nq0 + l31; \
                    _Pragma("unroll") for (int ks_ = 0; ks_ < 4; ++ks_) kf[ks_] = ld_sys16(QKg + (unsigned)(T * 256 + ((nrow_ >> 5) * 16 + hl * 4 + ks_) * 512 + (nrow_ & 31) * 16 + hh * 8)); } while (0)
#pragma unroll
                for (int kt = 0; kt < 5; ++kt) {
                    DIL_LOADK(kt);
                    f32x16 a;
#pragma unroll
                    for (int j = 0; j < 16; ++j) a[j] = 0.f;
#pragma unroll
                    for (int ks = 0; ks < 4; ++ks) a = __builtin_amdgcn_mfma_f32_32x32x16_bf16(kf[ks], qf[ks], a, 0, 0, 0);
                    sT[kt] = a;
                }
                bf16x8 vf[4];
#define DIL_LOADV(kt) do { _Pragma("unroll") for (int s_ = 0; s_ < 2; ++s_) { const int lkh_ = l0 - 64 + 32 * (kt) + 16 * s_; const bool in_ = (lkh_ >= 0) && (lkh_ < L); \
                    const int ncol_ = in_ ? nbase + 32 * (kt) + 16 * s_ + 8 * hh : nq0; \
                    _Pragma("unroll") for (int dt_ = 0; dt_ < 2; ++dt_) vf[2 * s_ + dt_] = ld_sys16(VTg + (unsigned)((ncol_ >> 5) * 8192 + (hl * 64 + dt_ * 32 + l31) * 32 + (ncol_ & 31))); } } while (0)
                DIL_LOADV(0);
#pragma unroll
                for (int kt = 0; kt < 5; ++kt)
#pragma unroll
                    for (int j = 0; j < 16; ++j) { const int lkh = l0 - 64 + 32 * kt + 16 * (j >> 3); const bool inr = (lkh >= 0) && (lkh < L);
                        const int rel = -64 + 32 * kt + 16 * (j >> 3) + 8 * hh + (j & 7) - l31; const bool ok = inr && rel >= -64 && rel <= 64;
                        sT[kt][j] = ok ? sT[kt][j] + BTL[rel + 160] : -1.0e30f; }
                float mo = -1.0e30f, lo = 0.f;
                if (g > 0) { mo = MST[tokl]; lo = LST[tokl]; }
                float mx = mo;
#pragma unroll
                for (int kt = 0; kt < 5; ++kt)
#pragma unroll
                    for (int j = 0; j < 16; ++j) mx = fmaxf(mx, sT[kt][j]);
                mx = fmaxf(mx, __shfl_xor(mx, 32));
                const float alpha = __expf(mo - mx);
                float ls = 0.f;
#pragma unroll
                for (int kt = 0; kt < 5; ++kt)
#pragma unroll
                    for (int j = 0; j < 16; ++j) { const float e = __expf(sT[kt][j] - mx); sT[kt][j] = e; ls += e; }
                ls += __shfl_xor(ls, 32);
                const float ln = lo * alpha + ls;
                f32x16 O[2];
#pragma unroll
                for (int dt = 0; dt < 2; ++dt)
#pragma unroll
                    for (int j = 0; j < 16; ++j) O[dt][j] = 0.f;
                if (g > 0) {
#pragma unroll
                    for (int dt = 0; dt < 2; ++dt)
#pragma unroll
                        for (int g4 = 0; g4 < 4; ++g4) { const f32x4 o4 = *(const LAS f32x4*)(OST + tokl * 68 + dt * 32 + g4 * 8 + hh * 4);
                            O[dt][4 * g4] = o4[0] * alpha; O[dt][4 * g4 + 1] = o4[1] * alpha; O[dt][4 * g4 + 2] = o4[2] * alpha; O[dt][4 * g4 + 3] = o4[3] * alpha; } }
#pragma unroll
                for (int kt = 0; kt < 5; ++kt) {
                    if (kt > 0) DIL_LOADV(kt);
#pragma unroll
                    for (int s2 = 0; s2 < 2; ++s2) {
                        u32x4 pw; pw.x = cvt_pk_bf16(sT[kt][8 * s2], sT[kt][8 * s2 + 1]); pw.y = cvt_pk_bf16(sT[kt][8 * s2 + 2], sT[kt][8 * s2 + 3]);
                        pw.z = cvt_pk_bf16(sT[kt][8 * s2 + 4], sT[kt][8 * s2 + 5]); pw.w = cvt_pk_bf16(sT[kt][8 * s2 + 6], sT[kt][8 * s2 + 7]);
                        const bf16x8 pf = __builtin_bit_cast(bf16x8, pw);
#pragma unroll
                        for (int dt = 0; dt < 2; ++dt) O[dt] = __builtin_amdgcn_mfma_f32_32x32x16_bf16(vf[2 * s2 + dt], pf, O[dt], 0, 0, 0);
                    }
                }
#undef DIL_LOADK
#undef DIL_LOADV
                if (g < 2) {
                    if (hh == 0) { MST[tokl] = mx; LST[tokl] = ln; }
#pragma unroll
                    for (int dt = 0; dt < 2; ++dt)
#pragma unroll
                        for (int g4 = 0; g4 < 4; ++g4) *(LAS f32x4*)(OST + tokl * 68 + dt * 32 + g4 * 8 + hh * 4) = (f32x4){O[dt][4 * g4], O[dt][4 * g4 + 1], O[dt][4 * g4 + 2], O[dt][4 * g4 + 3]};
                } else {
                    const float inv = 1.0f / ln;
#pragma unroll
                    for (int dt = 0; dt < 2; ++dt)
#pragma unroll
                        for (int g4 = 0; g4 < 4; ++g4) { u32x2 ow; ow.x = cvt_pk_bf16(O[dt][4 * g4] * inv, O[dt][4 * g4 + 1] * inv); ow.y = cvt_pk_bf16(O[dt][4 * g4 + 2] * inv, O[dt][4 * g4 + 3] * inv);
                            *(u32x2*)(AB + (size_t)(t0 + tokl) * DM + h * 64 + dt * 32 + g4 * 8 + hh * 4) = ow; }
                }
            }
            __syncthreads();
        }
    }
}

#define XB_TMO      128
#define XB_XCNT(j)  (256  + 64 * (j))
#define XB_XSUB(j)  (1280 + 64 * (j))
#define XB_XGEN(j)  (2304 + 64 * (j))
#define XB_TOP      3328
#define XB_TOPGEN   3392
#define XCD_BAR_WORDS 3456
#define XB_SPIN_CAP (1u << 22)
__device__ __forceinline__ unsigned xb_ld(unsigned* p)              { return __hip_atomic_load(p, __ATOMIC_RELAXED, __HIP_MEMORY_SCOPE_AGENT); }
__device__ __forceinline__ unsigned xb_add(unsigned* p, unsigned v) { return __hip_atomic_fetch_add(p, v, __ATOMIC_RELAXED, __HIP_MEMORY_SCOPE_AGENT); }
__device__ __forceinline__ unsigned xb_xcc_id() { return (unsigned)__builtin_amdgcn_s_getreg((3 << 11) | 20) & 0xFu; }
#define XB_SPIN(cond, bar) do { unsigned _sp = 0; while (cond) { __builtin_amdgcn_s_sleep(1); \
    if ((++_sp & 255u) == 0u) { if (xb_ld(&(bar)[XB_TMO])) break; if (_sp > XB_SPIN_CAP) { atomicAdd(&(bar)[XB_TMO], 1u); break; } } } } while (0)
struct XcdBarrier { unsigned* bar; unsigned x; volatile LAS unsigned* st; };
__device__ __forceinline__ XcdBarrier xcd_barrier_post(unsigned* bar, volatile LAS unsigned* st) {
    XcdBarrier b; b.bar = bar; b.x = xb_xcc_id(); b.st = st;
    if (threadIdx.x == 0) (void)xb_add(&bar[XB_XCNT(b.x)], 1u);
    return b;
}
__device__ __forceinline__ void xcd_barrier_complete(unsigned* bar, unsigned x, unsigned& nloc, unsigned& nx) {
    const unsigned G = gridDim.x * gridDim.y * gridDim.z;
    unsigned sum, cnt, mine, sp = 0u;
    for (;;) {
        sum = 0u; cnt = 0u; mine = 0u;
#pragma unroll
        for (unsigned j = 0; j < 16; ++j) { const unsigned c = xb_ld(&bar[XB_XCNT(j)]); sum += c; cnt += (c > 0u) ? 1u : 0u; mine = (j == x) ? c : mine; }
        if (sum == G) break;
        __builtin_amdgcn_s_sleep(1);
        if ((++sp & 255u) == 0u) { if (xb_ld(&bar[XB_TMO])) break; if (sp > XB_SPIN_CAP) { atomicAdd(&bar[XB_TMO], 1u); break; } }
    }
    nloc = mine > 0u ? mine : 1u; nx = cnt > 0u ? cnt : 1u;
}
__device__ __forceinline__ void xcd_barrier(const XcdBarrier& b) {
    asm volatile("s_waitcnt vmcnt(0)" ::: "memory");
    __syncthreads();
    if (threadIdx.x == 0) {
        unsigned* bar = b.bar;
        __builtin_amdgcn_s_waitcnt(0);
        unsigned nloc = b.st[0], nx = b.st[1];
        if (nloc == 0u) { xcd_barrier_complete(bar, b.x, nloc, nx); b.st[0] = nloc; b.st[1] = nx; }
        const unsigned old = xb_add(&bar[XB_XSUB(b.x)], 1u);
        const unsigned gen = old / nloc;
        if (old + 1u == (gen + 1u) * nloc) {
            __builtin_amdgcn_fence(__ATOMIC_RELEASE, "agent");
            asm volatile("s_waitcnt vmcnt(0)" ::: "memory");
            const unsigned og = xb_add(&bar[XB_TOP], 1u);
            const unsigned tg = og / nx;
            if (og + 1u == (tg + 1u) * nx) xb_add(&bar[XB_TOPGEN], 1u);
            else XB_SPIN(xb_ld(&bar[XB_TOPGEN]) == tg, bar);
            __builtin_amdgcn_fence(__ATOMIC_ACQUIRE, "agent");
            xb_add(&bar[XB_XGEN(b.x)], 1u);
            asm volatile("s_waitcnt vmcnt(0)" ::: "memory");
        } else {
            XB_SPIN(xb_ld(&bar[XB_XGEN(b.x)]) == gen, bar);
            __builtin_amdgcn_fence(__ATOMIC_ACQUIRE, "agent");
            asm volatile("s_waitcnt vmcnt(0)" ::: "memory");
        }
    }
    __syncthreads();
}

__global__ void __launch_bounds__(512, 2) fwd_megakernel(Params p) {
    extern __shared__ __attribute__((aligned(16))) unsigned char smem[];
    LAS unsigned char* lds = (LAS unsigned char*)smem;
    cg::grid_group grid = cg::this_grid();
    if (threadIdx.x < 2) ((volatile LAS unsigned*)(lds + LDS_CTL))[threadIdx.x] = 0u;
    __syncthreads();
    const XcdBarrier bar = xcd_barrier_post((unsigned*)(p.ws + OFF_CTL), (volatile LAS unsigned*)(lds + LDS_CTL));
    grid.sync();
    unsigned char* ws = p.ws; bf16_t* WB = (bf16_t*)ws; bf16_t* XB = (bf16_t*)(ws + OFF_XB); float* part = (float*)(ws + OFF_PART);
    unsigned char* st = ws + OFF_STAGE;
    for (int ph = p.ph_lo; ph < p.ph_hi; ++ph) {
        if (ph > p.ph_lo) { for (int xs = 0; xs <= PROBE_SYNC; ++xs) xcd_barrier(bar); }
        if (ph == 37) { phase_final(p); continue; }
        const int layer = ph >= 21 ? 1 : 0, q = ph - layer * 21;
        int op = -1, arg = 0;
        if (q == 0) op = 0; else if (q == 1) op = 1; else if (q == 2) op = 2;
        else if (layer == 0) {
            if (q <= 14) { const int hh = (q - 3) / 3, s = (q - 3) % 3; arg = hh; op = 10 + s; }
            else if (q == 15) { op = 13; arg = 3; } else op = q - 16 + 3;
        } else {
            if (q <= 10) { arg = (q - 3) >> 1; op = 20 + ((q - 3) & 1); } else op = q - 11 + 3;
        }
        if (op == 10 && arg > 0) gla_combine(p, arg - 1);
        for (int rep = 0; rep < (((PROBE_REP >> op) & 1u) ? 2 : 1); ++rep) {
        if (op == 0) { if (EN(0)) phase_prologue(p, layer, lds); }
        else if (op == 11) { if (EN(11)) gla_scan<false>(p, lds); }
        else if (op == 12) { if (EN(12)) gla_scan<true>(p, lds); }
        else if (op == 13) { if (EN(13)) gla_combine(p, arg); }
        else if (op == 21) { if (EN(21)) dil_attn(p, arg, lds); }
        else if (EN(1)) {
            GemmJob J;
            for (int j = 0; j < 8; ++j) { if (!get_job(p, op, arg, j, J)) break;
                const int nres = layer * 4 + (op >= 7 ? 3 : (op >= 5 && op < 10 ? 2 : (op == 4 || op == 3 ? 1 : (op == 2 ? 0 : (op == 1 ? 0 : (op == 6 ? 3 : 1))))));
                const int vr = (op == 1) ? layer * 4 : ((op == 10 || op == 20) ? layer * 4 + 1 : (op == 4 ? layer * 4 + 2 : layer * 4 + 3));
                const float* part = (const float*)(ws + OFF_PARTV + (size_t)vr * PARTV_BYTES); float* partw = (float*)(ws + OFF_PARTV + (size_t)(nres + 1) * PARTV_BYTES); const int kind = J.e.kind;
                if (EN(22) && kind == 0) { EpiPlain e{(bf16_t*)(ws + J.e.o_off), J.e.ldc, J.e.bstride}; gemm_phase(lds, J.K, J.lda, J.ldb, J.s, e); }
                else if (EN(23) && kind == 1) { EpiSwiGLU e{(bf16_t*)(ws + J.e.o_off), part}; gemm_phase(lds, DM, DM, DM, J.s, e); }
                else if (EN(24) && kind == 2) { EpiResid e{p.X, XB, partw, J.e.scale, (LAS float*)(lds + LDS_X)}; gemm_phase(lds, J.K, J.K, J.K, J.s, e); }
                else if (EN(25) && kind == 3) { EpiGlaProj e{(bf16_t*)(st + ST_QK), (float*)(st + ST_GG), (bf16_t*)(st + ST_VV), (bf16_t*)(st + ST_ABUF), part, p.in[11], p.in[13], J.e.h}; gemm_phase(lds, DM, DM, DM, J.s, e); }
                else if (EN(26) && kind == 4) { EpiDilQK e{(bf16_t*)(ws + J.e.o_off), part, J.e.r}; gemm_phase(lds, DM, J.lda, DM, J.s, e); }
                else if (EN(27) && kind == 5) { EpiDilVT e{(bf16_t*)(ws + J.e.o_off), part, J.e.r}; gemm_phase(lds, DM, DM, J.ldb, J.s, e); }
                else if (EN(28) && kind == 6) { EpiScores e{(bf16_t*)(ws + J.e.o_off), part, (LAS f32x2*)(lds + LDS_X)}; gemm_phase(lds, DM, DM, DM, J.s, e); }
            }
        }
        __syncthreads();
        }
    }
}

extern "C" void kernel_launch(void* const* d_in, const int* in_sizes, int n_in, void* d_out, int out_size, void* d_ws, size_t ws_size, hipStream_t stream) {
    static int grid_blocks = 0;
    if (!grid_blocks) {
        int dev = 0, cus = 0, per_cu = 0;
        hipGetDevice(&dev);
        hipDeviceGetAttribute(&cus, hipDeviceAttributeMultiprocessorCount, dev);
        hipFuncSetAttribute((const void*)fwd_megakernel, hipFuncAttributeMaxDynamicSharedMemorySize, LDS_BYTES);
        hipOccupancyMaxActiveBlocksPerMultiprocessor(&per_cu, fwd_megakernel, 512, LDS_BYTES);
        if (per_cu < 1) per_cu = 1;
        if (per_cu > 1) per_cu = 1;
        grid_blocks = cus * per_cu;
    }
    if (n_in != 27 || ws_size < WS_NEED) { fprintf(stderr, "kernel_launch: unexpected n_in %d / ws_size %zu (need %zu)\n", n_in, ws_size, (size_t)WS_NEED); return; }
    hipMemsetAsync((char*)d_ws + OFF_CTL, 0, CTL_BYTES, stream);
    Params p{};
    for (int i = 0; i < 27; ++i) p.in[i] = (const float*)d_in[i];
    p.X = (float*)d_out; p.ws = (unsigned char*)d_ws; p.ph_lo = 0; p.ph_hi = 38;
    void* args[] = {&p};
    hipError_t e = hipLaunchCooperativeKernel((const void*)fwd_megakernel, dim3(grid_blocks), dim3(512), args, LDS_BYTES, stream);
    if (e != hipSuccess) fprintf(stderr, "cooperative launch failed: %s (grid %d)\n", hipGetErrorString(e), grid_blocks);
}
```

```cpp
#include <hip/hip_runtime.h>
#include <hip/hip_cooperative_groups.h>
#include <cstdio>
#include <cstdint>
namespace cg = cooperative_groups;

#define LAS __attribute__((address_space(3)))
typedef unsigned short bf16_t;
typedef short bf16x8 __attribute__((ext_vector_type(8)));
typedef short bf16x4 __attribute__((ext_vector_type(4)));
typedef float f32x4 __attribute__((ext_vector_type(4)));
typedef float f32x2 __attribute__((ext_vector_type(2)));
typedef unsigned u32x4 __attribute__((ext_vector_type(4)));
typedef unsigned u32x2 __attribute__((ext_vector_type(2)));

#ifndef GP_SP2
#define GP_SP2 1
#endif
#ifndef GP_ALIGN
#define GP_ALIGN 1
#endif
#ifndef OPMASK
#define OPMASK 0xFFFFFFFFu
#endif
#define EN(o) ((OPMASK >> (o)) & 1u)
#ifndef PROBE_REP
#define PROBE_REP 0u
#endif
#ifndef PROBE_SYNC
#define PROBE_SYNC 0
#endif
constexpr int T = 32768, DM = 1024, DFF = 2816;
constexpr float EPS = 1e-6f;
constexpr int BM = 256, BK = 64, HALF = 128, HTB = HALF * BK * 2, STAGE_BYTES = 8 * HTB, NXCD = 8, WGM = 8;
constexpr int LDS_X = STAGE_BYTES;
constexpr int LDS_BYTES = 160 * 1024;
constexpr int LDS_CTL = LDS_BYTES - 64;

constexpr size_t E_FFN1_IN = 0, E_FFN1_OUT = 5767168, E_FFN2_IN = 8650752, E_FFN2_OUT = 14417920, E_CQ = 17301504, E_CKV = 18350080,
                 E_CO = 20447232, E_MIX_IN = 21495808, E_MIX_OUT = 30932992, E_GT = 31981568, E_HM = 35127296, E_WEND = 38273024;
constexpr size_t OFF_XB = E_WEND * 2, OFF_PART = OFF_XB + (size_t)T * DM * 2, OFF_BTAB = OFF_PART + (size_t)T * 16, OFF_STAGE = OFF_BTAB + 32768;
constexpr size_t ST_HID = 0, ST_MEMN = 184549376, ST_KV = 186122240;
constexpr size_t ST_ABUF = 0, ST_QK = 67108864, ST_GG = 83886080, ST_VV = 117440512, ST_OF = 134217728, ST_OB = 167772160, ST_SLOC = 201326592, ST_DVEC = 209715200;
constexpr size_t ST_QKG = 67108864, ST_VTG = 167772160;
constexpr size_t OFF_CTL = OFF_STAGE + 218103808;
constexpr size_t CTL_BYTES = 16384;
constexpr size_t OFF_PARTV = OFF_CTL + CTL_BYTES;
constexpr size_t PARTV_BYTES = (size_t)T * 16;
constexpr size_t WS_NEED = OFF_PARTV + 9 * PARTV_BYTES;

struct Params {
    const float* in[27];
    float* X;
    unsigned char* ws;
    int ph_lo, ph_hi;
};

__device__ __forceinline__ unsigned cvt_pk_bf16(float lo, float hi) { unsigned r; asm volatile("v_cvt_pk_bf16_f32 %0, %1, %2" : "=v"(r) : "v"(lo), "v"(hi)); return r; }
__device__ __forceinline__ float bf2f(bf16_t b) { return __uint_as_float(((unsigned)b) << 16); }
__device__ __forceinline__ bf16_t f2bf(float f) { return (bf16_t)(cvt_pk_bf16(f, 0.f) & 0xffffu); }

__host__ __device__ __forceinline__ int lds_byte(int r, int c) { const int st = (r >> 4) * 2 + (c >> 5), rr = r & 15, cc = c & 31, ob = rr * 64 + cc * 2; return st * 1024 + (ob ^ (((ob >> 9) & 1) << 5)); }
__host__ __device__ __forceinline__ void stage_rc(int b, int& R, int& C) { const int st = b / 1024, sb = b % 1024, swz = sb ^ (((sb >> 9) & 1) << 5); R = (st >> 1) * 16 + swz / 64; C = (st & 1) * 32 + (swz % 64) / 2; }
__host__ __device__ __forceinline__ int perm32(int rho) { const int n = rho >> 4, i = rho & 15; return 8 * (i >> 2) + 4 * n + (i & 3); }

struct Unit { int pm, pn, b; const char* a; const char* bt; };

__device__ __forceinline__ int dil_token0(int n0, int r) {
    const int sb = n0 < 8192 ? 0 : (n0 < 16384 ? 8192 : 16384), S = n0 < 16384 ? 8192 : 16384, L = S / r;
    const int c = (n0 - sb) / L, l0 = (n0 - sb) % L;
    return sb + l0 * r + c;
}

struct Sched {
    const char* A; const char* Bt;
    int a_tile, b_tile, a_batch, b_batch, seqB;
    int nM, nN, nB, G, c, mode, r;
    __device__ __forceinline__ bool next(int i, Unit& u) const {
        const int per = nM * nN; const long tot = (long)per * nB;
        const long L = (long)i * G + c; if (L >= tot) return false;
        int b = (int)(L / per); int wgid = (int)(L % per);
        { const int q = per / NXCD, rr = per % NXCD, xcd = wgid % NXCD, off = wgid / NXCD; wgid = (xcd < rr ? xcd * (q + 1) : rr * (q + 1) + (xcd - rr) * q) + off; }
        const int nig = WGM * nN, gid = wgid / nig, fm = gid * WGM, gsz = (nM - fm) < WGM ? (nM - fm) : WGM;
        u.pm = fm + ((wgid % nig) % gsz); u.pn = (wgid % nig) / gsz; u.b = b;
        const char* a = A + (long)b * a_batch; const char* bt = Bt + (long)b * b_batch;
        if (mode == 2) a += (long)dil_token0(u.pm * 256, r) * (DM * 2); else a += (long)u.pm * a_tile;
        if (mode == 3) bt += (long)dil_token0(u.pn * 256, r) * (DM * 2); else bt += (long)u.pn * b_tile;
        if (mode == 1) { const int s = u.pm < 32 ? 0 : (u.pm < 64 ? 1 : 2); bt += (long)s * seqB; }
        u.a = a; u.bt = bt; return true;
    }
};


typedef unsigned long long u64_t;
__device__ __forceinline__ float ldsys_f(const float* p) { return __hip_atomic_load(p, __ATOMIC_RELAXED, __HIP_MEMORY_SCOPE_SYSTEM); }
__device__ __forceinline__ bf16_t ldsys_h(const bf16_t* p) { return __hip_atomic_load(p, __ATOMIC_RELAXED, __HIP_MEMORY_SCOPE_SYSTEM); }
__device__ __forceinline__ u32x2 ld_sys8(const void* p) {
    const u64_t a = __hip_atomic_load((const u64_t*)p, __ATOMIC_RELAXED, __HIP_MEMORY_SCOPE_SYSTEM); return (u32x2){(unsigned)a, (unsigned)(a >> 32)};
}
__device__ __forceinline__ u32x4 ld_sys16u(const void* p) {
    const u64_t* q = (const u64_t*)p;
    const u64_t a = __hip_atomic_load(q, __ATOMIC_RELAXED, __HIP_MEMORY_SCOPE_SYSTEM), b = __hip_atomic_load(q + 1, __ATOMIC_RELAXED, __HIP_MEMORY_SCOPE_SYSTEM);
    return (u32x4){(unsigned)a, (unsigned)(a >> 32), (unsigned)b, (unsigned)(b >> 32)};
}
__device__ __forceinline__ bf16x8 ld_sys16(const void* p) { return __builtin_bit_cast(bf16x8, ld_sys16u(p)); }
__device__ __forceinline__ f32x4 ld_sys16f(const void* p) { return __builtin_bit_cast(f32x4, ld_sys16u(p)); }

__device__ __forceinline__ float rstd_of(const float* part, int row) {
    const f32x4 p = *(const f32x4*)(part + (size_t)row * 4);
    return rsqrtf(((p[0] + p[1]) + (p[2] + p[3])) * (1.0f / 1024.0f) + EPS);
}


__device__ __forceinline__ void rstd8(const float* part, int row0, float (&rs)[8]) {
    f32x4 pp[8];
#pragma unroll
    for (int i = 0; i < 8; ++i) pp[i] = *(const f32x4*)(part + (size_t)(row0 + (i >> 2) * 128 + (i & 3) * 16) * 4);
#pragma unroll
    for (int i = 0; i < 8; ++i) rs[i] = rsqrtf(((pp[i][0] + pp[i][1]) + (pp[i][2] + pp[i][3])) * (1.0f / 1024.0f) + EPS);
}

#define LBAR() do { asm volatile("s_waitcnt lgkmcnt(0)" ::: "memory"); __builtin_amdgcn_s_barrier(); asm volatile("" ::: "memory"); } while (0)

struct EpiPlain {
    bf16_t* O; int ldc; int bstride;
    __device__ __forceinline__ void operator()(const f32x4 (&acc)[2][2][4][2], const Unit& u, int wr, int wc, int fr, int fq) const {
        bf16_t* base = O + (long)u.b * bstride;
#pragma unroll
        for (int ai = 0; ai < 2; ++ai)
#pragma unroll
            for (int m = 0; m < 4; ++m) { const int row = u.pm * 256 + ai * 128 + wr * 64 + m * 16 + fr;
#pragma unroll
                for (int bj = 0; bj < 2; ++bj) { const int col = u.pn * 256 + bj * 128 + wc * 32 + 8 * fq;
                    const f32x4 v0 = acc[ai][bj][m][0], v1 = acc[ai][bj][m][1];
                    u32x4 w; w.x = cvt_pk_bf16(v0[0], v0[1]); w.y = cvt_pk_bf16(v0[2], v0[3]); w.z = cvt_pk_bf16(v1[0], v1[1]); w.w = cvt_pk_bf16(v1[2], v1[3]);
                    *(u32x4*)(base + (long)row * ldc + col) = w; } }
    }
};
struct EpiSwiGLU {
    bf16_t* H; const float* part;
    __device__ __forceinline__ void operator()(const f32x4 (&acc)[2][2][4][2], const Unit& u, int wr, int wc, int fr, int fq) const {
        float rs8[8]; rstd8(part, u.pm * 256 + wr * 64 + fr, rs8);
#pragma unroll
        for (int ai = 0; ai < 2; ++ai)
#pragma unroll
            for (int m = 0; m < 4; ++m) { const int row = u.pm * 256 + ai * 128 + wr * 64 + m * 16 + fr; const float rs = rs8[ai * 4 + m];
                float h[8];
#pragma unroll
                for (int n = 0; n < 2; ++n)
#pragma unroll
                    for (int j = 0; j < 4; ++j) { const float a = acc[ai][0][m][n][j] * rs, b = acc[ai][1][m][n][j] * rs; h[n * 4 + j] = a * b * __builtin_amdgcn_rcpf(1.0f + __expf(-a)); }
                u32x4 w; w.x = cvt_pk_bf16(h[0], h[1]); w.y = cvt_pk_bf16(h[2], h[3]); w.z = cvt_pk_bf16(h[4], h[5]); w.w = cvt_pk_bf16(h[6], h[7]);
                *(u32x4*)(H + (long)row * DFF + u.pn * 128 + wc * 32 + 8 * fq) = w; }
    }
};
struct EpiResid {
    float* X; bf16_t* XB; float* part; float scale; LAS float* xt;
    __device__ __forceinline__ void operator()(const f32x4 (&acc)[2][2][4][2], const Unit& u, int wr, int wc, int fr, int fq) const {
#pragma unroll
        for (int ai = 0; ai < 2; ++ai) {
            f32x4 xv[4][2][2];
#pragma unroll
            for (int m = 0; m < 4; ++m)
#pragma unroll
                for (int bj = 0; bj < 2; ++bj) { const float* xp = X + ((long)u.pm * 256 + ai * 128 + wr * 64 + m * 16 + fr) * DM + u.pn * 256 + bj * 128 + wc * 32 + 8 * fq;
                    xv[m][bj][0] = *(const f32x4*)xp; xv[m][bj][1] = *(const f32x4*)(xp + 4); }
#pragma unroll
            for (int m = 0; m < 4; ++m) { const int rl = ai * 128 + wr * 64 + m * 16 + fr; const long row = (long)u.pm * 256 + rl; float ss = 0.f;
#pragma unroll
                for (int bj = 0; bj < 2; ++bj) { const int col = u.pn * 256 + bj * 128 + wc * 32 + 8 * fq;
                    float* xp = X + row * DM + col;
                    const f32x4 x0 = xv[m][bj][0] + acc[ai][bj][m][0] * scale, x1 = xv[m][bj][1] + acc[ai][bj][m][1] * scale;
                    *(f32x4*)xp = x0; *(f32x4*)(xp + 4) = x1;
                    u32x4 w; w.x = cvt_pk_bf16(x0[0], x0[1]); w.y = cvt_pk_bf16(x0[2], x0[3]); w.z = cvt_pk_bf16(x1[0], x1[1]); w.w = cvt_pk_bf16(x1[2], x1[3]);
                    *(u32x4*)(XB + row * DM + col) = w;
                    ss += (x0[0] * x0[0] + x0[1] * x0[1]) + (x0[2] * x0[2] + x0[3] * x0[3]) + (x1[0] * x1[0] + x1[1] * x1[1]) + (x1[2] * x1[2] + x1[3] * x1[3]); }
                ss += __shfl_xor(ss, 16); ss += __shfl_xor(ss, 32);
                if (fq == 0) xt[rl * 4 + wc] = ss; }
            asm volatile("" ::: "memory");
        }
        LBAR();
        const int lane = fq * 16 + fr;
        if (lane < 32) { const int q = wc * 32 + lane, rl = (q >> 6) * 128 + wr * 64 + (q & 63);
            const f32x4 s = *(const LAS f32x4*)(xt + rl * 4);
            part[((size_t)u.pm * 256 + rl) * 4 + u.pn] = (s[0] + s[1]) + (s[2] + s[3]); }
    }
};
struct EpiGlaProj {
    bf16_t* QK; float* GG; bf16_t* VV; bf16_t* AB; const float* part; const float* bgf; const float* bgb; int h;
    __device__ __forceinline__ void operator()(const f32x4 (&acc)[2][2][4][2], const Unit& u, int wr, int wc, int fr, int fq) const {
        float rs8[8]; rstd8(part, u.pm * 256 + wr * 64 + fr, rs8);
#pragma unroll
        for (int ai = 0; ai < 2; ++ai)
#pragma unroll
            for (int m = 0; m < 4; ++m) { const long row = (long)u.pm * 256 + ai * 128 + wr * 64 + m * 16 + fr; const float rs = rs8[ai * 4 + m];
#pragma unroll
                for (int bj = 0; bj < 2; ++bj) { const int col = bj * 128 + wc * 32 + 8 * fq;
                    f32x4 v0 = acc[ai][bj][m][0] * rs, v1 = acc[ai][bj][m][1] * rs;
                    if (u.pn == 1) {
                        const float* bp = (bj == 0 ? bgf : bgb) + h * 128 + wc * 32 + 8 * fq;
                        const f32x4 b0 = *(const f32x4*)bp, b1 = *(const f32x4*)(bp + 4);
#pragma unroll
                        for (int j = 0; j < 4; ++j) { float z = v0[j] + b0[j]; v0[j] = (fminf(z, 0.f) - __logf(1.0f + __expf(-fabsf(z)))) * (1.0f / 16.0f);
                                                      z = v1[j] + b1[j]; v1[j] = (fminf(z, 0.f) - __logf(1.0f + __expf(-fabsf(z)))) * (1.0f / 16.0f); }
                        float* gp = GG + row * 256 + col; *(f32x4*)gp = v0; *(f32x4*)(gp + 4) = v1;
                    } else {
                        if (u.pn == 3) {
#pragma unroll
                            for (int j = 0; j < 4; ++j) { v0[j] = v0[j] * __builtin_amdgcn_rcpf(1.0f + __expf(-v0[j])); v1[j] = v1[j] * __builtin_amdgcn_rcpf(1.0f + __expf(-v1[j])); } }
                        u32x4 w; w.x = cvt_pk_bf16(v0[0], v0[1]); w.y = cvt_pk_bf16(v0[2], v0[3]); w.z = cvt_pk_bf16(v1[0], v1[1]); w.w = cvt_pk_bf16(v1[2], v1[3]);
                        bf16_t* dst = u.pn == 0 ? QK + row * 256 + col : (u.pn == 2 ? VV + row * 256 + col : AB + row * DM + h * 256 + col);
                        *(u32x4*)dst = w; } } }
    }
};
struct EpiDilQK {
    bf16_t* O; const float* part; int r;
    __device__ __forceinline__ void operator()(const f32x4 (&acc)[2][2][4][2], const Unit& u, int wr, int wc, int fr, int fq) const {
        const int tok0 = dil_token0(u.pm * 256, r);
        float rs8[8];
        { f32x4 pp[8];
#pragma unroll
          for (int i = 0; i < 8; ++i) pp[i] = *(const f32x4*)(part + (size_t)(tok0 + ((i >> 2) * 128 + wr * 64 + (i & 3) * 16 + fr) * r) * 4);
#pragma unroll
          for (int i = 0; i < 8; ++i) rs8[i] = rsqrtf(((pp[i][0] + pp[i][1]) + (pp[i][2] + pp[i][3])) * (1.0f / 1024.0f) + EPS); }
#pragma unroll
        for (int ai = 0; ai < 2; ++ai)
#pragma unroll
            for (int m = 0; m < 4; ++m) { const int rl = ai * 128 + wr * 64 + m * 16 + fr; const long row = (long)u.pm * 256 + rl; const float rs = rs8[ai * 4 + m];
#pragma unroll
                for (int bj = 0; bj < 2; ++bj) { const int col = u.pn * 256 + bj * 128 + wc * 32 + 8 * fq;
                    const f32x4 v0 = acc[ai][bj][m][0] * rs, v1 = acc[ai][bj][m][1] * rs;
                    u32x4 w; w.x = cvt_pk_bf16(v0[0], v0[1]); w.y = cvt_pk_bf16(v0[2], v0[3]); w.z = cvt_pk_bf16(v1[0], v1[1]); w.w = cvt_pk_bf16(v1[2], v1[3]);
                    { const int kc = bj * 128 + wc * 32 + 8 * fq;
                      *(u32x4*)(O + (size_t)u.pn * T * 256 + (size_t)((row >> 5) * 16 + (kc >> 6) * 4 + ((kc & 63) >> 4)) * 512 + (row & 31) * 16 + (kc & 8)) = w; } }
                asm volatile("" ::: "memory"); }
    }
};
struct EpiDilVT {
    bf16_t* O; const float* part; int r;
    __device__ __forceinline__ void operator()(const f32x4 (&acc)[2][2][4][2], const Unit& u, int wr, int wc, int fr, int fq) const {
        const int tok0 = dil_token0(u.pn * 256, r);
#pragma unroll
        for (int bj = 0; bj < 2; ++bj) { const int cl = bj * 128 + wc * 32 + 8 * fq; float rs[8];
#pragma unroll
            for (int j = 0; j < 8; ++j) rs[j] = rstd_of(part, tok0 + (cl + j) * r);
#pragma unroll
            for (int ai = 0; ai < 2; ++ai)
#pragma unroll
                for (int m = 0; m < 4; ++m) { const int row = ai * 128 + wr * 64 + m * 16 + fr;
                    const f32x4 v0 = acc[ai][bj][m][0], v1 = acc[ai][bj][m][1];
                    u32x4 w; w.x = cvt_pk_bf16(v0[0] * rs[0], v0[1] * rs[1]); w.y = cvt_pk_bf16(v0[2] * rs[2], v0[3] * rs[3]);
                    w.z = cvt_pk_bf16(v1[0] * rs[4], v1[1] * rs[5]); w.w = cvt_pk_bf16(v1[2] * rs[6], v1[3] * rs[7]);
                    { const int n_ = u.pn * 256 + cl; *(u32x4*)(O + (size_t)(n_ >> 5) * 8192 + row * 32 + (n_ & 31)) = w; }
                    asm volatile("" ::: "memory"); } }
    }
};
struct EpiScores {
    bf16_t* P; const float* part; LAS f32x2* xt;
    __device__ __forceinline__ void operator()(const f32x4 (&acc)[2][2][4][2], const Unit& u, int wr, int wc, int fr, int fq) const {
        float rs8[8]; rstd8(part, u.pm * 256 + wr * 64 + fr, rs8);
#pragma unroll
        for (int ai = 0; ai < 2; ++ai)
#pragma unroll
            for (int m = 0; m < 4; ++m) { const int rl = ai * 128 + wr * 64 + m * 16 + fr; const float r_ = rs8[ai * 4 + m];
                float mx = -3.0e38f;
#pragma unroll
                for (int bj = 0; bj < 2; ++bj)
#pragma unroll
                    for (int n = 0; n < 2; ++n)
#pragma unroll
                        for (int j = 0; j < 4; ++j) mx = fmaxf(mx, acc[ai][bj][m][n][j] * r_);
                mx = fmaxf(mx, __shfl_xor(mx, 16)); mx = fmaxf(mx, __shfl_xor(mx, 32));
                float l = 0.f;
#pragma unroll
                for (int bj = 0; bj < 2; ++bj)
#pragma unroll
                    for (int n = 0; n < 2; ++n)
#pragma unroll
                        for (int j = 0; j < 4; ++j) l += __expf(acc[ai][bj][m][n][j] * r_ - mx);
                l += __shfl_xor(l, 16); l += __shfl_xor(l, 32);
                if (fq == 0) xt[rl * 4 + wc] = (f32x2){mx, l};
                asm volatile("" ::: "memory"); }
        LBAR();
#pragma unroll
        for (int ai = 0; ai < 2; ++ai)
#pragma unroll
            for (int m = 0; m < 4; ++m) { const int rl = ai * 128 + wr * 64 + m * 16 + fr; const long row = (long)u.pm * 256 + rl; const float r_ = rs8[ai * 4 + m];
                const f32x2 a = xt[rl * 4 + 0], b = xt[rl * 4 + 1], c = xt[rl * 4 + 2], d = xt[rl * 4 + 3];
                const float M = fmaxf(fmaxf(a.x, b.x), fmaxf(c.x, d.x));
                const float Ls = a.y * __expf(a.x - M) + b.y * __expf(b.x - M) + c.y * __expf(c.x - M) + d.y * __expf(d.x - M);
                const float inv = __builtin_amdgcn_rcpf(Ls);
#pragma unroll
                for (int bj = 0; bj < 2; ++bj) { const int col = u.pn * 256 + bj * 128 + wc * 32 + 8 * fq; float p[8];
#pragma unroll
                    for (int n = 0; n < 2; ++n)
#pragma unroll
                        for (int j = 0; j < 4; ++j) p[n * 4 + j] = __expf(acc[ai][bj][m][n][j] * r_ - M) * inv;
                    u32x4 w; w.x = cvt_pk_bf16(p[0], p[1]); w.y = cvt_pk_bf16(p[2], p[3]); w.z = cvt_pk_bf16(p[4], p[5]); w.w = cvt_pk_bf16(p[6], p[7]);
                    *(u32x4*)(P + row * DM + col) = w; }
                asm volatile("" ::: "memory"); }
    }
};


struct EpiAny {
    int kind;
    long o_off;
    int ldc, bstride; float scale; int h, r;
    __device__ __forceinline__ void operator()(const f32x4 (&acc)[2][2][4][2], const Unit& u, int wr, int wc, int fr, int fq, const Params& p, LAS unsigned char* lds) const {
        unsigned char* ws = p.ws; unsigned char* st = ws + OFF_STAGE; const float* part = (const float*)(ws + OFF_PART);
        if (EN(22) && kind == 0) { EpiPlain e{(bf16_t*)(ws + o_off), ldc, bstride}; e(acc, u, wr, wc, fr, fq); }
        else if (EN(23) && kind == 1) { EpiSwiGLU e{(bf16_t*)(ws + o_off), part}; e(acc, u, wr, wc, fr, fq); }
        else if (EN(24) && kind == 2) { EpiResid e{p.X, (bf16_t*)(ws + OFF_XB), (float*)(ws + OFF_PART), scale, (LAS float*)(lds + LDS_X)}; e(acc, u, wr, wc, fr, fq); }
        else if (EN(25) && kind == 3) { EpiGlaProj e{(bf16_t*)(st + ST_QK), (float*)(st + ST_GG), (bf16_t*)(st + ST_VV), (bf16_t*)(st + ST_ABUF), part, p.in[11], p.in[13], h}; e(acc, u, wr, wc, fr, fq); }
        else if (EN(26) && kind == 4) { EpiDilQK e{(bf16_t*)(ws + o_off), part, r}; e(acc, u, wr, wc, fr, fq); }
        else if (EN(27) && kind == 5) { EpiDilVT e{(bf16_t*)(ws + o_off), part, r}; e(acc, u, wr, wc, fr, fq); }
        else if (EN(28)) { EpiScores e{(bf16_t*)(ws + o_off), part, (LAS f32x2*)(lds + LDS_X)}; e(acc, u, wr, wc, fr, fq); }
    }
};

template <class Epi>
__device__ __forceinline__ void gemm_phase(LAS unsigned char* lds, const int K, const int lda, const int ldb, const Sched& S, const Epi& E) {
    int tid = threadIdx.x; asm volatile("" : "+v"(tid));
    const int wid = __builtin_amdgcn_readfirstlane(tid >> 6), lane = tid & 63, wr = wid >> 2, wc = wid & 3, fr = lane & 15, fq = lane >> 4;
    const int nt = K / BK;
    unsigned voffA[2], voffB[2];
#pragma unroll
    for (int i = 0; i < 2; ++i) { int R, C; stage_rc(tid * 16 + i * 8192, R, C); const int Rb = (R & ~31) + perm32(R & 31);
        voffA[i] = (unsigned)(R * lda + C) * 2u; voffB[i] = (unsigned)(Rb * ldb + C) * 2u; }
    const size_t kstep = (size_t)(BK * 2);
    const size_t hstepA = (size_t)HALF * lda * 2, hstepB = (size_t)HALF * ldb * 2;
    const unsigned ldsw = (unsigned)wid * 1024u;
    const int aoff = lds_byte(wr * 64 + fr, fq * 8), boff = lds_byte(wc * 32 + fr, fq * 8);
#define PG8_SA(b, h) (((b) * 2 + (h)) * HTB)
#define PG8_SB(b, h) ((4 + (b) * 2 + (h)) * HTB)
#define PG8_STAGE(bufoff, gbase, voff) do { _Pragma("unroll") for (int _i = 0; _i < 2; ++_i) \
        __builtin_amdgcn_global_load_lds((const unsigned*)((const char*)(gbase) + (voff)[_i]), (LAS unsigned*)(lds + (bufoff) + ldsw + _i * 8192), 16, 0, 0); } while (0)
#define PG8_LDA(dst, b, h) do { _Pragma("unroll") for (int m = 0; m < 4; ++m) _Pragma("unroll") for (int k = 0; k < 2; ++k) dst[m][k] = *(const LAS bf16x8*)(lds + PG8_SA(b, h) + aoff + m * 2048 + k * 1024); } while (0)
#define PG8_LDB(dst, b, h) do { _Pragma("unroll") for (int n = 0; n < 2; ++n) _Pragma("unroll") for (int k = 0; k < 2; ++k) dst[n][k] = *(const LAS bf16x8*)(lds + PG8_SB(b, h) + boff + n * 2048 + k * 1024); } while (0)
#define PG8_MMA(ai, bj, At, Bt) do { __builtin_amdgcn_s_setprio(1); _Pragma("unroll") for (int m = 0; m < 4; ++m) _Pragma("unroll") for (int n = 0; n < 2; ++n) _Pragma("unroll") for (int k = 0; k < 2; ++k) \
        acc[ai][bj][m][n] = __builtin_amdgcn_mfma_f32_16x16x32_bf16(Bt[n][k], At[m][k], acc[ai][bj][m][n], 0, 0, 0); __builtin_amdgcn_s_setprio(0); } while (0)
#define PG8_WAIT_V(n) asm volatile("s_waitcnt vmcnt(" #n ")" ::: "memory")
#define PG8_WAIT_L(n) asm volatile("s_waitcnt lgkmcnt(" #n ")" ::: "memory")
#define PG8_BAR __builtin_amdgcn_s_barrier()
#define PG8_SCHED __builtin_amdgcn_sched_barrier(0)
    Unit cur, nxt; int ui = 0;
    if (!S.next(0, cur)) return;
    f32x4 acc[2][2][4][2];
#pragma unroll
    for (int a = 0; a < 2; ++a)
#pragma unroll
        for (int b = 0; b < 2; ++b)
#pragma unroll
            for (int m = 0; m < 4; ++m)
#pragma unroll
                for (int n = 0; n < 2; ++n) acc[a][b][m][n] = (f32x4){0.f, 0.f, 0.f, 0.f};
    bf16x8 At[4][2], B0[2][2], B1[2][2];
    const char* cA = cur.a; const char* cB = cur.bt;
#if GP_SP2
    PG8_STAGE(PG8_SB(0, 0), cB, voffB); PG8_STAGE(PG8_SB(0, 1), cB + hstepB, voffB); PG8_STAGE(PG8_SA(0, 0), cA, voffA); PG8_STAGE(PG8_SA(0, 1), cA + hstepA, voffA);
    if (wr == 1) PG8_BAR;
    PG8_WAIT_V(2); PG8_BAR;
    PG8_STAGE(PG8_SB(1, 0), cB + kstep, voffB); PG8_STAGE(PG8_SA(1, 0), cA + kstep, voffA); PG8_STAGE(PG8_SB(1, 1), cB + hstepB + kstep, voffB);
    PG8_WAIT_V(6); PG8_BAR;
#else
    PG8_STAGE(PG8_SB(0, 0), cB, voffB); PG8_STAGE(PG8_SA(0, 0), cA, voffA); PG8_STAGE(PG8_SB(0, 1), cB + hstepB, voffB); PG8_STAGE(PG8_SA(0, 1), cA + hstepA, voffA);
    if (wr == 1) PG8_BAR;
    PG8_WAIT_V(4); PG8_BAR;
    PG8_STAGE(PG8_SB(1, 0), cB + kstep, voffB); PG8_STAGE(PG8_SA(1, 0), cA + kstep, voffA); PG8_STAGE(PG8_SB(1, 1), cB + hstepB + kstep, voffB);
    PG8_WAIT_V(6); PG8_BAR;
#endif
    for (;;) {
        const bool has_next = S.next(ui + 1, nxt);
        const char* nA = has_next ? nxt.a : cA; const char* nB = has_next ? nxt.bt : cB;
        for (int t = 0; t < nt; t += 2) {
            const bool last = (t == nt - 2);
            const char* a1 = cA + (size_t)(t + 1) * kstep;
            const char* a2 = last ? nA : cA + (size_t)(t + 2) * kstep; const char* b2 = last ? nB : cB + (size_t)(t + 2) * kstep;
            const char* a3 = a2 + kstep; const char* b3 = b2 + kstep;
#if GP_SP2
            PG8_LDB(B0, 0, 0); PG8_LDB(B1, 0, 1); PG8_SCHED; PG8_LDA(At, 0, 0); PG8_STAGE(PG8_SA(1, 1), a1 + hstepA, voffA);
            PG8_WAIT_V(8); PG8_WAIT_L(0); PG8_BAR; PG8_MMA(0, 0, At, B0); PG8_MMA(0, 1, At, B1); PG8_BAR; PG8_SCHED;
            PG8_LDA(At, 0, 1); PG8_STAGE(PG8_SB(0, 0), b2, voffB); PG8_STAGE(PG8_SB(0, 1), b2 + hstepB, voffB); PG8_STAGE(PG8_SA(0, 0), a2, voffA);
            PG8_WAIT_V(8); PG8_WAIT_L(0); PG8_BAR; PG8_MMA(1, 0, At, B0); PG8_MMA(1, 1, At, B1); PG8_BAR; PG8_SCHED;
            PG8_LDB(B0, 1, 0); PG8_LDB(B1, 1, 1); PG8_SCHED; PG8_LDA(At, 1, 0); PG8_STAGE(PG8_SA(0, 1), a2 + hstepA, voffA);
            PG8_WAIT_V(8); PG8_WAIT_L(0); PG8_BAR; PG8_MMA(0, 0, At, B0); PG8_MMA(0, 1, At, B1); PG8_BAR; PG8_SCHED;
            PG8_LDA(At, 1, 1); PG8_STAGE(PG8_SB(1, 0), b3, voffB); PG8_STAGE(PG8_SB(1, 1), b3 + hstepB, voffB); PG8_STAGE(PG8_SA(1, 0), a3, voffA);
            PG8_WAIT_V(8); PG8_WAIT_L(0); PG8_BAR; PG8_MMA(1, 0, At, B0); PG8_MMA(1, 1, At, B1); PG8_BAR; PG8_SCHED;
#else
            PG8_LDB(B0, 0, 0); PG8_SCHED; PG8_LDA(At, 0, 0); PG8_STAGE(PG8_SA(1, 1), a1 + hstepA, voffA);
            PG8_WAIT_L(8); PG8_BAR; PG8_WAIT_L(0); PG8_MMA(0, 0, At, B0); PG8_BAR; PG8_SCHED;
            PG8_LDB(B1, 0, 1); PG8_STAGE(PG8_SB(0, 0), b2, voffB);
            PG8_BAR; PG8_WAIT_L(0); PG8_MMA(0, 1, At, B1); PG8_BAR;
            PG8_LDA(At, 0, 1); PG8_STAGE(PG8_SA(0, 0), a2, voffA);
            PG8_BAR; PG8_WAIT_L(0); PG8_MMA(1, 0, At, B0); PG8_BAR; PG8_SCHED;
            PG8_STAGE(PG8_SB(0, 1), b2 + hstepB, voffB);
            PG8_WAIT_V(6); PG8_BAR; PG8_MMA(1, 1, At, B1); PG8_BAR;
            PG8_LDB(B0, 1, 0); PG8_SCHED; PG8_LDA(At, 1, 0); PG8_STAGE(PG8_SA(0, 1), a2 + hstepA, voffA);
            PG8_WAIT_L(8); PG8_BAR; PG8_WAIT_L(0); PG8_MMA(0, 0, At, B0); PG8_BAR; PG8_SCHED;
            PG8_LDB(B1, 1, 1); PG8_STAGE(PG8_SB(1, 0), b3, voffB);
            PG8_BAR; PG8_WAIT_L(0); PG8_MMA(0, 1, At, B1); PG8_BAR;
            PG8_LDA(At, 1, 1); PG8_STAGE(PG8_SA(1, 0), a3, voffA);
            PG8_BAR; PG8_WAIT_L(0); PG8_MMA(1, 0, At, B0); PG8_BAR; PG8_SCHED;
            PG8_STAGE(PG8_SB(1, 1), b3 + hstepB, voffB);
            PG8_WAIT_V(6); PG8_BAR; PG8_MMA(1, 1, At, B1); PG8_BAR;
#endif
        }
#if GP_ALIGN
        if (wr == 0) PG8_BAR;
#endif
        { int t2 = threadIdx.x; asm volatile("" : "+v"(t2)); const int w2 = __builtin_amdgcn_readfirstlane(t2 >> 6), l2 = t2 & 63;
          E(acc, cur, w2 >> 2, w2 & 3, l2 & 15, l2 >> 4); }
        if (!has_next) break;
#pragma unroll
        for (int a = 0; a < 2; ++a)
#pragma unroll
            for (int b = 0; b < 2; ++b)
#pragma unroll
                for (int m = 0; m < 4; ++m)
#pragma unroll
                    for (int n = 0; n < 2; ++n) acc[a][b][m][n] = (f32x4){0.f, 0.f, 0.f, 0.f};
        cur = nxt; cA = nA; cB = nB; ++ui;
#if GP_ALIGN
        if (wr == 1) PG8_BAR;
#endif
    }
    PG8_WAIT_V(0);
#if !GP_ALIGN
    if (wr == 0) PG8_BAR;
#endif
    PG8_BAR;
#undef PG8_SA
#undef PG8_SB
#undef PG8_STAGE
#undef PG8_LDA
#undef PG8_LDB
#undef PG8_MMA
#undef PG8_WAIT_V
#undef PG8_WAIT_L
#undef PG8_BAR
#undef PG8_SCHED
}

__device__ __forceinline__ Sched mk_sched(const void* A, const void* Bt, int M, int N, int lda, int ldb, int rot) {
    Sched s; s.A = (const char*)A; s.Bt = (const char*)Bt; s.a_tile = 256 * lda * 2; s.b_tile = 256 * ldb * 2; s.a_batch = 0; s.b_batch = 0; s.seqB = 0;
    s.nM = M / 256; s.nN = N / 256; s.nB = 1; s.G = gridDim.x; s.c = (int)((blockIdx.x + (unsigned)rot) % gridDim.x); s.mode = 0; s.r = 1; return s;
}


struct GemmJob { int K, lda, ldb; Sched s; EpiAny e; };
__device__ __forceinline__ int rotc(int rot) { return (int)((blockIdx.x + gridDim.x - ((unsigned)rot % gridDim.x)) % gridDim.x); }
__device__ __forceinline__ bool get_job(const Params& p, int op, int arg, int j, GemmJob& J) {
    unsigned char* ws = p.ws; bf16_t* WB = (bf16_t*)ws; bf16_t* XB = (bf16_t*)(ws + OFF_XB); unsigned char* st = ws + OFF_STAGE;
    EpiAny e; e.kind = 0; e.o_off = 0; e.ldc = DM; e.bstride = 0; e.scale = 1.0f; e.h = 0; e.r = 1;
    J.K = DM; J.lda = DM; J.ldb = DM;
    if (op == 1) {
        if (j == 0) { J.s = mk_sched(st + ST_MEMN, WB + E_CKV, 768, 2048, DM, DM, 0); e.o_off = OFF_STAGE + ST_KV; e.ldc = 2048; }
        else if (j == 1) { J.s = mk_sched(XB, WB + E_FFN1_IN, T, 2 * DFF, DM, DM, 0); J.s.c = rotc(24); e.kind = 1; e.o_off = OFF_STAGE + ST_HID; }
        else return false;
    } else if (op == 2) {
        if (j == 0) { J.s = mk_sched(st + ST_HID, WB + E_FFN1_OUT, T, DM, DFF, DFF, 0); J.K = DFF; J.lda = DFF; J.ldb = DFF; e.kind = 2; e.scale = 0.5f; }
        else if (j <= 3) { const int sq = j - 1;
            J.s = mk_sched((const char*)(st + ST_KV) + (size_t)sq * 256 * 2048 * 2, WB + E_CQ, 256, 1024, 2048, DM, 0); J.s.nB = 4; J.s.a_batch = 512; J.s.b_batch = 512; J.s.c = rotc(sq * 16);
            J.K = 256; J.lda = 2048; J.ldb = DM; e.o_off = (E_GT + (size_t)sq * DM * DM) * 2; e.ldc = DM; e.bstride = 256 * DM; }
        else if (j <= 6) { const int sq = j - 4;
            J.s = mk_sched(WB + E_CO, (const char*)(st + ST_KV) + (size_t)sq * 256 * 2048 * 2 + 1024 * 2, 1024, 256, DM, 2048, 0); J.s.nB = 4; J.s.a_batch = 512; J.s.b_batch = 512; J.s.c = rotc(48 + sq * 16);
            J.K = 256; J.lda = DM; J.ldb = 2048; e.o_off = (E_HM + (size_t)sq * DM * DM) * 2; e.ldc = DM; e.bstride = 256; }
        else return false;
    } else if (op == 3) { if (j) return false; J.s = mk_sched(st + ST_ABUF, WB + E_MIX_OUT, T, DM, DM, DM, 0); e.kind = 2; }
    else if (op == 4) { if (j) return false; J.s = mk_sched(XB, WB + E_GT, T, DM, DM, DM, 0); J.s.mode = 1; J.s.seqB = DM * DM * 2; e.kind = 6; e.o_off = OFF_STAGE + ST_ABUF; }
    else if (op == 5) { if (j) return false; J.s = mk_sched(st + ST_ABUF, WB + E_HM, T, DM, DM, DM, 0); J.s.mode = 1; J.s.seqB = DM * DM * 2; e.kind = 2; }
    else if (op == 6) { if (j) return false; J.s = mk_sched(XB, WB + E_FFN2_IN, T, 2 * DFF, DM, DM, 0); e.kind = 1; e.o_off = OFF_STAGE + ST_HID; }
    else if (op == 7) { if (j) return false; J.s = mk_sched(st + ST_HID, WB + E_FFN2_OUT, T, DM, DFF, DFF, 0); J.K = DFF; J.lda = DFF; J.ldb = DFF; e.kind = 2; e.scale = 0.5f; }
    else if (op == 10) { if (j) return false; J.s = mk_sched(XB, WB + E_MIX_IN + (size_t)arg * 1024 * DM, T, 1024, DM, DM, 0); e.kind = 3; e.h = arg; }
    else if (op == 20) { if (j >= 6) return false; const int g = j >> 1, r = g == 0 ? 1 : (g == 1 ? 4 : 16); e.r = r;
        if ((j & 1) == 0) { J.s = mk_sched(XB, WB + E_MIX_IN + (size_t)(arg * 2304 + g * 512) * DM, T, 512, r * DM, DM, 0); J.s.mode = 2; J.s.r = r; J.s.c = rotc(g * 384);
            J.lda = r * DM; e.kind = 4; e.o_off = OFF_STAGE + ST_QKG + (size_t)g * T * 512 * 2; }
        else { J.s = mk_sched(WB + E_MIX_IN + (size_t)(arg * 2304 + 1536 + g * 256) * DM, XB, 256, T, DM, r * DM, 0); J.s.mode = 3; J.s.r = r; J.s.c = rotc(g * 384 + 256);
            J.ldb = r * DM; e.kind = 5; e.o_off = OFF_STAGE + ST_VTG + (size_t)g * 256 * T * 2; } }
    else return false;
    J.e = e; return true;
}

template <int NT>
__device__ __forceinline__ void conv_tiles(const float* src, int ld_src, const int (&k0)[NT], const int (&n0)[NT], bf16_t* dst, int ld_dst, const int (&dr0)[NT], const float* gain,
                                           const float (&scale)[NT], int nvalid, LAS float* tile) {
    int tid = threadIdx.x; asm volatile("" : "+v"(tid)); const int tx = tid & 63, ty = tid >> 6;
    float v[NT][8];
#pragma unroll
    for (int t = 0; t < NT; ++t) if (t < nvalid) {
#pragma unroll
        for (int i = 0; i < 8; ++i) v[t][i] = src[(size_t)(k0[t] + ty + 8 * i) * ld_src + n0[t] + tx];
    }
#pragma unroll
    for (int t = 0; t < NT; ++t) if (t < nvalid) {
#pragma unroll
        for (int i = 0; i < 8; ++i) { float x = v[t][i] * scale[t]; if (gain) x *= gain[k0[t] + ty + 8 * i]; tile[t * 4160 + (ty + 8 * i) * 65 + tx] = x; }
    }
    __syncthreads();
    const int i2 = tid & 31;
#pragma unroll
    for (int t = 0; t < NT; ++t) if (t < nvalid) {
#pragma unroll
        for (int jj = 0; jj < 4; ++jj) { const int j = (tid >> 5) + 16 * jj; const float a = tile[t * 4160 + (2 * i2) * 65 + j], b = tile[t * 4160 + (2 * i2 + 1) * 65 + j];
            *(unsigned*)(dst + (size_t)(dr0[t] + j) * ld_dst + k0[t] + 2 * i2) = cvt_pk_bf16(a, b); }
    }
    __syncthreads();
}
__device__ __forceinline__ int map_row(int kind, int n0, float& scale) {
    scale = 1.0f;
    if (EN(23) && kind == 1) { if (n0 < DFF) return (n0 / 128) * 256 + (n0 % 128); const int j = n0 - DFF; return (j / 128) * 256 + 128 + (j % 128); }
    if (EN(24) && kind == 2) {
        if (n0 < 512) { scale = 0.08838834764831845f; return (n0 / 128) * 1024 + (n0 % 128); }
        if (n0 < 1024) { const int j = n0 - 512; return (j / 128) * 1024 + 128 + (j % 128); }
        if (n0 < 2048) { const int j = n0 - 1024; return (j / 256) * 1024 + 512 + (j % 256); }
        const int j = n0 - 2048; return (j / 256) * 1024 + 768 + (j % 256);
    }
    if (EN(25) && kind == 3) { const int tg = n0 / 1024, h = (n0 % 1024) / 64, t = tg / 3, g = tg % 3, hc = h >> 2, hl = h & 3;
        if (t == 0) scale = 0.125f;
        if (t < 2) return hc * 2304 + g * 512 + t * 256 + hl * 64;
        return hc * 2304 + 1536 + g * 256 + hl * 64; }
    return n0;
}
__device__ __forceinline__ void conv_weight(const float* src, int K, int N, int ld_src, bf16_t* dst, const float* gain, int kind, LAS float* tile, int& rot) {
    constexpr int NT = 4;
    const int nk = K / 64, nn = N / 64, tot = nk * nn, G = gridDim.x;
    for (int t0 = (int)((blockIdx.x + G - (rot % G)) % G); t0 < tot; t0 += G * NT) {
        int k0[NT], n0[NT], dr0[NT]; float sc[NT]; int nvalid = 0;
#pragma unroll
        for (int j = 0; j < NT; ++j) { const int t = t0 + j * G; const bool ok = t < tot; const int tt = ok ? t : t0; const int kt = tt % nk, ntile = tt / nk;
            k0[j] = kt * 64; n0[j] = ntile * 64; dr0[j] = map_row(kind, ntile * 64, sc[j]); nvalid += ok ? 1 : 0; }
        conv_tiles<NT>(src, ld_src, k0, n0, dst, K, dr0, gain, sc, nvalid, tile);
    }
    rot += tot;
}
__device__ __forceinline__ const float* x_in_row(const Params& p, int t) { return t < 16384 ? p.in[0] + (size_t)t * DM : p.in[1] + (size_t)(t - 16384) * DM; }

__device__ __forceinline__ void phase_prologue(const Params& p, int layer, LAS unsigned char* lds) {
    unsigned char* ws = p.ws; bf16_t* WB = (bf16_t*)ws; LAS float* tile = (LAS float*)lds;
    int tid = threadIdx.x; asm volatile("" : "+v"(tid)); const int lane = tid & 63, wid = tid >> 6, nwv = gridDim.x * 8, gw = blockIdx.x * 8 + wid;
    int rot = 0;
    conv_weight(p.in[6] + (size_t)layer * DM * 2 * DFF, DM, 2 * DFF, 2 * DFF, WB + E_FFN1_IN, p.in[5] + layer * DM, 1, tile, rot);
    conv_weight(p.in[7] + (size_t)layer * DFF * DM, DFF, DM, DM, WB + E_FFN1_OUT, nullptr, 0, tile, rot);
    conv_weight(p.in[24] + (size_t)layer * DM * 2 * DFF, DM, 2 * DFF, 2 * DFF, WB + E_FFN2_IN, p.in[23] + layer * DM, 1, tile, rot);
    conv_weight(p.in[25] + (size_t)layer * DFF * DM, DFF, DM, DM, WB + E_FFN2_OUT, nullptr, 0, tile, rot);
    conv_weight(p.in[21] + (size_t)layer * DM * 2048, DM, 2048, 2048, WB + E_CKV, nullptr, 0, tile, rot);
    conv_weight(p.in[22] + (size_t)layer * DM * DM, DM, DM, DM, WB + E_CO, nullptr, 0, tile, rot);
    if (layer == 0) {
        conv_weight(p.in[9], DM, 3072, 3104, WB + E_MIX_IN, p.in[8], 2, tile, rot);
        conv_weight(p.in[15], DM, DM, DM, WB + E_MIX_OUT, nullptr, 0, tile, rot);
        for (size_t idx = (size_t)blockIdx.x * 512 + tid; idx < (size_t)2 * 512 * 1024; idx += (size_t)gridDim.x * 512) {
            const int c = (int)(idx & 1023), n = (int)((idx >> 10) & 511), dir = (int)(idx >> 19);
            const float* wi = p.in[9] + (size_t)c * 3104 + 3072 + dir * 16; const float* wg = (dir ? p.in[12] : p.in[10]) + n;
            float s = 0.f;
#pragma unroll
            for (int r = 0; r < 16; ++r) s += wi[r] * wg[r * 512];
            s *= p.in[8][c];
            WB[E_MIX_IN + (size_t)((n >> 7) * 1024 + 256 + dir * 128 + (n & 127)) * DM + c] = f2bf(s);
        }
    } else {
        conv_weight(p.in[16], DM, 9216, 9216, WB + E_MIX_IN, p.in[8] + DM, 3, tile, rot);
        conv_weight(p.in[17], DM, DM, DM, WB + E_MIX_OUT, nullptr, 0, tile, rot);
    }
    { const float* src = p.in[20] + (size_t)layer * DM * DM; const float* g = p.in[18] + layer * DM;
      for (size_t idx = ((size_t)blockIdx.x * 512 + tid) * 4; idx < (size_t)DM * DM; idx += (size_t)gridDim.x * 512 * 4) {
          const f32x4 v = *(const f32x4*)(src + idx); const float s = g[idx >> 10] * 0.0625f;
          u32x2 w; w.x = cvt_pk_bf16(v[0] * s, v[1] * s); w.y = cvt_pk_bf16(v[2] * s, v[3] * s);
          *(u32x2*)(WB + E_CQ + idx) = w; } }
    { bf16_t* MEMN = (bf16_t*)(ws + OFF_STAGE + ST_MEMN); const float* g = p.in[19] + layer * DM;
      for (int row = gw; row < 768; row += nwv) {
          const float* src = row < 512 ? p.in[2] + (size_t)row * DM : p.in[3] + (size_t)(row - 512) * DM;
          f32x4 v[4]; float ss = 0.f;
#pragma unroll
          for (int i = 0; i < 4; ++i) { v[i] = *(const f32x4*)(src + i * 256 + lane * 4); ss += (v[i][0] * v[i][0] + v[i][1] * v[i][1]) + (v[i][2] * v[i][2] + v[i][3] * v[i][3]); }
#pragma unroll
          for (int o = 1; o < 64; o <<= 1) ss += __shfl_xor(ss, o);
          const float rs = rsqrtf(ss * (1.0f / 1024.0f) + EPS);
#pragma unroll
          for (int i = 0; i < 4; ++i) { const f32x4 gg = *(const f32x4*)(g + i * 256 + lane * 4);
              u32x2 w; w.x = cvt_pk_bf16(v[i][0] * rs * gg[0], v[i][1] * rs * gg[1]); w.y = cvt_pk_bf16(v[i][2] * rs * gg[2], v[i][3] * rs * gg[3]);
              *(u32x2*)(MEMN + (size_t)row * DM + i * 256 + lane * 4) = w; } } }
    if (layer == 0) {
        bf16_t* XB = (bf16_t*)(ws + OFF_XB); float* part = (float*)(ws + OFF_PARTV);
        for (int row = gw; row < T; row += nwv) {
            const float* src = x_in_row(p, row); f32x4 v[4]; float ss = 0.f;
#pragma unroll
            for (int i = 0; i < 4; ++i) { v[i] = *(const f32x4*)(src + i * 256 + lane * 4); ss += (v[i][0] * v[i][0] + v[i][1] * v[i][1]) + (v[i][2] * v[i][2] + v[i][3] * v[i][3]); }
#pragma unroll
            for (int o = 1; o < 64; o <<= 1) ss += __shfl_xor(ss, o);
#pragma unroll
            for (int i = 0; i < 4; ++i) { *(f32x4*)(p.X + (size_t)row * DM + i * 256 + lane * 4) = v[i];
                u32x2 w; w.x = cvt_pk_bf16(v[i][0], v[i][1]); w.y = cvt_pk_bf16(v[i][2], v[i][3]);
                *(u32x2*)(XB + (size_t)row * DM + i * 256 + lane * 4) = w; }
            if (lane == 0) *(f32x4*)(part + (size_t)row * 4) = (f32x4){ss, 0.f, 0.f, 0.f};
        }
        float* bt = (float*)(ws + OFF_BTAB);
        for (int idx = blockIdx.x * 512 + tid; idx < 3 * 16 * 129; idx += gridDim.x * 512) {
            const int rel = idx % 129 - 64, h = (idx / 129) % 16, g = idx / (129 * 16); const int r = g == 0 ? 1 : (g == 1 ? 4 : 16);
            const int rr = rel * r, n = rr < 0 ? -rr : rr; int bk;
            if (n < 8) bk = n; else bk = 8 + (n >= 15) + (n >= 27) + (n >= 50) + (n >= 91) + (n >= 166) + (n >= 305) + (n >= 559);
            if (rr > 0) bk += 16;
            bt[idx] = p.in[4][bk * 48 + g * 16 + h];
        }
    }
}

__device__ __forceinline__ void phase_final(const Params& p) {
    const float* part = (const float*)(p.ws + OFF_PARTV + 8 * PARTV_BYTES); const float* g = p.in[26];
    int tid = threadIdx.x; asm volatile("" : "+v"(tid)); const int lane = tid & 63, wid = tid >> 6, nwv = gridDim.x * 8, gw = blockIdx.x * 8 + wid;
    for (int row = gw; row < T; row += nwv) { const float rs = rstd_of(part, row);
#pragma unroll
        for (int i = 0; i < 4; ++i) { float* xp = p.X + (size_t)row * DM + i * 256 + lane * 4; const f32x4 v = ld_sys16f(xp); const f32x4 gg = *(const f32x4*)(g + i * 256 + lane * 4);
            *(f32x4*)xp = (f32x4){v[0] * rs * gg[0], v[1] * rs * gg[1], v[2] * rs * gg[2], v[3] * rs * gg[3]}; } }
}

__device__ __forceinline__ void gla_combine(const Params& p, int h) {
    unsigned char* st = p.ws + OFF_STAGE; const float* OF = (const float*)(st + ST_OF); const float* OB = (const float*)(st + ST_OB); bf16_t* AB = (bf16_t*)(st + ST_ABUF);
    const float* gn = p.in[14] + h * 256;
    int tid = threadIdx.x; asm volatile("" : "+v"(tid)); const int lane = tid & 63, wid = tid >> 6, nwv = gridDim.x * 8, gw = blockIdx.x * 8 + wid;
    const f32x4 gg = *(const f32x4*)(gn + lane * 4);
    for (int row = gw; row < T; row += nwv) {
        const f32x4 a = ld_sys16f(OF + (size_t)row * 256 + lane * 4), b = ld_sys16f(OB + (size_t)row * 256 + lane * 4);
        const f32x4 o = a + b; float ss = (o[0] * o[0] + o[1] * o[1]) + (o[2] * o[2] + o[3] * o[3]);
#pragma unroll
        for (int s = 1; s < 64; s <<= 1) ss += __shfl_xor(ss, s);
        const float rs = rsqrtf(ss * (1.0f / 256.0f) + EPS);
        bf16_t* ap = AB + (size_t)row * DM + h * 256 + lane * 4; const u32x2 rr = ld_sys8(ap);
        const float r0 = __uint_as_float(rr.x << 16), r1 = __uint_as_float(rr.x & 0xffff0000u), r2 = __uint_as_float(rr.y << 16), r3 = __uint_as_float(rr.y & 0xffff0000u);
        u32x2 w; w.x = cvt_pk_bf16(o[0] * rs * gg[0] * r0, o[1] * rs * gg[1] * r1); w.y = cvt_pk_bf16(o[2] * rs * gg[2] * r2, o[3] * rs * gg[3] * r3);
        *(u32x2*)ap = w;
    }
}

constexpr int SC_QP = 0, SC_KP = 17408, SC_KT = 34816, SC_VT = 53248, SC_ATT = 62464, SC_SS = 71680, SC_QS = 89088, SC_BL = 91136;

template <bool OUT>
__device__ __forceinline__ void gla_scan(const Params& p, LAS unsigned char* lds) {
    unsigned char* st = p.ws + OFF_STAGE;
    const bf16_t* QK = (const bf16_t*)(st + ST_QK); const float* GG = (const float*)(st + ST_GG); const bf16_t* VV = (const bf16_t*)(st + ST_VV);
    float* SLOC = (float*)(st + ST_SLOC); float* DVEC = (float*)(st + ST_DVEC);
    int tid = threadIdx.x; asm volatile("" : "+v"(tid)); const int lane = tid & 63, w = tid >> 6, l15 = lane & 15, quad = lane >> 4;
    LAS bf16_t* QP = (LAS bf16_t*)(lds + SC_QP); LAS bf16_t* KP = (LAS bf16_t*)(lds + SC_KP); LAS bf16_t* KT = (LAS bf16_t*)(lds + SC_KT);
    LAS bf16_t* VT = (LAS bf16_t*)(lds + SC_VT); LAS bf16_t* ATT = (LAS bf16_t*)(lds + SC_ATT); LAS bf16_t* SS = (LAS bf16_t*)(lds + SC_SS);
    LAS float* QS = (LAS float*)(lds + SC_QS); LAS float* BL = (LAS float*)(lds + SC_BL);
    for (int unit = blockIdx.x; unit < 256; unit += gridDim.x) {
        const int slice = unit & 3, dir = (unit >> 2) & 1, seg = unit >> 3;
        const int sfirst = seg < 8 ? 0 : (seg < 16 ? 8 : 16), nseg = seg < 16 ? 8 : 16;
        const int sigma = dir == 0 ? seg - sfirst : sfirst + nseg - 1 - seg;
        float* oout = (float*)(st + (dir == 0 ? ST_OF : ST_OB));
        f32x4 S[4];
#pragma unroll
        for (int d = 0; d < 4; ++d) S[d] = (f32x4){0.f, 0.f, 0.f, 0.f};
        if (OUT) {
            for (int sp = 0; sp < sigma; ++sp) {
                const int sg = dir == 0 ? sfirst + sp : sfirst + nseg - 1 - sp;
                const float* sl = SLOC + (size_t)(sg * 2 + dir) * 128 * 256; const float* dv = DVEC + (size_t)(sg * 2 + dir) * 128;
#pragma unroll
                for (int r = 0; r < 4; ++r) { const int dk = 16 * w + 4 * quad + r; const float dd = ldsys_f(dv + dk);
#pragma unroll
                    for (int d = 0; d < 4; ++d) S[d][r] = S[d][r] * dd + ldsys_f(sl + (size_t)dk * 256 + slice * 64 + d * 16 + l15); }
            }
        }
        float dsum = 0.f;
        const int dkc = tid & 127, qr = tid >> 7;
        const int dvc = tid & 63, jr = tid >> 6;
        for (int ch = 0; ch < 16; ++ch) {
            const int tb = seg * 1024 + (dir == 0 ? ch * 64 : (15 - ch) * 64);
            float g[16]; float q[16], k[16];
#pragma unroll
            for (int ii = 0; ii < 16; ++ii) { const int ip = qr * 16 + ii; const int tok = tb + (dir == 0 ? ip : 63 - ip);
                g[ii] = ldsys_f(GG + (size_t)tok * 256 + dir * 128 + dkc);
                if (OUT) q[ii] = bf2f(ldsys_h(QK + (size_t)tok * 256 + dkc));
                k[ii] = bf2f(ldsys_h(QK + (size_t)tok * 256 + 128 + dkc)); }
            unsigned vpk[4];
            { float v[8];
#pragma unroll
              for (int jj = 0; jj < 8; ++jj) { const int jp = jr * 8 + jj; const int tok = tb + (dir == 0 ? jp : 63 - jp); v[jj] = bf2f(ldsys_h(VV + (size_t)tok * 256 + slice * 64 + dvc)); }
#pragma unroll
              for (int jj = 0; jj < 4; ++jj) vpk[jj] = cvt_pk_bf16(v[2 * jj], v[2 * jj + 1]); }
#pragma unroll
            for (int ii = 1; ii < 16; ++ii) g[ii] += g[ii - 1];
            QS[qr * 128 + dkc] = g[15];
            *(LAS u32x4*)(VT + dvc * 72 + jr * 8) = (u32x4){vpk[0], vpk[1], vpk[2], vpk[3]};
            __syncthreads();
            float off = 0.f, tot = 0.f;
#pragma unroll
            for (int qq = 0; qq < 4; ++qq) { const float s = QS[qq * 128 + dkc]; tot += s; if (qq < qr) off += s; }
            if (qr == 0) { BL[dkc] = __expf(tot); dsum += tot; }
            unsigned kt[8];
#pragma unroll
            for (int ii = 0; ii < 16; ii += 2) {
                const float b0 = off + g[ii], b1 = off + g[ii + 1];
                if (OUT) { const int ip = qr * 16 + ii;
                    QP[ip * 136 + dkc] = f2bf(q[ii] * __expf(b0)); QP[(ip + 1) * 136 + dkc] = f2bf(q[ii + 1] * __expf(b1));
                    KP[ip * 136 + dkc] = f2bf(k[ii] * __expf(-b0)); KP[(ip + 1) * 136 + dkc] = f2bf(k[ii + 1] * __expf(-b1)); }
                kt[ii >> 1] = cvt_pk_bf16(k[ii] * __expf(tot - b0), k[ii + 1] * __expf(tot - b1));
            }
            *(LAS u32x4*)(KT + dkc * 72 + qr * 16) = (u32x4){kt[0], kt[1], kt[2], kt[3]};
            *(LAS u32x4*)(KT + dkc * 72 + qr * 16 + 8) = (u32x4){kt[4], kt[5], kt[6], kt[7]};
            if (OUT) {
#pragma unroll
                for (int d = 0; d < 4; ++d) { u32x2 sw; sw.x = cvt_pk_bf16(S[d][0], S[d][1]); sw.y = cvt_pk_bf16(S[d][2], S[d][3]);
                    *(LAS u32x2*)(SS + (d * 16 + l15) * 136 + 16 * w + 4 * quad) = sw; }
            }
            __syncthreads();
            f32x4 O[2];
            if (OUT) {
                const int it = w >> 1, c0 = (w & 1) * 2;
                f32x4 at[2] = {(f32x4){0.f, 0.f, 0.f, 0.f}, (f32x4){0.f, 0.f, 0.f, 0.f}};
                O[0] = (f32x4){0.f, 0.f, 0.f, 0.f}; O[1] = (f32x4){0.f, 0.f, 0.f, 0.f};
#pragma unroll
                for (int kk = 0; kk < 4; ++kk) {
                    const bf16x8 af = *(const LAS bf16x8*)(QP + (it * 16 + l15) * 136 + kk * 32 + quad * 8);
#pragma unroll
                    for (int x = 0; x < 2; ++x) {
                        const bf16x8 kf = *(const LAS bf16x8*)(KP + ((c0 + x) * 16 + l15) * 136 + kk * 32 + quad * 8);
                        at[x] = __builtin_amdgcn_mfma_f32_16x16x32_bf16(af, kf, at[x], 0, 0, 0);
                        const bf16x8 sf = *(const LAS bf16x8*)(SS + ((c0 + x) * 16 + l15) * 136 + kk * 32 + quad * 8);
                        O[x] = __builtin_amdgcn_mfma_f32_16x16x32_bf16(af, sf, O[x], 0, 0, 0);
                    }
                }
#pragma unroll
                for (int x = 0; x < 2; ++x)
#pragma unroll
                    for (int r = 0; r < 4; ++r) { const int i = it * 16 + quad * 4 + r, j = (c0 + x) * 16 + l15;
                        ATT[i * 72 + j] = f2bf(j <= i ? at[x][r] : 0.f); }
            }
            {
#pragma unroll
                for (int r = 0; r < 4; ++r) { const float dd = BL[16 * w + 4 * quad + r];
#pragma unroll
                    for (int d = 0; d < 4; ++d) S[d][r] *= dd; }
#pragma unroll
                for (int kk = 0; kk < 2; ++kk) {
                    const bf16x8 af = *(const LAS bf16x8*)(KT + (16 * w + l15) * 72 + kk * 32 + quad * 8);
#pragma unroll
                    for (int d = 0; d < 4; ++d) { const bf16x8 vf = *(const LAS bf16x8*)(VT + (d * 16 + l15) * 72 + kk * 32 + quad * 8);
                        S[d] = __builtin_amdgcn_mfma_f32_16x16x32_bf16(af, vf, S[d], 0, 0, 0); }
                }
            }
            if (OUT) {
                __syncthreads();
                const int it = w >> 1, c0 = (w & 1) * 2;
#pragma unroll
                for (int kk = 0; kk < 2; ++kk) {
                    const bf16x8 af = *(const LAS bf16x8*)(ATT + (it * 16 + l15) * 72 + kk * 32 + quad * 8);
#pragma unroll
                    for (int x = 0; x < 2; ++x) { const bf16x8 vf = *(const LAS bf16x8*)(VT + ((c0 + x) * 16 + l15) * 72 + kk * 32 + quad * 8);
                        O[x] = __builtin_amdgcn_mfma_f32_16x16x32_bf16(af, vf, O[x], 0, 0, 0); }
                }
#pragma unroll
                for (int x = 0; x < 2; ++x)
#pragma unroll
                    for (int r = 0; r < 4; ++r) { const int ip = it * 16 + quad * 4 + r; const int tok = tb + (dir == 0 ? ip : 63 - ip);
                        oout[(size_t)tok * 256 + slice * 64 + (c0 + x) * 16 + l15] = O[x][r]; }
            }
            __syncthreads();
        }
        if (!OUT) {
            float* sl = SLOC + (size_t)(seg * 2 + dir) * 128 * 256;
#pragma unroll
            for (int r = 0; r < 4; ++r) { const int dk = 16 * w + 4 * quad + r;
#pragma unroll
                for (int d = 0; d < 4; ++d) sl[(size_t)dk * 256 + slice * 64 + d * 16 + l15] = S[d][r]; }
            if (slice == 0 && tid < 128) DVEC[(size_t)(seg * 2 + dir) * 128 + tid] = __expf(dsum);
        }
    }
}

typedef float f32x16 __attribute__((ext_vector_type(16)));
__device__ __forceinline__ void dil_attn(const Params& p, int hc, LAS unsigned char* lds) {
    unsigned char* st = p.ws + OFF_STAGE; bf16_t* AB = (bf16_t*)(st + ST_ABUF); const float* btab = (const float*)(p.ws + OFF_BTAB);
    LAS float* OST = (LAS float*)lds; LAS float* MST = (LAS float*)(lds + 139264); LAS float* LST = (LAS float*)(lds + 141312); LAS float* BTL = (LAS float*)(lds + 143360);
    int tid = threadIdx.x; asm volatile("" : "+v"(tid)); const int lane = tid & 63, w = tid >> 6, l31 = lane & 31, hh = lane >> 5;
    const int kap = (l31 & 16) | ((l31 & 4) << 1) | ((l31 & 8) >> 1) | (l31 & 3);
    for (int unit = blockIdx.x; unit < 256; unit += gridDim.x) {
        const int hl = unit & 3, tbk = unit >> 2, t0 = tbk * 512;
        const int sb = t0 < 8192 ? 0 : (t0 < 16384 ? 8192 : 16384), Sq = t0 < 16384 ? 8192 : 16384;
        const int h = hc * 4 + hl;
#pragma unroll 1
        for (int g = 0; g < 3; ++g) {
            const int r = g == 0 ? 1 : (g == 1 ? 4 : 16), L = Sq / r;
            const bf16_t* QKg = (const bf16_t*)(st + ST_QKG) + (size_t)g * T * 512; const bf16_t* VTg = (const bf16_t*)(st + ST_VTG) + (size_t)g * 256 * T;
            const float* bt = btab + (g * 16 + h) * 129;
            if (tid < 256) { const int ri = tid - 96; BTL[tid] = (ri >= 0 && ri <= 128) ? bt[ri] : 0.f; }
            __syncthreads();
#pragma unroll 1
            for (int itx = 0; itx < 2; ++itx) {
                const int item = 2 * w + itx;
                int c, l0;
                if (g == 0) { c = 0; l0 = (t0 - sb) + 32 * item; } else if (g == 1) { c = item >> 2; l0 = (t0 - sb) / 4 + 32 * (item & 3); } else { c = item; l0 = (t0 - sb) / 16; }
                const int nq0 = sb + c * L + l0, nbase = nq0 - 64;
                const int tokl = (l0 + l31) * r + c - (t0 - sb);
                bf16x8 qf[4];
#pragma unroll
                for (int ks = 0; ks < 4; ++ks) qf[ks] = ld_sys16(QKg + (unsigned)(((nq0 >> 5) * 16 + hl * 4 + ks) * 512 + l31 * 16 + hh * 8));
                f32x16 sT[5];
                bf16x8 kf[4];
#define DIL_LOADK(kt) do { const int lkh_ = l0 - 64 + 32 * (kt) + (l31 & 16); const bool in_ = (lkh_ >= 0) && (lkh_ < L); \
                    const int nrow_ = in_ ? nbase + 32 * (kt) + kap : nq0 + l31; \
                    _Pragma("unroll") for (int ks_ = 0; ks_ < 4; ++ks_) kf[ks_] = ld_sys16(QKg + (unsigned)(T * 256 + ((nrow_ >> 5) * 16 + hl * 4 + ks_) * 512 + (nrow_ & 31) * 16 + hh * 8)); } while (0)
#pragma unroll
                for (int kt = 0; kt < 5; ++kt) {
                    DIL_LOADK(kt);
                    f32x16 a;
#pragma unroll
                    for (int j = 0; j < 16; ++j) a[j] = 0.f;
#pragma unroll
                    for (int ks = 0; ks < 4; ++ks) a = __builtin_amdgcn_mfma_f32_32x32x16_bf16(kf[ks], qf[ks], a, 0, 0, 0);
                    sT[kt] = a;
                }
                bf16x8 vf[4];
#define DIL_LOADV(kt) do { _Pragma("unroll") for (int s_ = 0; s_ < 2; ++s_) { const int lkh_ = l0 - 64 + 32 * (kt) + 16 * s_; const bool in_ = (lkh_ >= 0) && (lkh_ < L); \
                    const int ncol_ = in_ ? nbase + 32 * (kt) + 16 * s_ + 8 * hh : nq0; \
                    _Pragma("unroll") for (int dt_ = 0; dt_ < 2; ++dt_) vf[2 * s_ + dt_] = ld_sys16(VTg + (unsigned)((ncol_ >> 5) * 8192 + (hl * 64 + dt_ * 32 + l31) * 32 + (ncol_ & 31))); } } while (0)
                DIL_LOADV(0);
#pragma unroll
                for (int kt = 0; kt < 5; ++kt)
#pragma unroll
                    for (int j = 0; j < 16; ++j) { const int lkh = l0 - 64 + 32 * kt + 16 * (j >> 3); const bool inr = (lkh >= 0) && (lkh < L);
                        const int rel = -64 + 32 * kt + 16 * (j >> 3) + 8 * hh + (j & 7) - l31; const bool ok = inr && rel >= -64 && rel <= 64;
                        sT[kt][j] = ok ? sT[kt][j] + BTL[rel + 160] : -1.0e30f; }
                float mo = -1.0e30f, lo = 0.f;
                if (g > 0) { mo = MST[tokl]; lo = LST[tokl]; }
                float mx = mo;
#pragma unroll
                for (int kt = 0; kt < 5; ++kt)
#pragma unroll
                    for (int j = 0; j < 16; ++j) mx = fmaxf(mx, sT[kt][j]);
                mx = fmaxf(mx, __shfl_xor(mx, 32));
                const float alpha = __expf(mo - mx);
                float ls = 0.f;
#pragma unroll
                for (int kt = 0; kt < 5; ++kt)
#pragma unroll
                    for (int j = 0; j < 16; ++j) { const float e = __expf(sT[kt][j] - mx); sT[kt][j] = e; ls += e; }
                ls += __shfl_xor(ls, 32);
                const float ln = lo * alpha + ls;
                f32x16 O[2];
#pragma unroll
                for (int dt = 0; dt < 2; ++dt)
#pragma unroll
                    for (int j = 0; j < 16; ++j) O[dt][j] = 0.f;
                if (g > 0) {
#pragma unroll
                    for (int dt = 0; dt < 2; ++dt)
#pragma unroll
                        for (int g4 = 0; g4 < 4; ++g4) { const f32x4 o4 = *(const LAS f32x4*)(OST + tokl * 68 + dt * 32 + g4 * 8 + hh * 4);
                            O[dt][4 * g4] = o4[0] * alpha; O[dt][4 * g4 + 1] = o4[1] * alpha; O[dt][4 * g4 + 2] = o4[2] * alpha; O[dt][4 * g4 + 3] = o4[3] * alpha; } }
#pragma unroll
                for (int kt = 0; kt < 5; ++kt) {
                    if (kt > 0) DIL_LOADV(kt);
#pragma unroll
                    for (int s2 = 0; s2 < 2; ++s2) {
                        u32x4 pw; pw.x = cvt_pk_bf16(sT[kt][8 * s2], sT[kt][8 * s2 + 1]); pw.y = cvt_pk_bf16(sT[kt][8 * s2 + 2], sT[kt][8 * s2 + 3]);
                        pw.z = cvt_pk_bf16(sT[kt][8 * s2 + 4], sT[kt][8 * s2 + 5]); pw.w = cvt_pk_bf16(sT[kt][8 * s2 + 6], sT[kt][8 * s2 + 7]);
                        const bf16x8 pf = __builtin_bit_cast(bf16x8, pw);
#pragma unroll
                        for (int dt = 0; dt < 2; ++dt) O[dt] = __builtin_amdgcn_mfma_f32_32x32x16_bf16(vf[2 * s2 + dt], pf, O[dt], 0, 0, 0);
                    }
                }
#undef DIL_LOADK
#undef DIL_LOADV
                if (g < 2) {
                    if (hh == 0) { MST[tokl] = mx; LST[tokl] = ln; }
#pragma unroll
                    for (int dt = 0; dt < 2; ++dt)
#pragma unroll
                        for (int g4 = 0; g4 < 4; ++g4) *(LAS f32x4*)(OST + tokl * 68 + dt * 32 + g4 * 8 + hh * 4) = (f32x4){O[dt][4 * g4], O[dt][4 * g4 + 1], O[dt][4 * g4 + 2], O[dt][4 * g4 + 3]};
                } else {
                    const float inv = 1.0f / ln;
#pragma unroll
                    for (int dt = 0; dt < 2; ++dt)
#pragma unroll
                        for (int g4 = 0; g4 < 4; ++g4) { u32x2 ow; ow.x = cvt_pk_bf16(O[dt][4 * g4] * inv, O[dt][4 * g4 + 1] * inv); ow.y = cvt_pk_bf16(O[dt][4 * g4 + 2] * inv, O[dt][4 * g4 + 3] * inv);
                            *(u32x2*)(AB + (size_t)(t0 + tokl) * DM + h * 64 + dt * 32 + g4 * 8 + hh * 4) = ow; }
                }
            }
            __syncthreads();
        }
    }
}

#define XB_TMO      128
#define XB_XCNT(j)  (256  + 64 * (j))
#define XB_XSUB(j)  (1280 + 64 * (j))
#define XB_XGEN(j)  (2304 + 64 * (j))
#define XB_TOP      3328
#define XB_TOPGEN   3392
#define XCD_BAR_WORDS 3456
#define XB_SPIN_CAP (1u << 22)
__device__ __forceinline__ unsigned xb_ld(unsigned* p)              { return __hip_atomic_load(p, __ATOMIC_RELAXED, __HIP_MEMORY_SCOPE_AGENT); }
__device__ __forceinline__ unsigned xb_add(unsigned* p, unsigned v) { return __hip_atomic_fetch_add(p, v, __ATOMIC_RELAXED, __HIP_MEMORY_SCOPE_AGENT); }
__device__ __forceinline__ unsigned xb_xcc_id() { return (unsigned)__builtin_amdgcn_s_getreg((3 << 11) | 20) & 0xFu; }
#define XB_SPIN(cond, bar) do { unsigned _sp = 0; while (cond) { __builtin_amdgcn_s_sleep(1); \
    if ((++_sp & 255u) == 0u) { if (xb_ld(&(bar)[XB_TMO])) break; if (_sp > XB_SPIN_CAP) { atomicAdd(&(bar)[XB_TMO], 1u); break; } } } } while (0)
struct XcdBarrier { unsigned* bar; unsigned x; volatile LAS unsigned* st; };
__device__ __forceinline__ XcdBarrier xcd_barrier_post(unsigned* bar, volatile LAS unsigned* st) {
    XcdBarrier b; b.bar = bar; b.x = xb_xcc_id(); b.st = st;
    if (threadIdx.x == 0) (void)xb_add(&bar[XB_XCNT(b.x)], 1u);
    return b;
}
__device__ __forceinline__ void xcd_barrier_complete(unsigned* bar, unsigned x, unsigned& nloc, unsigned& nx) {
    const unsigned G = gridDim.x * gridDim.y * gridDim.z;
    unsigned sum, cnt, mine, sp = 0u;
    for (;;) {
        sum = 0u; cnt = 0u; mine = 0u;
#pragma unroll
        for (unsigned j = 0; j < 16; ++j) { const unsigned c = xb_ld(&bar[XB_XCNT(j)]); sum += c; cnt += (c > 0u) ? 1u : 0u; mine = (j == x) ? c : mine; }
        if (sum == G) break;
        __builtin_amdgcn_s_sleep(1);
        if ((++sp & 255u) == 0u) { if (xb_ld(&bar[XB_TMO])) break; if (sp > XB_SPIN_CAP) { atomicAdd(&bar[XB_TMO], 1u); break; } }
    }
    nloc = mine > 0u ? mine : 1u; nx = cnt > 0u ? cnt : 1u;
}
__device__ __forceinline__ void xcd_barrier(const XcdBarrier& b) {
    asm volatile("s_waitcnt vmcnt(0)" ::: "memory");
    __syncthreads();
    if (threadIdx.x == 0) {
        unsigned* bar = b.bar;
        __builtin_amdgcn_s_waitcnt(0);
        unsigned nloc = b.st[0], nx = b.st[1];
        if (nloc == 0u) { xcd_barrier_complete(bar, b.x, nloc, nx); b.st[0] = nloc; b.st[1] = nx; }
        const unsigned old = xb_add(&bar[XB_XSUB(b.x)], 1u);
        const unsigned gen = old / nloc;
        if (old + 1u == (gen + 1u) * nloc) {
            __builtin_amdgcn_fence(__ATOMIC_RELEASE, "agent");
            asm volatile("s_waitcnt vmcnt(0)" ::: "memory");
            const unsigned og = xb_add(&bar[XB_TOP], 1u);
            const unsigned tg = og / nx;
            if (og + 1u == (tg + 1u) * nx) xb_add(&bar[XB_TOPGEN], 1u);
            else XB_SPIN(xb_ld(&bar[XB_TOPGEN]) == tg, bar);
            __builtin_amdgcn_fence(__ATOMIC_ACQUIRE, "agent");
            xb_add(&bar[XB_XGEN(b.x)], 1u);
            asm volatile("s_waitcnt vmcnt(0)" ::: "memory");
        } else {
            XB_SPIN(xb_ld(&bar[XB_XGEN(b.x)]) == gen, bar);
            __builtin_amdgcn_fence(__ATOMIC_ACQUIRE, "agent");
            asm volatile("s_waitcnt vmcnt(0)" ::: "memory");
        }
    }
    __syncthreads();
}

__global__ void __launch_bounds__(512, 2) fwd_megakernel(Params p) {
    extern __shared__ __attribute__((aligned(16))) unsigned char smem[];
    LAS unsigned char* lds = (LAS unsigned char*)smem;
    cg::grid_group grid = cg::this_grid();
    if (threadIdx.x < 2) ((volatile LAS unsigned*)(lds + LDS_CTL))[threadIdx.x] = 0u;
    __syncthreads();
    const XcdBarrier bar = xcd_barrier_post((unsigned*)(p.ws + OFF_CTL), (volatile LAS unsigned*)(lds + LDS_CTL));
    grid.sync();
    unsigned char* ws = p.ws; bf16_t* WB = (bf16_t*)ws; bf16_t* XB = (bf16_t*)(ws + OFF_XB); float* part = (float*)(ws + OFF_PART);
    unsigned char* st = ws + OFF_STAGE;
    for (int ph = p.ph_lo; ph < p.ph_hi; ++ph) {
        if (ph > p.ph_lo) { for (int xs = 0; xs <= PROBE_SYNC; ++xs) xcd_barrier(bar); }
        if (ph == 37) { phase_final(p); continue; }
        const int layer = ph >= 21 ? 1 : 0, q = ph - layer * 21;
        int op = -1, arg = 0;
        if (q == 0) op = 0; else if (q == 1) op = 1; else if (q == 2) op = 2;
        else if (layer == 0) {
            if (q <= 14) { const int hh = (q - 3) / 3, s = (q - 3) % 3; arg = hh; op = 10 + s; }
            else if (q == 15) { op = 13; arg = 3; } else op = q - 16 + 3;
        } else {
            if (q <= 10) { arg = (q - 3) >> 1; op = 20 + ((q - 3) & 1); } else op = q - 11 + 3;
        }
        if (op == 10 && arg > 0) gla_combine(p, arg - 1);
        for (int rep = 0; rep < (((PROBE_REP >> op) & 1u) ? 2 : 1); ++rep) {
        if (op == 0) { if (EN(0)) phase_prologue(p, layer, lds); }
        else if (op == 11) { if (EN(11)) gla_scan<false>(p, lds); }
        else if (op == 12) { if (EN(12)) gla_scan<true>(p, lds); }
        else if (op == 13) { if (EN(13)) gla_combine(p, arg); }
        else if (op == 21) { if (EN(21)) dil_attn(p, arg, lds); }
        else if (EN(1)) {
            GemmJob J;
            for (int j = 0; j < 8; ++j) { if (!get_job(p, op, arg, j, J)) break;
                const int nres = layer * 4 + (op >= 7 ? 3 : (op >= 5 && op < 10 ? 2 : (op == 4 || op == 3 ? 1 : (op == 2 ? 0 : (op == 1 ? 0 : (op == 6 ? 3 : 1))))));
                const int vr = (op == 1) ? layer * 4 : ((op == 10 || op == 20) ? layer * 4 + 1 : (op == 4 ? layer * 4 + 2 : layer * 4 + 3));
                const float* part = (const float*)(ws + OFF_PARTV + (size_t)vr * PARTV_BYTES); float* partw = (float*)(ws + OFF_PARTV + (size_t)(nres + 1) * PARTV_BYTES); const int kind = J.e.kind;
                if (EN(22) && kind == 0) { EpiPlain e{(bf16_t*)(ws + J.e.o_off), J.e.ldc, J.e.bstride}; gemm_phase(lds, J.K, J.lda, J.ldb, J.s, e); }
                else if (EN(23) && kind == 1) { EpiSwiGLU e{(bf16_t*)(ws + J.e.o_off), part}; gemm_phase(lds, DM, DM, DM, J.s, e); }
                else if (EN(24) && kind == 2) { EpiResid e{p.X, XB, partw, J.e.scale, (LAS float*)(lds + LDS_X)}; gemm_phase(lds, J.K, J.K, J.K, J.s, e); }
                else if (EN(25) && kind == 3) { EpiGlaProj e{(bf16_t*)(st + ST_QK), (float*)(st + ST_GG), (bf16_t*)(st + ST_VV), (bf16_t*)(st + ST_ABUF), part, p.in[11], p.in[13], J.e.h}; gemm_phase(lds, DM, DM, DM, J.s, e); }
                else if (EN(26) && kind == 4) { EpiDilQK e{(bf16_t*)(ws + J.e.o_off), part, J.e.r}; gemm_phase(lds, DM, J.lda, DM, J.s, e); }
                else if (EN(27) && kind == 5) { EpiDilVT e{(bf16_t*)(ws + J.e.o_off), part, J.e.r}; gemm_phase(lds, DM, DM, J.ldb, J.s, e); }
                else if (EN(28) && kind == 6) { EpiScores e{(bf16_t*)(ws + J.e.o_off), part, (LAS f32x2*)(lds + LDS_X)}; gemm_phase(lds, DM, DM, DM, J.s, e); }
            }
        }
        __syncthreads();
        }
    }
}

extern "C" void kernel_launch(void* const* d_in, const int* in_sizes, int n_in, void* d_out, int out_size, void* d_ws, size_t ws_size, hipStream_t stream) {
    static int grid_blocks = 0;
    if (!grid_blocks) {
        int dev = 0, cus = 0, per_cu = 0;
        hipGetDevice(&dev);
        hipDeviceGetAttribute(&cus, hipDeviceAttributeMultiprocessorCount, dev);
        hipFuncSetAttribute((const void*)fwd_megakernel, hipFuncAttributeMaxDynamicSharedMemorySize, LDS_BYTES);
        hipOccupancyMaxActiveBlocksPerMultiprocessor(&per_cu, fwd_megakernel, 512, LDS_BYTES);
        if (per_cu < 1) per_cu = 1;
        if (per_cu > 1) per_cu = 1;
        grid_blocks = cus * per_cu;
    }
    if (n_in != 27 || ws_size < WS_NEED) { fprintf(stderr, "kernel_launch: unexpected n_in %d / ws_size %zu (need %zu)\n", n_in, ws_size, (size_t)WS_NEED); return; }
    hipMemsetAsync((char*)d_ws + OFF_CTL, 0, CTL_BYTES, stream);
    Params p{};
    for (int i = 0; i < 27; ++i) p.in[i] = (const float*)d_in[i];
    p.X = (float*)d_out; p.ws = (unsigned char*)d_ws; p.ph_lo = 0; p.ph_hi = 38;
    void* args[] = {&p};
    hipError_t e = hipLaunchCooperativeKernel((const void*)fwd_megakernel, dim3(grid_blocks), dim3(512), args, LDS_BYTES, stream);
    if (e != hipSuccess) fprintf(stderr, "cooperative launch failed: %s (grid %d)\n", hipGetErrorString(e), grid_blocks);
}
```
